# Optimizing an MI355X kernel written in HIP

```python
import math
import jax, jax.numpy as jnp
from jax import lax
import numpy as np

D_MODEL = 4096
BATCH = 4
SEQ = 4096
DEPTH = 1

GRID_W = 64
SSM_EXPAND = 2
SSM_D_INNER = SSM_EXPAND * D_MODEL
SSM_HEAD_DIM = 64
SSM_HEADS = SSM_D_INNER // SSM_HEAD_DIM
SSM_GROUPS = 8
SSM_STATE = 128
SSM_CONV_W = 3
SSM_CHUNK = 128
SSM_CONV_DIM = SSM_D_INNER + 2 * SSM_GROUPS * SSM_STATE
ATTN_HEAD_DIM = 128
ATTN_Q_HEADS = D_MODEL // ATTN_HEAD_DIM
ATTN_KV_HEADS = 8
ATTN_BLOCK_Q = 128
ROPE_THETA = 10000.0
FFN_DIM = 11008
FFN_CONV_W = 3
LN_EPS = 1e-5
RMS_EPS = 1e-6
DEEPNORM_ALPHA = (2.0 * DEPTH) ** 0.25
DEEPNORM_BETA = (8.0 * DEPTH) ** -0.25
ADA_INIT = 0.5

Z_COLS = SSM_D_INNER
XBC_COLS = SSM_CONV_DIM
DT_COLS = 2 * SSM_HEADS
Q_COLS = ATTN_Q_HEADS * ATTN_HEAD_DIM
KV_COLS = ATTN_KV_HEADS * ATTN_HEAD_DIM
IN_COLS = Z_COLS + XBC_COLS + DT_COLS + Q_COLS + 2 * KV_COLS
IN_SPLITS = [Z_COLS, Z_COLS + XBC_COLS, Z_COLS + XBC_COLS + DT_COLS,
             Z_COLS + XBC_COLS + DT_COLS + Q_COLS,
             Z_COLS + XBC_COLS + DT_COLS + Q_COLS + KV_COLS]

kernel_name = "hybrid_ssd_gqa_convffn_deepnorm_adaln"


def layer_norm(x, g=None, b=None):
    xf = x.astype(jnp.float32)
    mu = jnp.mean(xf, axis=-1, keepdims=True)
    var = jnp.mean(jnp.square(xf - mu), axis=-1, keepdims=True)
    y = (xf - mu) * lax.rsqrt(var + LN_EPS)
    if g is not None:
        y = y * g.astype(jnp.float32) + b.astype(jnp.float32)
    return y.astype(x.dtype)


def rms_norm(x, g):
    xf = x.astype(jnp.float32)
    y = xf * lax.rsqrt(jnp.mean(jnp.square(xf), axis=-1, keepdims=True) + RMS_EPS)
    return (y * g.astype(jnp.float32)).astype(x.dtype)


def dwconv_centered(x, w, b):
    K = w.shape[0]
    pad = K // 2
    S = x.shape[1]
    xp = jnp.pad(x, ((0, 0), (pad, pad), (0, 0)))
    y = xp[:, 0:S, :] * w[0]
    for j in range(1, K):
        y = y + xp[:, j:j + S, :] * w[j]
    return y + b


def axial_rope(x, row, col):
    half = x.shape[-1] // 2
    quarter = half // 2
    inv = 1.0 / (ROPE_THETA ** (jnp.arange(quarter, dtype=jnp.float32) / quarter))

    def rot(xh, pos):
        ang = pos.astype(jnp.float32)[:, None] * inv[None, :]
        cos = jnp.cos(ang)[None, :, None, :]
        sin = jnp.sin(ang)[None, :, None, :]
        x1 = xh[..., :quarter].astype(jnp.float32)
        x2 = xh[..., quarter:].astype(jnp.float32)
        return jnp.concatenate([x1 * cos - x2 * sin, x2 * cos + x1 * sin], axis=-1)

    out = jnp.concatenate([rot(x[..., :half], row), rot(x[..., half:], col)], axis=-1)
    return out.astype(x.dtype)


def block_attention(q, k, v):
    Bsz, S, Hq, Dh = q.shape
    Hkv = k.shape[2]
    G = Hq // Hkv
    nb = S // ATTN_BLOCK_Q
    qb = q.reshape(Bsz, nb, ATTN_BLOCK_Q, Hkv, G, Dh).transpose(1, 0, 2, 3, 4, 5)
    scale = Dh ** -0.5

    def one_block(qi):
        s = jnp.einsum('bqkgd,bskd->bkgqs', qi, k).astype(jnp.float32) * scale
        p = jax.nn.softmax(s, axis=-1).astype(v.dtype)
        return jnp.einsum('bkgqs,bskd->bqkgd', p, v)

    o = lax.map(one_block, qb)
    return o.transpose(1, 0, 2, 3, 4, 5).reshape(Bsz, S, Hq * Dh)


def ssd_scan(x, dt, A, Bm, Cm):
    Bsz, S, H, P = x.shape
    G, N = Bm.shape[2], Bm.shape[3]
    Hg = H // G
    L = SSM_CHUNK
    nc = S // L

    def chunk(t):
        return jnp.moveaxis(t.reshape((Bsz, nc, L) + t.shape[2:]), 1, 0)

    xc = chunk(x.reshape(Bsz, S, G, Hg, P))
    ac = chunk((dt * A).reshape(Bsz, S, G, Hg))
    dtc = chunk(dt.reshape(Bsz, S, G, Hg))
    Bc = chunk(Bm)
    Cc = chunk(Cm)
    mask = jnp.tril(jnp.ones((L, L), dtype=bool))[None, :, :, None, None]

    def step(h, inp):
        xi, ai, dti, Bi, Ci = inp
        cum = jnp.cumsum(ai, axis=1)
        seg = cum[:, :, None] - cum[:, None, :]
        decay = jnp.exp(jnp.where(mask, seg, -jnp.inf))
        cb = jnp.einsum('blgn,bsgn->blsg', Ci, Bi)
        y_intra = jnp.einsum('blsg,blsgh,bsgh,bsghp->blghp', cb, decay, dti, xi)
        y_inter = jnp.einsum('blgn,bghpn,blgh->blghp', Ci, h, jnp.exp(cum))
        to_end = jnp.exp(cum[:, -1:] - cum) * dti
        h_new = h * jnp.exp(cum[:, -1])[..., None, None] + \
            jnp.einsum('bsgn,bsgh,bsghp->bghpn', Bi, to_end, xi)
        return h_new, y_intra + y_inter

    h0 = jnp.zeros((Bsz, G, Hg, P, N), jnp.float32)
    _, y = lax.scan(step, h0, (xc, ac, dtc, Bc, Cc))
    return jnp.moveaxis(y, 0, 1).reshape(Bsz, S, H, P)


def ssd_branch(z, xbc, dt_raw, conv_w, conv_b, a_log, dt_bias, d_skip, norm_w):
    Bsz, S, _ = z.shape
    f32 = jnp.float32
    xbc = jax.nn.silu(dwconv_centered(xbc, conv_w, conv_b)).astype(f32)
    xs = xbc[..., :SSM_D_INNER].reshape(Bsz, S, SSM_HEADS, SSM_HEAD_DIM)
    Bm = xbc[..., SSM_D_INNER:SSM_D_INNER + SSM_GROUPS * SSM_STATE].reshape(Bsz, S, SSM_GROUPS, SSM_STATE)
    Cm = xbc[..., SSM_D_INNER + SSM_GROUPS * SSM_STATE:].reshape(Bsz, S, SSM_GROUPS, SSM_STATE)
    dt = jax.nn.softplus(dt_raw.astype(f32).reshape(Bsz, S, 2, SSM_HEADS) + dt_bias.astype(f32))
    A = -jnp.exp(a_log.astype(f32))
    flip = lambda t: jnp.flip(t, axis=1)
    y_f = ssd_scan(xs, dt[:, :, 0], A[0], Bm, Cm)
    y_b = flip(ssd_scan(flip(xs), flip(dt[:, :, 1]), A[1], flip(Bm), flip(Cm)))
    y = (y_f + y_b + d_skip.astype(f32)[:, None] * xs).reshape(Bsz, S, SSM_D_INNER)
    yg = (y * jax.nn.silu(z.astype(f32))).reshape(Bsz, S, SSM_GROUPS, SSM_D_INNER // SSM_GROUPS)
    yg = yg * lax.rsqrt(jnp.mean(jnp.square(yg), axis=-1, keepdims=True) + RMS_EPS)
    return (yg.reshape(Bsz, S, SSM_D_INNER) * norm_w.astype(f32)).astype(z.dtype)


def setup_inputs(seed: int = 0) -> dict:
    key = jax.random.key(seed)
    ks = jax.random.split(key, 26)
    f32 = jnp.float32
    nrm = lambda k, shape, s: jax.random.normal(k, shape, f32) * s
    dt0 = jnp.exp(jax.random.uniform(ks[7], (DEPTH, 2, SSM_HEADS), f32, math.log(1e-3), math.log(1e-1)))
    return {
        "x": nrm(ks[0], (BATCH, SEQ, D_MODEL), 1.0),
        "c": nrm(ks[1], (BATCH, D_MODEL), 1.0),
        "w_ada": nrm(ks[2], (DEPTH, D_MODEL, 6 * D_MODEL), ADA_INIT * D_MODEL ** -0.5),
        "b_ada": nrm(ks[3], (DEPTH, 6 * D_MODEL), 0.01),
        "w_in": nrm(ks[4], (DEPTH, D_MODEL, IN_COLS), D_MODEL ** -0.5),
        "ssm_conv_w": nrm(ks[5], (DEPTH, SSM_CONV_W, SSM_CONV_DIM), SSM_CONV_W ** -0.5),
        "ssm_conv_b": nrm(ks[6], (DEPTH, SSM_CONV_DIM), 0.01),
        "ssm_a_log": jnp.log(jax.random.uniform(ks[8], (DEPTH, 2, SSM_HEADS), f32, 1.0, 16.0)),
        "ssm_dt_bias": dt0 + jnp.log(-jnp.expm1(-dt0)),
        "ssm_d": 1.0 + nrm(ks[9], (DEPTH, SSM_HEADS), 0.1),
        "ssm_norm_w": 1.0 + nrm(ks[10], (DEPTH, SSM_D_INNER), 0.1),
        "q_norm_w": 1.0 + nrm(ks[11], (DEPTH, ATTN_HEAD_DIM), 0.1),
        "k_norm_w": 1.0 + nrm(ks[12], (DEPTH, ATTN_HEAD_DIM), 0.1),
        "w_ssm_proj": nrm(ks[13], (DEPTH, SSM_D_INNER, D_MODEL), SSM_D_INNER ** -0.5),
        "w_attn_proj": nrm(ks[14], (DEPTH, Q_COLS, D_MODEL), Q_COLS ** -0.5),
        "w_gate": nrm(ks[15], (DEPTH, D_MODEL, 2 * D_MODEL), D_MODEL ** -0.5),
        "b_gate": nrm(ks[16], (DEPTH, 2 * D_MODEL), 0.01),
        "w_out": nrm(ks[17], (DEPTH, D_MODEL, D_MODEL), DEEPNORM_BETA * D_MODEL ** -0.5),
        "ln1_g": 1.0 + nrm(ks[18], (DEPTH, D_MODEL), 0.1),
        "ln1_b": nrm(ks[19], (DEPTH, D_MODEL), 0.01),
        "w_up": nrm(ks[20], (DEPTH, D_MODEL, 2 * FFN_DIM), D_MODEL ** -0.5),
        "ffn_conv_w": nrm(ks[21], (DEPTH, FFN_CONV_W, 2 * FFN_DIM), FFN_CONV_W ** -0.5),
        "ffn_conv_b": nrm(ks[22], (DEPTH, 2 * FFN_DIM), 0.01),
        "w_down": nrm(ks[23], (DEPTH, FFN_DIM, D_MODEL), DEEPNORM_BETA * FFN_DIM ** -0.5),
        "ln2_g": 1.0 + nrm(ks[24], (DEPTH, D_MODEL), 0.1),
        "ln2_b": nrm(ks[25], (DEPTH, D_MODEL), 0.01),
    }


def reference(x, c, w_ada, b_ada, w_in, ssm_conv_w, ssm_conv_b, ssm_a_log, ssm_dt_bias,
              ssm_d, ssm_norm_w, q_norm_w, k_norm_w, w_ssm_proj, w_attn_proj, w_gate, b_gate,
              w_out, ln1_g, ln1_b, w_up, ffn_conv_w, ffn_conv_b, w_down, ln2_g, ln2_b):
    Bsz, S, D = x.shape
    rows = S // GRID_W
    row = jnp.repeat(jnp.arange(rows, dtype=jnp.int32), GRID_W)
    col = jnp.tile(jnp.arange(GRID_W, dtype=jnp.int32), rows)
    cond = jax.nn.silu(c)

    for layer in range(DEPTH):
        mod = (cond @ w_ada[layer] + b_ada[layer])[:, None, :]
        sh1, sc1, g1, sh2, sc2, g2 = jnp.split(mod, 6, axis=-1)

        h = layer_norm(x) * (1.0 + sc1) + sh1
        proj = h @ w_in[layer]
        z, xbc, dt_raw, q, k, v = jnp.split(proj, IN_SPLITS, axis=-1)

        y_ssm = ssd_branch(z, xbc, dt_raw, ssm_conv_w[layer], ssm_conv_b[layer],
                           ssm_a_log[layer], ssm_dt_bias[layer], ssm_d[layer],
                           ssm_norm_w[layer])

        q = rms_norm(q.reshape(Bsz, S, ATTN_Q_HEADS, ATTN_HEAD_DIM), q_norm_w[layer])
        k = rms_norm(k.reshape(Bsz, S, ATTN_KV_HEADS, ATTN_HEAD_DIM), k_norm_w[layer])
        v = v.reshape(Bsz, S, ATTN_KV_HEADS, ATTN_HEAD_DIM)
        q = axial_rope(q, row, col)
        k = axial_rope(k, row, col)
        y_attn = block_attention(q, k, v)

        o_ssm = y_ssm @ w_ssm_proj[layer]
        o_attn = y_attn @ w_attn_proj[layer]
        gates = jax.nn.sigmoid(h @ w_gate[layer] + b_gate[layer])
        ga, gb = jnp.split(gates, 2, axis=-1)
        mixed = (ga * o_ssm + gb * o_attn) @ w_out[layer]
        x = layer_norm(DEEPNORM_ALPHA * x + g1 * mixed, ln1_g[layer], ln1_b[layer])

        h2 = layer_norm(x) * (1.0 + sc2) + sh2
        u = dwconv_centered(h2 @ w_up[layer], ffn_conv_w[layer], ffn_conv_b[layer])
        ua, ub = jnp.split(u, 2, axis=-1)
        f = (jax.nn.silu(ua) * ub) @ w_down[layer]
        x = layer_norm(DEEPNORM_ALPHA * x + g2 * f, ln2_g[layer], ln2_b[layer])

    return x
```

```cpp
#include <hip/hip_runtime.h>
#include <cstdio>
#include <cstdint>

#define GAS __attribute__((address_space(1)))
#define LAS __attribute__((address_space(3)))
typedef unsigned short bf16;
typedef unsigned v4u __attribute__((ext_vector_type(4)));
typedef unsigned v2u __attribute__((ext_vector_type(2)));
typedef float v4f __attribute__((ext_vector_type(4)));

constexpr int D_MODEL = 4096, BATCH = 4, SEQ = 4096, MTOK = BATCH * SEQ;
constexpr int GRID_W = 64;
constexpr int SSM_DI = 8192, SSM_HD = 64, SSM_H = 128, SSM_G = 8, SSM_N = 128, SSM_CONVD = 10240;
constexpr int AT_D = 128, AT_HQ = 32, AT_HKV = 8;
constexpr int FFN = 11008, FFN2 = 22016;
constexpr int IN_COLS = 24832, CAT_COLS = IN_COLS + 2 * D_MODEL;
constexpr float LN_EPS = 1e-5f, RMS_EPS = 1e-6f;
constexpr float DN_ALPHA = 1.189207115002721f;
constexpr int MOD_LD = 6 * D_MODEL;

__device__ __forceinline__ float bf2f(unsigned b) { return __uint_as_float(b << 16); }
__device__ __forceinline__ float bflo(unsigned w) { return __uint_as_float(w << 16); }
__device__ __forceinline__ float bfhi(unsigned w) { return __uint_as_float(w & 0xffff0000u); }
__device__ __forceinline__ unsigned pkbf(float lo, float hi) { unsigned r; asm volatile("v_cvt_pk_bf16_f32 %0, %1, %2" : "=v"(r) : "v"(lo), "v"(hi)); return r; }
__device__ __forceinline__ float sigmoidf_(float v) { return __builtin_amdgcn_rcpf(1.0f + __expf(-v)); }
__device__ __forceinline__ float siluf_(float v) { return v * __builtin_amdgcn_rcpf(1.0f + __expf(-v)); }
__device__ __forceinline__ float softplusf_(float v) { return v > 20.f ? v : log1pf(__expf(v)); }
__device__ __forceinline__ float wave_sum(float v) {
#pragma unroll
    for (int o = 1; o < 64; o <<= 1) v += __shfl_xor(v, o);
    return v;
}
__device__ __forceinline__ int lane_id_now() { int l; asm volatile("v_mbcnt_lo_u32_b32 %0, -1, 0\n\tv_mbcnt_hi_u32_b32 %0, -1, %0" : "=v"(l)); return l; }
namespace pg8 {
#define PG8_LAS __attribute__((address_space(3)))
typedef unsigned short bf16_t;
typedef short bf16x8 __attribute__((ext_vector_type(8)));
typedef float f32x4 __attribute__((ext_vector_type(4)));
typedef unsigned u32x4 __attribute__((ext_vector_type(4)));
constexpr int BM = 256, BK = 64, HALF = 128, HTB = HALF * BK * 2  , STAGE_BYTES = 8 * HTB, NXCD = 8, WGM = 8;

__host__ __device__ __forceinline__ int lds_byte(int r, int c) { const int st = (r >> 4) * 2 + (c >> 5), rr = r & 15, cc = c & 31, ob = rr * 64 + cc * 2; return st * 1024 + (ob ^ (((ob >> 9) & 1) << 5)); }
__host__ __device__ __forceinline__ void stage_rc(int b, int& R, int& C) { const int st = b / 1024, sb = b % 1024, swz = sb ^ (((sb >> 9) & 1) << 5); R = (st >> 1) * 16 + swz / 64; C = (st & 1) * 32 + (swz % 64) / 2; }
__host__ __device__ __forceinline__ int perm32(int rho) { const int n = rho >> 4, i = rho & 15; return 8 * (i >> 2) + 4 * n + (i & 3); }

struct Unit { int pm, pn; };
struct Gemm { const bf16_t* A; const bf16_t* Bt; int M, N, K; };

struct StaticOrder {
    int nM, nN, nwg, G, c;
    __host__ __device__ void init(int M, int N, int G_, int c_) { nM = M / BM; nN = N / BM; nwg = nM * nN; G = G_; c = c_; }
    __host__ __device__ bool next(int i, Unit& u) const {
        const long L = (long)i * G + c; if (L >= nwg) return false;
        int wgid = (int)L; { const int q = nwg / NXCD, r = nwg % NXCD, xcd = wgid % NXCD, off = wgid / NXCD; wgid = (xcd < r ? xcd * (q + 1) : r * (q + 1) + (xcd - r) * q) + off; }
        const int nig = WGM * nN, gid = wgid / nig, fm = gid * WGM, gsz = (nM - fm) < WGM ? (nM - fm) : WGM;
        u.pm = fm + ((wgid % nig) % gsz); u.pn = (wgid % nig) / gsz; return true;
    }
    __device__ __forceinline__ void a_ready(const Unit&) const {}
    __device__ __forceinline__ void done(const Unit&) const {}
};

__device__ __forceinline__ unsigned cvt_pk_bf16(float lo, float hi) { unsigned r; asm volatile("v_cvt_pk_bf16_f32 %0, %1, %2" : "=v"(r) : "v"(lo), "v"(hi)); return r; }
typedef float f32x2 __attribute__((ext_vector_type(2)));
__device__ __forceinline__ void st8bf(bf16_t* p, const f32x4& v0, const f32x4& v1) {
    u32x4 w; w.x = cvt_pk_bf16(v0[0], v0[1]); w.y = cvt_pk_bf16(v0[2], v0[3]); w.z = cvt_pk_bf16(v1[0], v1[1]); w.w = cvt_pk_bf16(v1[2], v1[3]);
    *(u32x4*)p = w;
}
__device__ __forceinline__ void ld8bf(const bf16_t* p, f32x4& v0, f32x4& v1) {
    const u32x4 w = *(const u32x4*)p;
    v0 = (f32x4){__uint_as_float(w.x << 16), __uint_as_float(w.x & 0xffff0000u), __uint_as_float(w.y << 16), __uint_as_float(w.y & 0xffff0000u)};
    v1 = (f32x4){__uint_as_float(w.z << 16), __uint_as_float(w.z & 0xffff0000u), __uint_as_float(w.w << 16), __uint_as_float(w.w & 0xffff0000u)};
}
__device__ __forceinline__ float epi_sigmoid(float v) { return __builtin_amdgcn_rcpf(1.0f + __expf(-v)); }
__device__ __forceinline__ float epi_softplus(float v) { return v > 20.f ? v : log1pf(__expf(v)); }

__device__ __forceinline__ float dpp_prev(float v) { return __uint_as_float((unsigned)__builtin_amdgcn_update_dpp(0, (int)__float_as_uint(v), 0x111, 0xF, 0xF, true)); }
__device__ __forceinline__ float dpp_next(float v) { return __uint_as_float((unsigned)__builtin_amdgcn_update_dpp(0, (int)__float_as_uint(v), 0x101, 0xF, 0xF, true)); }
__device__ __forceinline__ f32x4 dpp_prev4(const f32x4& v) { return (f32x4){dpp_prev(v[0]), dpp_prev(v[1]), dpp_prev(v[2]), dpp_prev(v[3])}; }
__device__ __forceinline__ f32x4 dpp_next4(const f32x4& v) { return (f32x4){dpp_next(v[0]), dpp_next(v[1]), dpp_next(v[2]), dpp_next(v[3])}; }
struct EpiIn {
    static constexpr bool PERM = true, AFTER_DRAIN = false, APERM = true;
    bf16_t *z, *xbc, *q, *k, *v, *gates; float* dt; const float* dt_bias; const float* b_gate; const float* cw; const float* cb; float* edge;
    __device__ __forceinline__ void operator()(const f32x4 (&acc)[2][2][4][2], const Unit& u, int wr, int wc, int fr, int fq) const {
        const int pn = u.pn, row0 = u.pm * BM + wr * 128 + fr * 8, cw_ = wc * 32 + 8 * fq;
        if (pn == 72) {
#pragma unroll
            for (int bj = 0; bj < 2; ++bj) { const int col = cw_ + bj * HALF; const f32x4 b0 = *(const f32x4*)(dt_bias + col), b1 = *(const f32x4*)(dt_bias + col + 4);
#pragma unroll
                for (int ai = 0; ai < 2; ++ai)
#pragma unroll
                    for (int m = 0; m < 4; ++m) { f32x4 v0 = acc[ai][bj][m][0] + b0, v1 = acc[ai][bj][m][1] + b1;
#pragma unroll
                        for (int j = 0; j < 4; ++j) { v0[j] = epi_softplus(v0[j]); v1[j] = epi_softplus(v1[j]); }
                        float* p = dt + (size_t)(row0 + ai * 4 + m) * 256 + col; *(f32x4*)p = v0; *(f32x4*)(p + 4) = v1; } }
            return;
        }
        if (pn >= 32 && pn < 72) {
            const int seg = 2 * u.pm + wr;
#pragma unroll
            for (int bj = 0; bj < 2; ++bj)
#pragma unroll
                for (int n = 0; n < 2; ++n) {
                    const int ch = (pn - 32) * 256 + bj * HALF + cw_ + 4 * n;
                    const f32x4 w0 = *(const f32x4*)(cw + ch), w1 = *(const f32x4*)(cw + 10240 + ch), w2 = *(const f32x4*)(cw + 2 * 10240 + ch), bb = *(const f32x4*)(cb + ch);
#pragma unroll
                    for (int kk = 0; kk < 8; ++kk) {
                        const f32x4 um = (kk == 0) ? dpp_prev4(acc[1][bj][3][n]) : acc[(kk - 1) >> 2][bj][(kk - 1) & 3][n], up = (kk == 7) ? dpp_next4(acc[0][bj][0][n]) : acc[(kk + 1) >> 2][bj][(kk + 1) & 3][n];
                        const f32x4 c4 = um * w0 + acc[kk >> 2][bj][kk & 3][n] * w1 + up * w2 + bb;
                        typedef unsigned u32x2_ __attribute__((ext_vector_type(2)));
                        u32x2_ w; w.x = cvt_pk_bf16(c4[0] * epi_sigmoid(c4[0]), c4[1] * epi_sigmoid(c4[1])); w.y = cvt_pk_bf16(c4[2] * epi_sigmoid(c4[2]), c4[3] * epi_sigmoid(c4[3]));
                        *(u32x2_*)(xbc + (size_t)(row0 + kk) * 10240 + ch) = w;
                    }
                    if (fr == 0) { float* ep = edge + ((size_t)seg * 4 + 0) * 10240 + ch; *(f32x4*)ep = acc[0][bj][0][n]; *(f32x4*)(ep + 10240) = acc[0][bj][1][n]; }
                    if (fr == 15) { float* ep = edge + ((size_t)seg * 4 + 2) * 10240 + ch; *(f32x4*)ep = acc[1][bj][2][n]; *(f32x4*)(ep + 10240) = acc[1][bj][3][n]; }
                    asm volatile("" ::: "memory");
                }
            return;
        }
        bf16_t* base; int ldc, colt, mode = 0;
        if (pn < 32) { base = z; ldc = 8192; colt = pn * 256; }
        else if (pn < 89) { base = q; ldc = 4096; colt = (pn - 73) * 256; }
        else if (pn < 93) { base = k; ldc = 1024; colt = (pn - 89) * 256; }
        else if (pn < 97) { base = v; ldc = 1024; colt = (pn - 93) * 256; }
        else { base = gates; ldc = 8192; colt = (pn - 97) * 256; mode = 2; }
        f32x4 bv[2][2];
#pragma unroll
        for (int bj = 0; bj < 2; ++bj)
#pragma unroll
            for (int n = 0; n < 2; ++n) bv[bj][n] = (mode == 2) ? *(const f32x4*)(b_gate + colt + cw_ + bj * HALF + 4 * n) : (f32x4){0.f, 0.f, 0.f, 0.f};
#pragma unroll
        for (int ai = 0; ai < 2; ++ai)
#pragma unroll
            for (int m = 0; m < 4; ++m) { bf16_t* rowp = base + (size_t)(row0 + ai * 4 + m) * ldc + colt + cw_;
#pragma unroll
                for (int bj = 0; bj < 2; ++bj) { f32x4 v0 = acc[ai][bj][m][0] + bv[bj][0], v1 = acc[ai][bj][m][1] + bv[bj][1];
                    st8bf(rowp + bj * HALF, v0, v1); } }
    }
};
struct EpiMix {
    static constexpr bool PERM = true, AFTER_DRAIN = false, APERM = false;
    const bf16_t* gates; bf16_t* pm; int second;
    __device__ __forceinline__ void operator()(const f32x4 (&acc)[2][2][4][2], const Unit& u, int wr, int wc, int fr, int fq) const {
        const int row0 = u.pm * BM + wr * 64 + fr, col0 = u.pn * BM + wc * 32 + 8 * fq;
#pragma unroll
        for (int ai = 0; ai < 2; ++ai)
#pragma unroll
            for (int m = 0; m < 4; ++m) { const size_t row = (size_t)(row0 + ai * HALF + m * 16);
#pragma unroll
                for (int bj = 0; bj < 2; ++bj) { const int col = col0 + bj * HALF; f32x4 g0, g1; ld8bf(gates + row * 8192 + second * 4096 + col, g0, g1);
#pragma unroll
                    for (int j = 0; j < 4; ++j) { g0[j] = epi_sigmoid(g0[j]); g1[j] = epi_sigmoid(g1[j]); }

                    f32x4 v0 = acc[ai][bj][m][0] * g0, v1 = acc[ai][bj][m][1] * g1;
                    if (second) { f32x4 p0, p1; ld8bf(pm + row * 4096 + col, p0, p1); v0 += p0; v1 += p1; }
                    st8bf(pm + row * 4096 + col, v0, v1); } }
    }
};
struct EpiRes {
    static constexpr bool PERM = true, AFTER_DRAIN = false, APERM = false;
    const float* base; float* out; const float* gate; float alpha;
    __device__ __forceinline__ void operator()(const f32x4 (&acc)[2][2][4][2], const Unit& u, int wr, int wc, int fr, int fq) const {
        const int row0 = u.pm * BM + wr * 64 + fr, col0 = u.pn * BM + wc * 32 + 8 * fq;
        const float* g = gate + (size_t)(u.pm >> 4) * 24576;
#pragma unroll
        for (int bj = 0; bj < 2; ++bj) { const int col = col0 + bj * HALF; const f32x4 g0 = *(const f32x4*)(g + col), g1 = *(const f32x4*)(g + col + 4);
#pragma unroll
            for (int ai = 0; ai < 2; ++ai)
#pragma unroll
                for (int m = 0; m < 4; ++m) { const size_t off = (size_t)(row0 + ai * HALF + m * 16) * 4096 + col;
                    const f32x4 x0 = *(const f32x4*)(base + off), x1 = *(const f32x4*)(base + off + 4);
                    *(f32x4*)(out + off) = x0 * alpha + g0 * acc[ai][bj][m][0]; *(f32x4*)(out + off + 4) = x1 * alpha + g1 * acc[ai][bj][m][1]; } }
    }
};
struct EpiConvGate {
    static constexpr bool PERM = true, AFTER_DRAIN = false, APERM = true;
    bf16_t* act; float* edge; const float* cw; const float* cb;
    __device__ __forceinline__ void operator()(const f32x4 (&acc)[2][2][4][2], const Unit& u, int wr, int wc, int fr, int fq) const {
        const int tok0 = u.pm * BM + wr * 128 + fr * 8, seg = 2 * u.pm + wr;
#pragma unroll
        for (int n = 0; n < 2; ++n) {
            const int ch = u.pn * 128 + wc * 32 + 8 * fq + 4 * n;
            const f32x4 wa0 = *(const f32x4*)(cw + ch), wa1 = *(const f32x4*)(cw + 22016 + ch), wa2 = *(const f32x4*)(cw + 2 * 22016 + ch), ba = *(const f32x4*)(cb + ch);
            const f32x4 wb0 = *(const f32x4*)(cw + 11008 + ch), wb1 = *(const f32x4*)(cw + 22016 + 11008 + ch), wb2 = *(const f32x4*)(cw + 2 * 22016 + 11008 + ch), bb = *(const f32x4*)(cb + 11008 + ch);
#pragma unroll
            for (int k = 0; k < 8; ++k) {
                const f32x4 ua_m = (k == 0) ? dpp_prev4(acc[1][0][3][n]) : acc[(k - 1) >> 2][0][(k - 1) & 3][n], ua_p = (k == 7) ? dpp_next4(acc[0][0][0][n]) : acc[(k + 1) >> 2][0][(k + 1) & 3][n];
                const f32x4 ub_m = (k == 0) ? dpp_prev4(acc[1][1][3][n]) : acc[(k - 1) >> 2][1][(k - 1) & 3][n], ub_p = (k == 7) ? dpp_next4(acc[0][1][0][n]) : acc[(k + 1) >> 2][1][(k + 1) & 3][n];
                const f32x4 ca = ua_m * wa0 + acc[k >> 2][0][k & 3][n] * wa1 + ua_p * wa2 + ba;
                const f32x4 cb_ = ub_m * wb0 + acc[k >> 2][1][k & 3][n] * wb1 + ub_p * wb2 + bb;
                f32x4 o;
#pragma unroll
                for (int j = 0; j < 4; ++j) o[j] = ca[j] * epi_sigmoid(ca[j]) * cb_[j];
                typedef unsigned u32x2_ __attribute__((ext_vector_type(2)));
                u32x2_ w; w.x = cvt_pk_bf16(o[0], o[1]); w.y = cvt_pk_bf16(o[2], o[3]);
                *(u32x2_*)(act + (size_t)(tok0 + k) * 11008 + ch) = w;
            }
            const int tc = u.pn * 256 + wc * 32 + 8 * fq + 4 * n;
            if (fr == 0) { float* ep = edge + ((size_t)seg * 4 + 0) * 22016 + tc;
                *(f32x4*)ep = acc[0][0][0][n]; *(f32x4*)(ep + 128) = acc[0][1][0][n]; *(f32x4*)(ep + 22016) = acc[0][0][1][n]; *(f32x4*)(ep + 22016 + 128) = acc[0][1][1][n]; }
            if (fr == 15) { float* ep = edge + ((size_t)seg * 4 + 2) * 22016 + tc;
                *(f32x4*)ep = acc[1][0][2][n]; *(f32x4*)(ep + 128) = acc[1][1][2][n]; *(f32x4*)(ep + 22016) = acc[1][0][3][n]; *(f32x4*)(ep + 22016 + 128) = acc[1][1][3][n]; }
            asm volatile("" ::: "memory");
        }
    }
};
struct EpiResLn {
    static constexpr bool PERM = true, AFTER_DRAIN = false, APERM = false;
    const float* r1; const float* stats; const float* ln_g; const float* ln_b; float* out; const float* gate; float alpha;
    __device__ __forceinline__ void operator()(const f32x4 (&acc)[2][2][4][2], const Unit& u, int wr, int wc, int fr, int fq) const {
        typedef float f2_ __attribute__((ext_vector_type(2)));
        const int row0 = u.pm * BM + wr * 64 + fr, col0 = u.pn * BM + wc * 32 + 8 * fq;
        const float* g = gate + (size_t)(u.pm >> 4) * 24576;
#pragma unroll
        for (int bj = 0; bj < 2; ++bj) { const int col = col0 + bj * HALF; const f32x4 g0 = *(const f32x4*)(g + col), g1 = *(const f32x4*)(g + col + 4);
            const f32x4 a0 = *(const f32x4*)(ln_g + col) * alpha, a1 = *(const f32x4*)(ln_g + col + 4) * alpha, b0 = *(const f32x4*)(ln_b + col) * alpha, b1 = *(const f32x4*)(ln_b + col + 4) * alpha;
#pragma unroll
            for (int ai = 0; ai < 2; ++ai)
#pragma unroll
                for (int m = 0; m < 4; ++m) { const size_t row = (size_t)(row0 + ai * HALF + m * 16), off = row * 4096 + col; const f2_ st = *(const f2_*)(stats + 2 * row); const float mean = st.x, rstd = st.y;
                    const f32x4 x0 = (*(const f32x4*)(r1 + off) - mean) * rstd, x1 = (*(const f32x4*)(r1 + off + 4) - mean) * rstd;
                    *(f32x4*)(out + off) = x0 * a0 + b0 + g0 * acc[ai][bj][m][0]; *(f32x4*)(out + off + 4) = x1 * a1 + b1 + g1 * acc[ai][bj][m][1]; } }
    }
};
template <class Epi, class Sched, bool ALIGN_EPI = false, bool SP2 = false>
__device__ __forceinline__ void gemm_phase(PG8_LAS unsigned char* lds, const Gemm g, const Sched& S, const Epi& E, int tid_in) {
    int tid_l = tid_in; asm volatile("" : "+v"(tid_l));
    const int tid = tid_l, wid = __builtin_amdgcn_readfirstlane(tid >> 6), lane = tid & 63, wr = wid >> 2, wc = wid & 3, fr = lane & 15, fq = lane >> 4;
    const int K = g.K, nt = K / BK;
    unsigned voffA[2], voffB[2];
#pragma unroll
    for (int i = 0; i < 2; ++i) { int R, C; stage_rc(tid * 16 + i * 8192, R, C); const int Rb = Epi::PERM ? ((R & ~31) + perm32(R & 31)) : R;
        const int Ra = Epi::APERM ? (128 * (R >> 6) + 8 * (R & 15) + ((R >> 4) & 3)) : R;
        voffA[i] = (unsigned)(Ra * K + C) * 2u; voffB[i] = (unsigned)(Rb * K + C) * 2u; }
    const size_t kstep = (size_t)(BK * 2);
    const size_t hstep = (size_t)HALF * K * 2;
    const size_t tstep = 2 * hstep;
    const size_t hstepA = Epi::APERM ? (size_t)4 * K * 2 : hstep;
    const unsigned ldsw = (unsigned)wid * 1024u;
    const int aoff = lds_byte(wr * 64 + fr, fq * 8), boff = lds_byte(wc * 32 + fr, fq * 8);
#define PG8_SA(b, h) (((b) * 2 + (h)) * HTB)
#define PG8_SB(b, h) ((4 + (b) * 2 + (h)) * HTB)
#define PG8_STAGE(bufoff, gbase, voff) do { _Pragma("unroll") for (int _i = 0; _i < 2; ++_i) \
        __builtin_amdgcn_global_load_lds((const unsigned*)((const char*)(gbase) + (voff)[_i]), (PG8_LAS unsigned*)(lds + (bufoff) + ldsw + _i * 8192), 16, 0, 0); } while (0)
#define PG8_LDA(dst, b, h) do { _Pragma("unroll") for (int m = 0; m < 4; ++m) _Pragma("unroll") for (int k = 0; k < 2; ++k) dst[m][k] = *(const PG8_LAS bf16x8*)(lds + PG8_SA(b, h) + aoff + m * 2048 + k * 1024); } while (0)
#define PG8_LDB(dst, b, h) do { _Pragma("unroll") for (int n = 0; n < 2; ++n) _Pragma("unroll") for (int k = 0; k < 2; ++k) dst[n][k] = *(const PG8_LAS bf16x8*)(lds + PG8_SB(b, h) + boff + n * 2048 + k * 1024); } while (0)
#define PG8_MMA(ai, bj, At, Bt) do { __builtin_amdgcn_s_setprio(1); _Pragma("unroll") for (int m = 0; m < 4; ++m) _Pragma("unroll") for (int n = 0; n < 2; ++n) _Pragma("unroll") for (int k = 0; k < 2; ++k) \
        acc[ai][bj][m][n] = __builtin_amdgcn_mfma_f32_16x16x32_bf16(Bt[n][k], At[m][k], acc[ai][bj][m][n], 0, 0, 0); __builtin_amdgcn_s_setprio(0); } while (0)
#define PG8_WAIT_V(n) asm volatile("s_waitcnt vmcnt(" #n ")" ::: "memory")
#define PG8_WAIT_L(n) asm volatile("s_waitcnt lgkmcnt(" #n ")" ::: "memory")
#define PG8_BAR __builtin_amdgcn_s_barrier()
#define PG8_SCHED __builtin_amdgcn_sched_barrier(0)
    Unit cur, nxt; int ui = 0;
    if (!S.next(0, cur)) return;
    f32x4 acc[2][2][4][2];
#pragma unroll
    for (int a = 0; a < 2; ++a)
#pragma unroll
        for (int b = 0; b < 2; ++b)
#pragma unroll
            for (int m = 0; m < 4; ++m)
#pragma unroll
                for (int n = 0; n < 2; ++n) acc[a][b][m][n] = (f32x4){0.f, 0.f, 0.f, 0.f};
    bf16x8 At[4][2], B0[2][2], B1[2][2];
    const char* cA = (const char*)g.A + (size_t)cur.pm * tstep; const char* cB = (const char*)g.Bt + (size_t)cur.pn * tstep;
    S.a_ready(cur);
    if constexpr (SP2) {
        PG8_STAGE(PG8_SB(0, 0), cB, voffB); PG8_STAGE(PG8_SB(0, 1), cB + hstep, voffB); PG8_STAGE(PG8_SA(0, 0), cA, voffA); PG8_STAGE(PG8_SA(0, 1), cA + hstepA, voffA);
        if (wr == 1) PG8_BAR;
        PG8_WAIT_V(2); PG8_BAR;
        PG8_STAGE(PG8_SB(1, 0), cB + kstep, voffB); PG8_STAGE(PG8_SA(1, 0), cA + kstep, voffA); PG8_STAGE(PG8_SB(1, 1), cB + hstep + kstep, voffB);
        PG8_WAIT_V(6); PG8_BAR;
    } else {
        PG8_STAGE(PG8_SB(0, 0), cB, voffB); PG8_STAGE(PG8_SA(0, 0), cA, voffA); PG8_STAGE(PG8_SB(0, 1), cB + hstep, voffB); PG8_STAGE(PG8_SA(0, 1), cA + hstepA, voffA);
        if (wr == 1) PG8_BAR;
        PG8_WAIT_V(4); PG8_BAR;
        PG8_STAGE(PG8_SB(1, 0), cB + kstep, voffB); PG8_STAGE(PG8_SA(1, 0), cA + kstep, voffA); PG8_STAGE(PG8_SB(1, 1), cB + hstep + kstep, voffB);
        PG8_WAIT_V(6); PG8_BAR;
    }
    for (;;) {
        const bool has_next = S.next(ui + 1, nxt);
        const char* nA = has_next ? (const char*)g.A + (size_t)nxt.pm * tstep : cA; const char* nB = has_next ? (const char*)g.Bt + (size_t)nxt.pn * tstep : cB;
        for (int t = 0; t < nt; t += 2) {
            const bool last = (t == nt - 2);
            const char* a1 = cA + (size_t)(t + 1) * kstep;
            const char* a2 = last ? nA : cA + (size_t)(t + 2) * kstep; const char* b2 = last ? nB : cB + (size_t)(t + 2) * kstep;
            const char* a3 = a2 + kstep; const char* b3 = b2 + kstep;
            if (last && has_next) S.a_ready(nxt);
            if constexpr (SP2) {
            PG8_LDB(B0, 0, 0); PG8_LDB(B1, 0, 1); PG8_SCHED; PG8_LDA(At, 0, 0); PG8_STAGE(PG8_SA(1, 1), a1 + hstepA, voffA);
            PG8_WAIT_V(8); PG8_WAIT_L(0); PG8_BAR; PG8_MMA(0, 0, At, B0); PG8_MMA(0, 1, At, B1); PG8_BAR; PG8_SCHED;
            PG8_LDA(At, 0, 1); PG8_STAGE(PG8_SB(0, 0), b2, voffB); PG8_STAGE(PG8_SB(0, 1), b2 + hstep, voffB); PG8_STAGE(PG8_SA(0, 0), a2, voffA);
            PG8_WAIT_V(8); PG8_WAIT_L(0); PG8_BAR; PG8_MMA(1, 0, At, B0); PG8_MMA(1, 1, At, B1); PG8_BAR; PG8_SCHED;
            PG8_LDB(B0, 1, 0); PG8_LDB(B1, 1, 1); PG8_SCHED; PG8_LDA(At, 1, 0); PG8_STAGE(PG8_SA(0, 1), a2 + hstepA, voffA);
            PG8_WAIT_V(8); PG8_WAIT_L(0); PG8_BAR; PG8_MMA(0, 0, At, B0); PG8_MMA(0, 1, At, B1); PG8_BAR; PG8_SCHED;
            PG8_LDA(At, 1, 1); PG8_STAGE(PG8_SB(1, 0), b3, voffB); PG8_STAGE(PG8_SB(1, 1), b3 + hstep, voffB); PG8_STAGE(PG8_SA(1, 0), a3, voffA);
            PG8_WAIT_V(8); PG8_WAIT_L(0); PG8_BAR; PG8_MMA(1, 0, At, B0); PG8_MMA(1, 1, At, B1); PG8_BAR; PG8_SCHED;
            } else {
            PG8_LDB(B0, 0, 0); PG8_SCHED; PG8_LDA(At, 0, 0); PG8_STAGE(PG8_SA(1, 1), a1 + hstepA, voffA);
            PG8_WAIT_L(8); PG8_BAR; PG8_WAIT_L(0); PG8_MMA(0, 0, At, B0); PG8_BAR; PG8_SCHED;
            PG8_LDB(B1, 0, 1); PG8_STAGE(PG8_SB(0, 0), b2, voffB);
            PG8_BAR; PG8_WAIT_L(0); PG8_MMA(0, 1, At, B1); PG8_BAR;
            PG8_LDA(At, 0, 1); PG8_STAGE(PG8_SA(0, 0), a2, voffA);
            PG8_BAR; PG8_WAIT_L(0); PG8_MMA(1, 0, At, B0); PG8_BAR; PG8_SCHED;
            PG8_STAGE(PG8_SB(0, 1), b2 + hstep, voffB);
            PG8_WAIT_V(6); PG8_BAR; PG8_MMA(1, 1, At, B1); PG8_BAR;
            PG8_LDB(B0, 1, 0); PG8_SCHED; PG8_LDA(At, 1, 0); PG8_STAGE(PG8_SA(0, 1), a2 + hstepA, voffA);
            PG8_WAIT_L(8); PG8_BAR; PG8_WAIT_L(0); PG8_MMA(0, 0, At, B0); PG8_BAR; PG8_SCHED;
            PG8_LDB(B1, 1, 1); PG8_STAGE(PG8_SB(1, 0), b3, voffB);
            PG8_BAR; PG8_WAIT_L(0); PG8_MMA(0, 1, At, B1); PG8_BAR;
            PG8_LDA(At, 1, 1); PG8_STAGE(PG8_SA(1, 0), a3, voffA);
            PG8_BAR; PG8_WAIT_L(0); PG8_MMA(1, 0, At, B0); PG8_BAR; PG8_SCHED;
            PG8_STAGE(PG8_SB(1, 1), b3 + hstep, voffB);
            PG8_WAIT_V(6); PG8_BAR; PG8_MMA(1, 1, At, B1); PG8_BAR;
            }
        }
        if constexpr (ALIGN_EPI) { if (wr == 0) PG8_BAR; }
        if constexpr (!Epi::AFTER_DRAIN) { E(acc, cur, wr, wc, fr, fq); S.done(cur); }
        if (!has_next) break;
#pragma unroll
        for (int a = 0; a < 2; ++a)
#pragma unroll
            for (int b = 0; b < 2; ++b)
#pragma unroll
                for (int m = 0; m < 4; ++m)
#pragma unroll
                    for (int n = 0; n < 2; ++n) acc[a][b][m][n] = (f32x4){0.f, 0.f, 0.f, 0.f};
        cur = nxt; cA = nA; cB = nB; ++ui;
        if constexpr (ALIGN_EPI) { if (wr == 1) PG8_BAR; }
    }
    PG8_WAIT_V(0);
    if constexpr (!ALIGN_EPI) { if (wr == 0) PG8_BAR; }
    PG8_BAR;
    if constexpr (Epi::AFTER_DRAIN) { E.fused(acc, cur, wr, wc, fr, fq, lds, wid, lane); S.done(cur); }
#undef PG8_SA
#undef PG8_SB
#undef PG8_STAGE
#undef PG8_LDA
#undef PG8_LDB
#undef PG8_MMA
#undef PG8_WAIT_V
#undef PG8_WAIT_L
#undef PG8_BAR
#undef PG8_SCHED
}
}
namespace attn {
constexpr int D = 128, NW = 8, QBLK = 32, KVBLK = 64;
constexpr float SCALE = 0.088388347648318440f;
constexpr float THR = 8.f;
constexpr int SDEPTH = 2;
constexpr int LDQ = AT_HQ * D, LDK = AT_HKV * D, LDO = LDQ;
constexpr size_t SHM_V = KVBLK * D * 2, SHM_K = KVBLK * D * 2, SHM_ATTN = 2 * SHM_V + 2 * SHM_K + NW * 64 * 4;
using bf16x8 = __attribute__((ext_vector_type(8))) short;
using s16x4  = __attribute__((ext_vector_type(4))) short;
using f32x16 = __attribute__((ext_vector_type(16))) float;
using u32x4  = __attribute__((ext_vector_type(4))) unsigned;
#define KSWZ(row, colB) ((row) * 256 + ((colB) ^ (((row) & 7) << 4)))
#define SBAR() __builtin_amdgcn_sched_barrier(0)
__device__ __forceinline__ int crow(int r, int hi) { return (r & 3) + 8 * (r >> 2) + 4 * hi; }
__device__ __forceinline__ unsigned cvtpk(float lo, float hi) { unsigned r; asm volatile("v_cvt_pk_bf16_f32 %0, %1, %2" : "=v"(r) : "v"(lo), "v"(hi)); return r; }
__device__ __forceinline__ bf16x8 ld8(const bf16* p) { return *reinterpret_cast<const bf16x8*>(p); }

__device__ __forceinline__ void partialSM(f32x16& p0, f32x16& p1, float& m_reg, float& mn, float& alpha) {
  constexpr float C = SCALE * 1.4426950408889634f;
  float pmax = p0[0];
#pragma unroll
  for (int r = 1; r < 16; ++r) pmax = fmaxf(pmax, p0[r]);
#pragma unroll
  for (int r = 0; r < 16; ++r) pmax = fmaxf(pmax, p1[r]);
  { auto rr = __builtin_amdgcn_permlane32_swap(__float_as_uint(pmax), __float_as_uint(pmax), false, false);
    pmax = fmaxf(__uint_as_float(rr[0]), __uint_as_float(rr[1])); }
  if (__builtin_expect(__all(pmax - m_reg <= THR / SCALE), 1)) { mn = m_reg; alpha = 1.f; }
  else { mn = fmaxf(m_reg, pmax); alpha = __builtin_amdgcn_exp2f((m_reg - mn) * C); m_reg = mn; }
  float mnC = -mn * C;
#pragma unroll
  for (int r = 0; r < 16; ++r) p0[r] = fmaf(p0[r], C, mnC);
#pragma unroll
  for (int r = 0; r < 16; ++r) p1[r] = fmaf(p1[r], C, mnC);
#pragma unroll
  for (int r = 0; r < 16; ++r) p0[r] = __builtin_amdgcn_exp2f(p0[r]);
}
__device__ __forceinline__ void finishSM(f32x16& p0, f32x16& p1, float alpha, float& l_reg, bf16x8& pa0, bf16x8& pa1, bf16x8& pa2, bf16x8& pa3) {
#pragma unroll
  for (int r = 0; r < 16; ++r) p1[r] = __builtin_amdgcn_exp2f(p1[r]);
  float ps = 0;
#pragma unroll
  for (int r = 0; r < 16; ++r) ps += p0[r];
#pragma unroll
  for (int r = 0; r < 16; ++r) ps += p1[r];
  { auto rr = __builtin_amdgcn_permlane32_swap(__float_as_uint(ps), __float_as_uint(ps), false, false);
    ps = __uint_as_float(rr[0]) + __uint_as_float(rr[1]); }
  l_reg = l_reg * alpha + ps;
#define PK4(P, BASE, OUT) do { unsigned a0 = cvtpk(P[BASE + 0], P[BASE + 1]), a1 = cvtpk(P[BASE + 2], P[BASE + 3]);   \
    unsigned b0 = cvtpk(P[BASE + 4], P[BASE + 5]), b1 = cvtpk(P[BASE + 6], P[BASE + 7]);                              \
    auto r0 = __builtin_amdgcn_permlane32_swap(a0, b0, false, false); auto r1 = __builtin_amdgcn_permlane32_swap(a1, b1, false, false); \
    u32x4 w = {r0[0], r1[0], r0[1], r1[1]}; OUT = *reinterpret_cast<bf16x8*>(&w); } while (0)
  PK4(p0, 0, pa0); PK4(p0, 8, pa1); PK4(p1, 0, pa2); PK4(p1, 8, pa3);
#undef PK4
}
__device__ __forceinline__ void qkt(f32x16& p0, f32x16& p1, const bf16* Ks, const bf16x8* qr, int r32, int hi) {
  p0 = f32x16{}; p1 = f32x16{};
#pragma unroll
  for (int d0 = 0; d0 < 8; ++d0) { int cb = (d0 * 16 + hi * 8) * 2;
    bf16x8 b0 = *reinterpret_cast<const bf16x8*>((const char*)Ks + KSWZ(r32, cb));
    bf16x8 b1 = *reinterpret_cast<const bf16x8*>((const char*)Ks + KSWZ(32 + r32, cb));
    p0 = __builtin_amdgcn_mfma_f32_32x32x16_bf16(b0, qr[d0], p0, 0, 0, 0);
    p1 = __builtin_amdgcn_mfma_f32_32x32x16_bf16(b1, qr[d0], p1, 0, 0, 0); }
}
__device__ __forceinline__ int v_st(int k, int c) { const int kk = (k & ~0xC) | ((k & 4) << 1) | ((k & 8) >> 1); return ((kk >> 3) * 4 + (c >> 5)) * 512 + ((kk & 7) * 32 + (c & 31)) * 2; }
__device__ __forceinline__ int v_rd_base(int lane) { return ((lane & 3) << 3) | (((lane >> 2) & 3) << 6) | (((lane >> 4) & 1) << 5) | (((lane >> 5) & 1) << 8); }
constexpr int v_rd_off(int d0, int ks, int half) { return d0 * 512 + ks * 4096 + half * 2048; }
template <int OFF> __device__ __forceinline__ s16x4 tr_read(int vb) {
  s16x4 r; asm volatile("ds_read_b64_tr_b16 %0, %1 offset:%2" : "=&v"(r) : "v"(vb), "i"(OFF) : "memory"); return r;
}
#define PV_READ(D0, F) do { F[0] = tr_read<v_rd_off(D0, 0, 0)>(vb); F[1] = tr_read<v_rd_off(D0, 0, 1)>(vb); F[2] = tr_read<v_rd_off(D0, 1, 0)>(vb); F[3] = tr_read<v_rd_off(D0, 1, 1)>(vb); \
                            F[4] = tr_read<v_rd_off(D0, 2, 0)>(vb); F[5] = tr_read<v_rd_off(D0, 2, 1)>(vb); F[6] = tr_read<v_rd_off(D0, 3, 0)>(vb); F[7] = tr_read<v_rd_off(D0, 3, 1)>(vb); } while (0)
#define PV_PK(L, H) (bf16x8){L[0], L[1], L[2], L[3], H[0], H[1], H[2], H[3]}
#define PV_MMA(od, F) do { od = __builtin_amdgcn_mfma_f32_32x32x16_bf16(pa0, PV_PK(F[0], F[1]), od, 0, 0, 0); od = __builtin_amdgcn_mfma_f32_32x32x16_bf16(pa1, PV_PK(F[2], F[3]), od, 0, 0, 0); \
                            od = __builtin_amdgcn_mfma_f32_32x32x16_bf16(pa2, PV_PK(F[4], F[5]), od, 0, 0, 0); od = __builtin_amdgcn_mfma_f32_32x32x16_bf16(pa3, PV_PK(F[6], F[7]), od, 0, 0, 0); } while (0)
__device__ __forceinline__ void pv_d0(f32x16* o, int vb, bf16x8 pa0, bf16x8 pa1, bf16x8 pa2, bf16x8 pa3) {
  s16x4 fa[8], fb[8];
  PV_READ(0, fa);
  PV_READ(1, fb); asm volatile("s_waitcnt lgkmcnt(8)" ::: "memory"); SBAR(); PV_MMA(o[0], fa);
  PV_READ(2, fa); asm volatile("s_waitcnt lgkmcnt(8)" ::: "memory"); SBAR(); PV_MMA(o[1], fb);
  PV_READ(3, fb); asm volatile("s_waitcnt lgkmcnt(8)" ::: "memory"); SBAR(); PV_MMA(o[2], fa);
  asm volatile("s_waitcnt lgkmcnt(0)" ::: "memory"); SBAR(); PV_MMA(o[3], fb);
}
#undef PV_READ
#undef PV_PK
#undef PV_MMA

struct AttnPre { bf16x8 qr[8]; bf16x8 vs0[2], vs1[2], ks0[2], ks1[2]; };
__device__ __forceinline__ void attn_prime(AttnPre& P, const bf16* Qb, const bf16* __restrict__ Kh, const bf16* __restrict__ Vh, int tid_in) {
  const int tid = tid_in, wid = __builtin_amdgcn_readfirstlane(tid >> 6), lane = tid & 63, r32 = lane & 31, hi = lane >> 5;
  const int sr = tid >> 4, sc = (tid & 15) * 8;
#pragma unroll
  for (int i = 0; i < 2; ++i) { P.vs0[i] = ld8(&Vh[(long)(i * KVBLK + sr) * LDK + sc]); P.vs1[i] = ld8(&Vh[(long)(i * KVBLK + 32 + sr) * LDK + sc]);
    P.ks0[i] = ld8(&Kh[(long)(i * KVBLK + sr) * LDK + sc]); P.ks1[i] = ld8(&Kh[(long)(i * KVBLK + 32 + sr) * LDK + sc]); }
  const bf16* Qw = Qb + (long)(wid * QBLK + r32) * LDQ + hi * 8;
#pragma unroll
  for (int d0 = 0; d0 < 8; ++d0) P.qr[d0] = ld8(Qw + d0 * 16);
}
__device__ __forceinline__ void attn_dense_body(AttnPre& P, const bf16* __restrict__ Kh, const bf16* __restrict__ Vh, bf16* Ob, int seq, char* lds, const float* qnw, const float* rtab, int t0, int tid_in,
                                                const bf16* Qn, const bf16* __restrict__ Kn, const bf16* __restrict__ Vn, bool has_next) {
  const int tid = tid_in, wid = __builtin_amdgcn_readfirstlane(tid >> 6), lane = tid & 63, r32 = lane & 31, hi = lane >> 5;
  bf16* V_lds = (bf16*)lds; bf16* K_lds = (bf16*)(lds + 2 * SHM_V);
  float* ws = (float*)(lds + 2 * SHM_V + 2 * SHM_K) + wid * 64; float* li_l = ws; float* al_l = ws + 32;
  float m_reg = -1e30f, l_reg = 0; f32x16 o[4] = {}; bf16x8 (&qr)[8] = P.qr;
  {
    float ss = 0.f;
#pragma unroll
    for (int d0 = 0; d0 < 8; ++d0) { const u32x4 w = __builtin_bit_cast(u32x4, qr[d0]);
#pragma unroll
      for (int c = 0; c < 4; ++c) { const float lo = __uint_as_float(w[c] << 16), hi_ = __uint_as_float(w[c] & 0xffff0000u); ss += lo * lo + hi_ * hi_; } }
    ss += __shfl_xor(ss, 32);
    const float rn = 1.0f / sqrtf(ss * (1.f / 128.f) + RMS_EPS);
    const int tq = t0 + wid * QBLK + r32;
    v4f tv[2][2][4], wv[2][2][4];
#pragma unroll
    for (int hf = 0; hf < 2; ++hf) {
      const int pos = hf ? (tq & (GRID_W - 1)) : (tq / GRID_W);
#pragma unroll
      for (int dl = 0; dl < 2; ++dl) {
        const int d1 = 4 * hf + dl, d2 = d1 + 2;
        const float* tp = rtab + (size_t)(pos * 32 + 16 * dl + 8 * hi) * 2;
#pragma unroll
        for (int q4 = 0; q4 < 4; ++q4) tv[hf][dl][q4] = *(const v4f*)(tp + 4 * q4);
        wv[hf][dl][0] = *(const v4f*)(qnw + d1 * 16 + hi * 8); wv[hf][dl][1] = *(const v4f*)(qnw + d1 * 16 + hi * 8 + 4);
        wv[hf][dl][2] = *(const v4f*)(qnw + d2 * 16 + hi * 8); wv[hf][dl][3] = *(const v4f*)(qnw + d2 * 16 + hi * 8 + 4);
      } }
#pragma unroll
    for (int hf = 0; hf < 2; ++hf)
#pragma unroll
      for (int dl = 0; dl < 2; ++dl) {
        const int d1 = 4 * hf + dl, d2 = d1 + 2;
        const u32x4 w1 = __builtin_bit_cast(u32x4, qr[d1]), w2 = __builtin_bit_cast(u32x4, qr[d2]);
        u32x4 o1, o2;
#pragma unroll
        for (int c = 0; c < 4; ++c) {
          const v4f t = tv[hf][dl][c]; const v4f n1 = wv[hf][dl][c >> 1], n2 = wv[hf][dl][2 + (c >> 1)];
          const float a0 = __uint_as_float(w1[c] << 16) * rn * n1[2 * (c & 1)], a1 = __uint_as_float(w1[c] & 0xffff0000u) * rn * n1[2 * (c & 1) + 1];
          const float b0 = __uint_as_float(w2[c] << 16) * rn * n2[2 * (c & 1)], b1 = __uint_as_float(w2[c] & 0xffff0000u) * rn * n2[2 * (c & 1) + 1];
          o1[c] = cvtpk(a0 * t.x - b0 * t.y, a1 * t.z - b1 * t.w);
          o2[c] = cvtpk(b0 * t.x + a0 * t.y, b1 * t.z + a1 * t.w); }
        qr[d1] = __builtin_bit_cast(bf16x8, o1); qr[d2] = __builtin_bit_cast(bf16x8, o2);
      } }
  const int sr = tid >> 4, sc = (tid & 15) * 8, vst0 = v_st(sr, sc), vst1 = v_st(32 + sr, sc);
  const int vb0 = (int)(uintptr_t)V_lds + v_rd_base(lane);
#define SLOADP(i, Kp, Vp, k0) do { P.vs0[i] = ld8(&(Vp)[(long)((k0) + sr) * LDK + sc]); P.vs1[i] = ld8(&(Vp)[(long)((k0) + 32 + sr) * LDK + sc]); \
    P.ks0[i] = ld8(&(Kp)[(long)((k0) + sr) * LDK + sc]); P.ks1[i] = ld8(&(Kp)[(long)((k0) + 32 + sr) * LDK + sc]); } while (0)
#define SLOAD(i, k0) SLOADP(i, Kh, Vh, k0)
#define SWRITE(b, i) do { *(bf16x8*)((char*)V_lds + (b) * SHM_V + vst0) = P.vs0[i];          \
    *(bf16x8*)((char*)V_lds + (b) * SHM_V + vst1) = P.vs1[i]; int kc = sc * 2;               \
    *(bf16x8*)((char*)K_lds + (b) * SHM_K + KSWZ(sr, kc)) = P.ks0[i];                       \
    *(bf16x8*)((char*)K_lds + (b) * SHM_K + KSWZ(32 + sr, kc)) = P.ks1[i]; } while (0)
#define SWAIT() do { asm volatile("s_waitcnt vmcnt(4)" ::: "memory"); } while (0)
#define RESC(a) do { if (__any((a) < 1.f)) { if (hi == 0) al_l[r32] = (a); asm volatile("s_waitcnt lgkmcnt(0)" ::: "memory"); \
    _Pragma("unroll") for (int d = 0; d < 4; ++d) _Pragma("unroll") for (int r = 0; r < 16; ++r) o[d][r] *= al_l[crow(r, hi)]; } } while (0)
  f32x16 pA0, pA1, pB0, pB1; float mnA, mnB, alA, alB; bf16x8 pa0, pa1, pa2, pa3; const int NT = seq / KVBLK;
  constexpr int SE = 0, SO = SDEPTH - 1;
  __syncthreads();
  SWRITE(0, SE); __syncthreads();
  qkt(pA0, pA1, K_lds, qr, r32, hi); partialSM(pA0, pA1, m_reg, mnA, alA);
  if (2 < NT) SLOAD(SE, 2 * KVBLK);
  SWAIT(); SWRITE(1, SO); __syncthreads();
  for (int j = 1; j + 1 < NT; j += 2) {
    SBAR(); qkt(pB0, pB1, (bf16*)((char*)K_lds + SHM_K), qr, r32, hi);
    finishSM(pA0, pA1, alA, l_reg, pa0, pa1, pa2, pa3); SBAR();
    SLOAD(SO, (j + SDEPTH) * KVBLK); SBAR();
    pv_d0(o, vb0, pa0, pa1, pa2, pa3); partialSM(pB0, pB1, m_reg, mnB, alB);
    __syncthreads(); SWAIT(); SWRITE(0, SE);
    RESC(alB); __syncthreads();
    SBAR(); qkt(pA0, pA1, K_lds, qr, r32, hi);
    finishSM(pB0, pB1, alB, l_reg, pa0, pa1, pa2, pa3); SBAR();
    if (j + 3 < NT) SLOAD(SE, (j + 1 + SDEPTH) * KVBLK); SBAR();
    pv_d0(o, vb0 + (int)SHM_V, pa0, pa1, pa2, pa3); partialSM(pA0, pA1, m_reg, mnA, alA);
    __syncthreads(); SWAIT(); SWRITE(1, SO);
    RESC(alA); __syncthreads();
  }
  if (has_next) {
    const int t2 = (wid << 6) | lane_id_now(), sr2 = t2 >> 4, sc2 = (t2 & 15) * 8; const unsigned o2 = (unsigned)(sr2 * LDK + sc2) * 2u;
#pragma unroll
    for (int i = 0; i < 2; ++i) { const char* vp = (const char*)Vn + (size_t)(i * KVBLK * LDK * 2); const char* kp = (const char*)Kn + (size_t)(i * KVBLK * LDK * 2);
      P.vs0[i] = *(const bf16x8*)(vp + o2); P.vs1[i] = *(const bf16x8*)(vp + o2 + 32 * LDK * 2); P.ks0[i] = *(const bf16x8*)(kp + o2); P.ks1[i] = *(const bf16x8*)(kp + o2 + 32 * LDK * 2); } }
  SBAR(); qkt(pB0, pB1, (bf16*)((char*)K_lds + SHM_K), qr, r32, hi);
  finishSM(pA0, pA1, alA, l_reg, pa0, pa1, pa2, pa3); SBAR();
  if (has_next) { const int l2 = lane_id_now(); const unsigned qo2 = (unsigned)((wid * QBLK + (l2 & 31)) * LDQ + (l2 >> 5) * 8) * 2u;
#pragma unroll
    for (int d0 = 0; d0 < 8; ++d0) qr[d0] = *(const bf16x8*)((const char*)Qn + qo2 + d0 * 32); }
  SBAR();
  pv_d0(o, vb0, pa0, pa1, pa2, pa3); partialSM(pB0, pB1, m_reg, mnB, alB);
  __syncthreads(); RESC(alB);
  finishSM(pB0, pB1, alB, l_reg, pa0, pa1, pa2, pa3); SBAR();
  pv_d0(o, vb0 + (int)SHM_V, pa0, pa1, pa2, pa3);
  if (hi == 0) li_l[r32] = l_reg; asm volatile("s_waitcnt lgkmcnt(0)" ::: "memory");
  float rli[16];
#pragma unroll
  for (int r = 0; r < 16; ++r) rli[r] = __builtin_amdgcn_rcpf(li_l[crow(r, hi)]);
  bf16* Ow = Ob + (long)(wid * QBLK) * LDO;
#pragma unroll
  for (int r = 0; r < 16; ++r) { int orow = crow(r, hi);
#pragma unroll
    for (int d0 = 0; d0 < 4; ++d0) Ow[(long)orow * LDO + d0 * 32 + r32] = (bf16)(cvtpk(o[d0][r] * rli[r], 0.f) & 0xffffu); }
#undef SLOAD
#undef SLOADP
#undef SWRITE
#undef SWAIT
#undef RESC
}
#undef KSWZ
#undef SBAR
}
constexpr int NWAVES = 8;
constexpr size_t MiB = 1u << 20;
constexpr size_t WS_CTL = 0, CTL_ZERO_BYTES = 1 * MiB;
constexpr size_t WS_MOD = 512 * 1024;
constexpr size_t WS_WCAT = 1 * MiB;
constexpr size_t WS_H = 259 * MiB;
constexpr size_t WS_WSSM = 387 * MiB;
constexpr size_t WS_WATT = 451 * MiB;
constexpr size_t WS_WOUT = 483 * MiB;
constexpr size_t WS_WUP = 515 * MiB;
constexpr size_t WS_WDN = 687 * MiB;
constexpr size_t WS_Z = 773 * MiB;
constexpr size_t WS_XBCC = 1029 * MiB;
constexpr size_t WS_DT = 1349 * MiB;
constexpr size_t WS_Q = 1365 * MiB;
constexpr size_t WS_K = 1493 * MiB;
constexpr size_t WS_V = 1525 * MiB;
constexpr size_t WS_GATES = 1557 * MiB;
constexpr size_t WS_PART = WS_Z;
constexpr size_t WS_EDGE1 = 687 * MiB;
constexpr size_t WS_YB = 1 * MiB;
constexpr size_t WS_PM = WS_XBCC;
constexpr size_t WS_R1 = 1 * MiB;
constexpr size_t WS_ST1 = WS_Z;
constexpr size_t WS_H2 = WS_XBCC;
constexpr size_t WS_EDGE = 1157 * MiB;
constexpr size_t WS_ACT = 1202 * MiB;
constexpr size_t WS_END = 1557 * MiB + 256 * MiB;

constexpr int LDS_BYTES = 147456;
constexpr int LDS_ZERO_OFF = 143360, MISC_OFF = LDS_ZERO_OFF + 320;

typedef GAS unsigned gu32;
#define RLX_AGENT __ATOMIC_RELAXED, __HIP_MEMORY_SCOPE_AGENT
#define LDS_WAIT() asm volatile("s_waitcnt lgkmcnt(0)" ::: "memory")
#define VM_WAIT() asm volatile("s_waitcnt vmcnt(0)" ::: "memory")
namespace ssd {
using bf16x8 = __attribute__((ext_vector_type(8))) short;
using s16x4  = __attribute__((ext_vector_type(4))) short;
using f32x16 = __attribute__((ext_vector_type(16))) float;
typedef float f2 __attribute__((ext_vector_type(2)));
constexpr int B_OFF = 0, C_OFF = 32768, XX_OFF = 65536, H_OFF = 98304, TBL_OFF = 114688, TBL_BYTES = 2048, MX_OFF = TBL_OFF + 2 * TBL_BYTES, SSD_LDS = MX_OFF + 10 * 2048;
constexpr int T_CUM = 0, T_DT = 512, T_WT = 1024, T_ETOT = 1536;
__device__ __forceinline__ int off_b(int row, int ch) { return 256 * row + 16 * (ch ^ (((row & 3) << 2) | ((row >> 2) & 3))); }
template <int OFF> __device__ __forceinline__ s16x4 tr_read(int addr) {
    s16x4 r; asm volatile("ds_read_b64_tr_b16 %0, %1 offset:%2" : "=&v"(r) : "v"(addr), "i"(OFF) : "memory"); return r;
}
#define SSD_PK(L, H) (bf16x8){L[0], L[1], L[2], L[3], H[0], H[1], H[2], H[3]}
#define SSD_LGKM0() do { asm volatile("s_waitcnt lgkmcnt(0)" ::: "memory"); __builtin_amdgcn_sched_barrier(0); } while (0)
#define SSD_MFMA(a, b, c) __builtin_amdgcn_mfma_f32_32x32x16_bf16(a, b, c, 0, 0, 0)

template <int SB, int LB>
__device__ __forceinline__ void decay_tile(const f32x16& g, bf16x8& m0, bf16x8& m1, LAS const char* tbl, int l31, int h, float cl) {
    const LAS float* cs2 = (const LAS float*)(tbl + T_DT); const float cl2 = cl * 1.4426950408889634f;
    float m[16];
#pragma unroll
    for (int q = 0; q < 4; ++q) { const v4f c4 = *(const LAS v4f*)(cs2 + 32 * SB + 8 * q + 4 * h);
#pragma unroll
        for (int e = 0; e < 4; ++e) { const float v = g[4 * q + e] * __builtin_amdgcn_exp2f(cl2 - c4[e]);
            m[4 * q + e] = (SB != LB || (8 * q + 4 * h + e) <= l31) ? v : 0.f; } }
    { v4u w; w.x = pkbf(m[0], m[1]); w.y = pkbf(m[2], m[3]); w.z = pkbf(m[4], m[5]); w.w = pkbf(m[6], m[7]); m0 = __builtin_bit_cast(bf16x8, w); }
    { v4u w; w.x = pkbf(m[8], m[9]); w.y = pkbf(m[10], m[11]); w.z = pkbf(m[12], m[13]); w.w = pkbf(m[14], m[15]); m1 = __builtin_bit_cast(bf16x8, w); }
}
#define SSD_RRO(s) (rr0 ^ (32 * (s)))
#define SSD_BROW(SB, s) (*(const LAS bf16x8*)(L + B_OFF + 8192 * (SB) + SSD_RRO(s)))

#define SSD_XF(SB, xf) do { xf[0] = tr_read<256 * (32 * (SB) + 0)>(xtr0); xf[1] = tr_read<256 * (32 * (SB) + 8)>(xtr1); xf[2] = tr_read<256 * (32 * (SB) + 16)>(xtr0); xf[3] = tr_read<256 * (32 * (SB) + 24)>(xtr1); } while (0)
#define SSD_MXA(LB_, SB_, KS_) (MX_OFF + ((((LB_) * ((LB_) + 1) / 2 + (SB_)) * 2 + (KS_)) << 10))
template <int LB, int PB>
__device__ __forceinline__ void chunk_y1(f32x16& yi, LAS char* L, LAS const char* tbl, int rr0, int pb, int lane, int l31, int h) {
    constexpr bool HAS_A = (PB <= LB), HAS_B = (PB + 2 <= LB);
    bf16x8 Cfr[8];
#pragma unroll
    for (int s = 0; s < 8; ++s) { LAS const char* as_ = L + SSD_RRO(s); Cfr[s] = *(const LAS bf16x8*)(as_ + (C_OFF + 8192 * LB)); }
    const float cl = *(const LAS float*)(tbl + T_CUM + 4 * (32 * LB + l31));
    f32x16 ga = {}, gb = {}; yi = (f32x16){};
#pragma unroll
    for (int s = 0; s < 8; ++s) {
        LAS const char* as_ = L + SSD_RRO(s);
        const bf16x8 hfr = *(const LAS bf16x8*)(as_ + (H_OFF + 8192 * PB)); yi = SSD_MFMA(hfr, Cfr[s], yi);
        if constexpr (HAS_A) { const bf16x8 ba = *(const LAS bf16x8*)(as_ + (B_OFF + 8192 * PB)); ga = SSD_MFMA(ba, Cfr[s], ga); }
        if constexpr (HAS_B) { const bf16x8 bb = *(const LAS bf16x8*)(as_ + (B_OFF + 8192 * (PB + 2))); gb = SSD_MFMA(bb, Cfr[s], gb); }
    }
    { const float el = __expf(cl);
#pragma unroll
      for (int r = 0; r < 16; ++r) yi[r] *= el; }
    if constexpr (HAS_A) { bf16x8 m0, m1; decay_tile<PB, LB>(ga, m0, m1, tbl, l31, h, cl);
        *(LAS bf16x8*)(L + SSD_MXA(LB, PB, 0) + 16 * lane) = m0; *(LAS bf16x8*)(L + SSD_MXA(LB, PB, 1) + 16 * lane) = m1; }
    if constexpr (HAS_B) { bf16x8 m0, m1; decay_tile<PB + 2, LB>(gb, m0, m1, tbl, l31, h, cl);
        *(LAS bf16x8*)(L + SSD_MXA(LB, PB + 2, 0) + 16 * lane) = m0; *(LAS bf16x8*)(L + SSD_MXA(LB, PB + 2, 1) + 16 * lane) = m1; }
}
template <int LB>
__device__ __forceinline__ void chunk_y2(f32x16& acc_y, LAS const char* L, int xtr0, int xtr1, int lane) {
    s16x4 xf[LB + 1][4]; bf16x8 mf[LB + 1][2];
    SSD_XF(0, xf[0]);
    if constexpr (LB >= 1) SSD_XF(1, xf[1]);
    if constexpr (LB >= 2) SSD_XF(2, xf[2]);
    if constexpr (LB >= 3) SSD_XF(3, xf[3]);
#pragma unroll
    for (int sb = 0; sb <= LB; ++sb) { mf[sb][0] = *(const LAS bf16x8*)(L + SSD_MXA(LB, sb, 0) + 16 * lane); mf[sb][1] = *(const LAS bf16x8*)(L + SSD_MXA(LB, sb, 1) + 16 * lane); }
    SSD_LGKM0();
#pragma unroll
    for (int sb = 0; sb <= LB; ++sb) { acc_y = SSD_MFMA(SSD_PK(xf[sb][0], xf[sb][1]), mf[sb][0], acc_y); acc_y = SSD_MFMA(SSD_PK(xf[sb][2], xf[sb][3]), mf[sb][1], acc_y); }
}
#undef SSD_XF

__device__ __forceinline__ void ssd_unit(LAS char* L, int unit, const bf16* xbc, const float* dtb, const float* a_log, const float* dskip, bf16* yout, int tid_in) {
    const int dir = unit & 1, head = (unit >> 1) & 127, b = unit >> 8, grp = head >> 4;
    asm volatile("" : "+s"(xbc), "+s"(dtb), "+s"(yout));
    int tid_l = tid_in; asm volatile("" : "+v"(tid_l));
    const int tid = tid_l, lane = tid & 63, w = __builtin_amdgcn_readfirstlane(tid >> 6), h = lane >> 5, l31 = lane & 31;
    const int pb = (w < 4) ? 0 : 1, lb = (w < 4) ? w : 7 - w, nb = w & 3, pb2 = w >> 2;
    constexpr int SCANW = 7;
    const float A = -__expf(a_log[dir * SSM_H + head]); const float dsk_eff = (dir == 0) ? dskip[head] : 0.f;
    const int rr0 = 256 * l31 + 16 * (h ^ (((l31 & 3) << 2) | ((l31 >> 2) & 3)));
    const int tq = (lane & 15) >> 2, tp = lane & 3, tblk = (lane >> 4) & 1;
    const int Lb = (int)(uintptr_t)L;
    const int xtr0 = Lb + XX_OFF + 256 * (4 * h + tq) + 16 * ((4 * pb + 2 * tblk + (tp >> 1)) ^ ((tq << 2) | ((0 + h) & 3))) + 8 * (tp & 1);
    const int xtr1 = Lb + XX_OFF + 256 * (4 * h + tq) + 16 * ((4 * pb + 2 * tblk + (tp >> 1)) ^ ((tq << 2) | ((2 + h) & 3))) + 8 * (tp & 1);
    const int btr0 = Lb + B_OFF + 256 * (8 * h + tq) + 16 * ((4 * nb + 2 * tblk + (tp >> 1)) ^ ((tq << 2) | (2 * h + 0))) + 8 * (tp & 1);
    const int btr1 = Lb + B_OFF + 256 * (8 * h + tq) + 16 * ((4 * nb + 2 * tblk + (tp >> 1)) ^ ((tq << 2) | (2 * h + 1))) + 8 * (tp & 1);
    const int wtr0 = Lb + XX_OFF + 256 * (8 * h + tq) + 16 * ((4 * (2 + pb2) + 2 * tblk + (tp >> 1)) ^ ((tq << 2) | (2 * h + 0))) + 8 * (tp & 1);
    const int wtr1 = Lb + XX_OFF + 256 * (8 * h + tq) + 16 * ((4 * (2 + pb2) + 2 * tblk + (tp >> 1)) ^ ((tq << 2) | (2 * h + 1))) + 8 * (tp & 1);

    { unsigned z0; asm volatile("v_mov_b32 %0, 0" : "=v"(z0)); const v4u zz = (v4u){z0, z0, z0, z0};
      for (int i = tid; i < 16384 / 16; i += 512) *(LAS v4u*)(L + H_OFF + i * 16) = zz; }
    f32x16 acc_h = {};
    v4u xr[2], br[4], cr[4]; float dtr0 = 0.f, dtr1 = 0.f, dtn0 = 0.f, dtn1 = 0.f;
    const size_t brow = (size_t)b * SEQ; const int sgn = dir ? -1 : 1;
#define SSD_TOK(ci, tau) (dir ? ((SEQ / 128 - 1 - (ci)) * 128 + 127 - (tau)) : ((ci) * 128 + (tau)))
#define SSD_TB(ci) ((int)brow + (dir ? ((SEQ / 128 - 1 - (ci)) * 128 + 127) : ((ci) * 128)))
#define SSD_PREFETCH(ci) do { const int tb_ = SSD_TB(ci); \
        { const unsigned ox = (unsigned)((tb_ + sgn * (tidl >> 3)) * (SSM_CONVD * 2) + (head * 64 + (tidl & 7) * 8) * 2); const unsigned sx = (unsigned)(sgn * 64 * SSM_CONVD * 2); \
          _Pragma("unroll") for (int i = 0; i < 2; ++i) xr[i] = *(const GAS v4u*)((const char*)xbc + (ox + (unsigned)i * sx)); } \
        { const unsigned ob = (unsigned)((tb_ + sgn * (tidl >> 4)) * (SSM_CONVD * 2) + (SSM_DI + grp * 128 + (tidl & 15) * 8) * 2); const unsigned sb = (unsigned)(sgn * 32 * SSM_CONVD * 2); \
          _Pragma("unroll") for (int i = 0; i < 4; ++i) { const char* rp = (const char*)xbc + (ob + (unsigned)i * sb); br[i] = *(const GAS v4u*)rp; cr[i] = *(const GAS v4u*)(rp + 2048); } } } while (0)
#define SSD_DTLOAD(ci, d0, d1) do { if (w == SCANW) { const unsigned od = (unsigned)((SSD_TB(ci) + sgn * 2 * lane) * 256 + dir * SSM_H + head) * 4u; \
        d0 = *(const GAS float*)((const char*)dtb + od); d1 = *(const GAS float*)((const char*)dtb + (od + (unsigned)(sgn * 1024))); } } while (0)
#define SSD_SCAN(TB) do { if (w == SCANW) { LAS char* tb_ = L + TBL_OFF + (TB) * TBL_BYTES; \
        const float a0 = dtr0 * A, a1 = dtr1 * A; float inc = a0 + a1; \
        _Pragma("unroll") for (int o = 1; o < 64; o <<= 1) { const float v = __shfl_up(inc, o); if (lane >= o) inc += v; } \
        const float c1 = inc, c0 = inc - a1; const float total = __shfl(inc, 63); \
        *(LAS f2*)(tb_ + T_CUM + 8 * lane) = (f2){c0, c1}; *(LAS f2*)(tb_ + T_DT + 8 * lane) = (f2){(c0 - __logf(dtr0)) * 1.4426950408889634f, (c1 - __logf(dtr1)) * 1.4426950408889634f}; \
        *(LAS f2*)(tb_ + T_WT + 8 * lane) = (f2){__expf(total - c0) * dtr0, __expf(total - c1) * dtr1}; if (lane == 0) *(LAS float*)(tb_ + T_ETOT) = __expf(total); } } while (0)
#define SSD_STAGE(TB) do { const LAS char* tb_ = L + TBL_OFF + (TB) * TBL_BYTES; \
        { const int obc = off_b(tidl >> 4, tidl & 15);                    \
          _Pragma("unroll") for (int i = 0; i < 4; ++i) { *(LAS v4u*)(L + B_OFF + obc + 8192 * i) = br[i]; *(LAS v4u*)(L + C_OFF + obc + 8192 * i) = cr[i]; } } \
        { const int oxx = off_b(tidl >> 3, tidl & 7);                     \
          _Pragma("unroll") for (int i = 0; i < 2; ++i) { const float wt = *(const LAS float*)(tb_ + T_WT + 4 * (tidl >> 3) + 256 * i); \
            *(LAS v4u*)(L + XX_OFF + oxx + 16384 * i) = xr[i]; \
            v4u o; o.x = pkbf(bflo(xr[i].x) * wt, bfhi(xr[i].x) * wt); o.y = pkbf(bflo(xr[i].y) * wt, bfhi(xr[i].y) * wt); o.z = pkbf(bflo(xr[i].z) * wt, bfhi(xr[i].z) * wt); o.w = pkbf(bflo(xr[i].w) * wt, bfhi(xr[i].w) * wt); \
            *(LAS v4u*)(L + XX_OFF + (oxx ^ 128) + 16384 * i) = o; } } } while (0)

    int tidl = tid; asm volatile("" : "+v"(tidl));
    SSD_DTLOAD(0, dtr0, dtr1);
    SSD_PREFETCH(0);
    SSD_SCAN(0);
    SSD_DTLOAD(1, dtr0, dtr1);
    __syncthreads();
    SSD_STAGE(0);
    SSD_PREFETCH(1);
    __syncthreads();
    for (int ci = 0; ci < SEQ / 128; ++ci) {
        const bool more = (ci + 1 < SEQ / 128);
        tidl = tid; asm volatile("" : "+v"(tidl));
        LAS const char* tbl = L + TBL_OFF + (ci & 1) * TBL_BYTES;
        if (ci + 2 < SEQ / 128) SSD_DTLOAD(ci + 2, dtn0, dtn1);
        if (more) SSD_SCAN((ci + 1) & 1);
        const float e_tot = *(const LAS float*)(tbl + T_ETOT);
        f32x16 acc_y;
        if (pb == 0) { if (lb == 0) chunk_y1<0, 0>(acc_y, L, tbl, rr0, pb, lane, l31, h); else if (lb == 1) chunk_y1<1, 0>(acc_y, L, tbl, rr0, pb, lane, l31, h);
                       else if (lb == 2) chunk_y1<2, 0>(acc_y, L, tbl, rr0, pb, lane, l31, h); else chunk_y1<3, 0>(acc_y, L, tbl, rr0, pb, lane, l31, h); }
        else         { if (lb == 0) chunk_y1<0, 1>(acc_y, L, tbl, rr0, pb, lane, l31, h); else if (lb == 1) chunk_y1<1, 1>(acc_y, L, tbl, rr0, pb, lane, l31, h);
                       else if (lb == 2) chunk_y1<2, 1>(acc_y, L, tbl, rr0, pb, lane, l31, h); else chunk_y1<3, 1>(acc_y, L, tbl, rr0, pb, lane, l31, h); }
        __syncthreads();
        if (lb == 0) chunk_y2<0>(acc_y, L, xtr0, xtr1, lane); else if (lb == 1) chunk_y2<1>(acc_y, L, xtr0, xtr1, lane);
        else if (lb == 2) chunk_y2<2>(acc_y, L, xtr0, xtr1, lane); else chunk_y2<3>(acc_y, L, xtr0, xtr1, lane);
        s16x4 sa[8][2], sb_[8][2];
#define SSD_ST_RD(KS) do { sa[KS][0] = tr_read<256 * (16 * (KS) + 0)>(btr0); sa[KS][1] = tr_read<256 * (16 * (KS) + 4)>(btr1); \
                           sb_[KS][0] = tr_read<256 * (16 * (KS) + 0)>(wtr0); sb_[KS][1] = tr_read<256 * (16 * (KS) + 4)>(wtr1); } while (0)
        SSD_ST_RD(0); SSD_ST_RD(1); SSD_ST_RD(2); SSD_ST_RD(3); SSD_ST_RD(4); SSD_ST_RD(5); SSD_ST_RD(6); SSD_ST_RD(7);
#undef SSD_ST_RD
        { char* yp = (char*)yout + (unsigned)((SSD_TB(ci) + sgn * (32 * lb + l31)) * SSM_DI + head * 64 + 32 * pb + 4 * h) * 2u;
          if (dir == 0) { const int x0 = off_b(32 * lb + l31, 4 * pb) + 8 * h;
#pragma unroll
            for (int q = 0; q < 4; ++q) { const v2u xq = *(const LAS v2u*)(L + XX_OFF + (x0 ^ (16 * q)));
              v2u o; o.x = pkbf(acc_y[4 * q] + dsk_eff * bflo(xq.x), acc_y[4 * q + 1] + dsk_eff * bfhi(xq.x)); o.y = pkbf(acc_y[4 * q + 2] + dsk_eff * bflo(xq.y), acc_y[4 * q + 3] + dsk_eff * bfhi(xq.y));
              *(GAS v2u*)(yp + 16 * q) = o; }
          } else {
#pragma unroll
            for (int q = 0; q < 4; ++q) { v2u o; o.x = pkbf(acc_y[4 * q], acc_y[4 * q + 1]); o.y = pkbf(acc_y[4 * q + 2], acc_y[4 * q + 3]); *(GAS v2u*)(yp + 16 * q) = o; } } }
        dtr0 = dtn0; dtr1 = dtn1;
        SSD_LGKM0();
        __syncthreads();
        { f32x16 ha = {}, hb = {};
          __builtin_amdgcn_s_setprio(1);
          ha = SSD_MFMA(SSD_PK(sa[0][0], sa[0][1]), SSD_PK(sb_[0][0], sb_[0][1]), ha); hb = SSD_MFMA(SSD_PK(sa[1][0], sa[1][1]), SSD_PK(sb_[1][0], sb_[1][1]), hb);
          ha = SSD_MFMA(SSD_PK(sa[2][0], sa[2][1]), SSD_PK(sb_[2][0], sb_[2][1]), ha); hb = SSD_MFMA(SSD_PK(sa[3][0], sa[3][1]), SSD_PK(sb_[3][0], sb_[3][1]), hb);
          ha = SSD_MFMA(SSD_PK(sa[4][0], sa[4][1]), SSD_PK(sb_[4][0], sb_[4][1]), ha); hb = SSD_MFMA(SSD_PK(sa[5][0], sa[5][1]), SSD_PK(sb_[5][0], sb_[5][1]), hb);
          ha = SSD_MFMA(SSD_PK(sa[6][0], sa[6][1]), SSD_PK(sb_[6][0], sb_[6][1]), ha); hb = SSD_MFMA(SSD_PK(sa[7][0], sa[7][1]), SSD_PK(sb_[7][0], sb_[7][1]), hb);
          __builtin_amdgcn_s_setprio(0);
#pragma unroll
          for (int r = 0; r < 16; ++r) acc_h[r] = acc_h[r] * e_tot + (ha[r] + hb[r]); }
        tidl = tid; asm volatile("" : "+v"(tidl));
        if (more) {
            const int a0 = off_b(32 * pb2 + l31, 4 * nb) + 8 * h;
#pragma unroll
            for (int q = 0; q < 4; ++q) { v2u o; o.x = pkbf(acc_h[4 * q], acc_h[4 * q + 1]); o.y = pkbf(acc_h[4 * q + 2], acc_h[4 * q + 3]);
                *(LAS v2u*)(L + H_OFF + (a0 ^ (16 * q))) = o; }
            SSD_STAGE((ci + 1) & 1);
            if (ci + 2 < SEQ / 128) SSD_PREFETCH(ci + 2);
        }
        __syncthreads();
    }
#undef SSD_TOK
#undef SSD_PREFETCH
#undef SSD_DTLOAD
#undef SSD_SCAN
#undef SSD_STAGE
}
#undef SSD_PK
#undef SSD_LGKM0
#undef SSD_MFMA
#undef SSD_BROW
#undef SSD_RRO
#undef SSD_MXA
}
#define XB_TMO      128
#define XB_XCNT(j)  (256  + 64 * (j))
#define XB_XSUB(j)  (1280 + 64 * (j))
#define XB_XGEN(j)  (2304 + 64 * (j))
#define XB_TOP      3328
#define XB_TOPGEN   3392
#define XCD_BAR_WORDS 3456
#define XB_GEMV_DONE 3520
#define XB_SPIN_CAP (1u << 18)

__device__ __forceinline__ unsigned xb_ld(unsigned* p)              { return __hip_atomic_load(p, __ATOMIC_RELAXED, __HIP_MEMORY_SCOPE_AGENT); }
__device__ __forceinline__ unsigned xb_add(unsigned* p, unsigned v) { return __hip_atomic_fetch_add(p, v, __ATOMIC_RELAXED, __HIP_MEMORY_SCOPE_AGENT); }
__device__ __forceinline__ unsigned xb_xcc_id() { return (unsigned)__builtin_amdgcn_s_getreg((3 << 11) | 20) & 0xFu; }
#define XB_SPIN(cond, bar) do { unsigned _sp = 0; while (cond) { __builtin_amdgcn_s_sleep(1); \
    if ((++_sp & 255u) == 0u) { if (xb_ld(&(bar)[XB_TMO])) break; if (_sp > XB_SPIN_CAP) { atomicAdd(&(bar)[XB_TMO], 1u); break; } } } } while (0)

struct XcdBarrier {
    unsigned* bar; unsigned x;
    volatile LAS unsigned* st;
};

__device__ __forceinline__ XcdBarrier xcd_barrier_post(unsigned* bar, volatile LAS unsigned* st, int tid) {
    XcdBarrier b; b.bar = bar; b.x = xb_xcc_id(); b.st = st;
    if (tid == 0) (void)xb_add(&bar[XB_XCNT(b.x)], 1u);
    return b;
}
__device__ __forceinline__ void xcd_barrier_complete(unsigned* bar, unsigned x, unsigned& nloc, unsigned& nx) {
    const unsigned G = gridDim.x * gridDim.y * gridDim.z;
    unsigned sum, cnt, mine, sp = 0u;
    for (;;) {
        sum = 0u; cnt = 0u; mine = 0u;
#pragma unroll
        for (unsigned j = 0; j < 16; ++j) { const unsigned c = xb_ld(&bar[XB_XCNT(j)]); sum += c; cnt += (c > 0u) ? 1u : 0u; mine = (j == x) ? c : mine; }
        if (sum == G) break;
        __builtin_amdgcn_s_sleep(1);
        if ((++sp & 255u) == 0u) { if (xb_ld(&bar[XB_TMO])) break; if (sp > XB_SPIN_CAP) { atomicAdd(&bar[XB_TMO], 1u); break; } }
    }
    nloc = mine > 0u ? mine : 1u; nx = cnt > 0u ? cnt : 1u;
}

__device__ __forceinline__ void xcd_barrier(const XcdBarrier& b, int tid) {
    asm volatile("s_waitcnt vmcnt(0)" ::: "memory");
    __syncthreads();
    if (tid == 0) {
        unsigned* bar = b.bar;
        __builtin_amdgcn_s_waitcnt(0);
        unsigned nloc = b.st[0], nx = b.st[1];
        if (nloc == 0u) { xcd_barrier_complete(bar, b.x, nloc, nx); b.st[0] = nloc; b.st[1] = nx; }
        const unsigned old = xb_add(&bar[XB_XSUB(b.x)], 1u);
        const unsigned gen = old / nloc;
        if (old + 1u == (gen + 1u) * nloc) {
            __builtin_amdgcn_fence(__ATOMIC_RELEASE, "agent");
            asm volatile("s_waitcnt vmcnt(0)" ::: "memory");
            const unsigned og = xb_add(&bar[XB_TOP], 1u);
            const unsigned tg = og / nx;
            if (og + 1u == (tg + 1u) * nx) xb_add(&bar[XB_TOPGEN], 1u);
            else XB_SPIN(xb_ld(&bar[XB_TOPGEN]) == tg, bar);
            __builtin_amdgcn_fence(__ATOMIC_ACQUIRE, "agent");
            xb_add(&bar[XB_XGEN(b.x)], 1u);
            asm volatile("s_waitcnt vmcnt(0)" ::: "memory");
        } else {
            XB_SPIN(xb_ld(&bar[XB_XGEN(b.x)]) == gen, bar);
            __builtin_amdgcn_fence(__ATOMIC_ACQUIRE, "agent");
            asm volatile("s_waitcnt vmcnt(0)" ::: "memory");
        }
    }
    __syncthreads();
}

__device__ __forceinline__ void arrivals_wait(unsigned* bar, int w, unsigned expect, int tid) {
    if (tid == 0) {
        XB_SPIN(xb_ld(bar + w) < expect, bar);
        __builtin_amdgcn_fence(__ATOMIC_ACQUIRE, "agent");
        asm volatile("s_waitcnt vmcnt(0)" ::: "memory");
    }
    __syncthreads();
}
struct Ctx { LAS unsigned char* lds; int tid, lane, wave, gw, NGW, G; };
constexpr int NWAVES_C = 8;

__device__ __forceinline__ void transpose_item(const float* W, int K, int N, bf16* WT, int row_off, LAS float* scr, int item, int lane) {
    const int nblk = N / 32, kb = item / nblk, nb = item % nblk, k0 = 64 * kb, n0 = 32 * nb;
#pragma unroll 8
    for (int i = 0; i < 32; ++i) { const int kk = 2 * i + (lane >> 5); scr[kk * 33 + (lane & 31)] = W[(size_t)(k0 + kk) * N + n0 + (lane & 31)]; }
    LDS_WAIT(); asm volatile("" ::: "memory");
    const int c = lane & 7;
#pragma unroll
    for (int j = 0; j < 4; ++j) { const int n = (lane >> 3) + 8 * j; const LAS float* s = scr + (8 * c) * 33 + n;
        v4u o; o.x = pkbf(s[0 * 33], s[1 * 33]); o.y = pkbf(s[2 * 33], s[3 * 33]); o.z = pkbf(s[4 * 33], s[5 * 33]); o.w = pkbf(s[6 * 33], s[7 * 33]);
        *(GAS v4u*)(WT + (size_t)(row_off + n0 + n) * K + k0 + 8 * c) = o; }
    LDS_WAIT(); asm volatile("" ::: "memory");
}

struct P0Args { const float *c, *w_ada, *b_ada; float* mod; float* ropetab; const float *w_in, *w_gate, *w_ssm, *w_att, *w_out, *w_up, *w_dn; bf16 *Wcat, *Wssm, *Watt, *Wout, *Wup, *Wdn; };
__device__ __forceinline__ void phase_prologue(const Ctx& X, const P0Args& A, unsigned* ctl) {
    for (int it = X.gw; it < 96 * 64; it += X.NGW) {
        const int nb = it % 96, kc = it / 96, n0 = nb * 256 + X.lane * 4, k0 = kc * 64;
        float sc[4];
#pragma unroll
        for (int b = 0; b < 4; ++b) sc[b] = siluf_(A.c[b * D_MODEL + k0 + X.lane]);
        v4f acc[4];
#pragma unroll
        for (int b = 0; b < 4; ++b) acc[b] = (v4f){0.f, 0.f, 0.f, 0.f};
        const float* wp = A.w_ada + (size_t)k0 * MOD_LD + n0;
#pragma unroll 1
        for (int kq = 0; kq < 4; ++kq) {
            v4f w[16];
#pragma unroll
            for (int kk = 0; kk < 16; ++kk) w[kk] = *(const GAS v4f*)(wp + (size_t)(kq * 16 + kk) * MOD_LD);
#pragma unroll
            for (int kk = 0; kk < 16; ++kk)
#pragma unroll
                for (int b = 0; b < 4; ++b) { const float s = __uint_as_float(__builtin_amdgcn_readlane(__float_as_uint(sc[b]), kq * 16 + kk)); acc[b] += w[kk] * s; }
        }
        if (kc == 0) { const v4f bb = *(const GAS v4f*)(A.b_ada + n0);
#pragma unroll
            for (int b = 0; b < 4; ++b) acc[b] += bb; }
#pragma unroll
        for (int b = 0; b < 4; ++b) { float* mp = A.mod + (size_t)b * MOD_LD + n0;
            unsafeAtomicAdd(mp, acc[b].x); unsafeAtomicAdd(mp + 1, acc[b].y); unsafeAtomicAdd(mp + 2, acc[b].z); unsafeAtomicAdd(mp + 3, acc[b].w); }
    }
    asm volatile("s_waitcnt vmcnt(0)" ::: "memory");
    __syncthreads();
    if (X.tid == 0) { __builtin_amdgcn_s_waitcnt(0); __builtin_amdgcn_fence(__ATOMIC_RELEASE, "agent"); asm volatile("s_waitcnt vmcnt(0)" ::: "memory"); (void)xb_add(ctl + XB_GEMV_DONE, 1u); }
    { const int gt = X.gw * 64 + X.lane;
      if (gt < 64 * 32) { const int pos = gt >> 5, i = gt & 31; const float ang = (float)pos * exp2f(-(float)i * (13.287712379549449f / 32.0f)); float sn, cs; sincosf(ang, &sn, &cs);
          A.ropetab[2 * gt] = cs; A.ropetab[2 * gt + 1] = sn; } }
    LAS float* scr = (LAS float*)(X.lds + X.wave * 16384);
    constexpr int I_IN = (D_MODEL / 64) * (IN_COLS / 32), I_GATE = (D_MODEL / 64) * (2 * D_MODEL / 32);
    constexpr int NITEMS = I_IN + I_GATE;
    for (int it = X.gw; it < NITEMS; it += X.NGW) {
        int r = it;
        if (r < I_IN) { transpose_item(A.w_in, D_MODEL, IN_COLS, A.Wcat, 0, scr, r, X.lane); continue; } r -= I_IN;
        transpose_item(A.w_gate, D_MODEL, 2 * D_MODEL, A.Wcat, IN_COLS, scr, r, X.lane);
    }
}
__device__ __forceinline__ void transposes_up_share(const Ctx& X, const float* w_up, bf16* Wup) {
    LAS float* scr = (LAS float*)(X.lds + X.wave * 16384);
    constexpr int I_UP = (D_MODEL / 64) * (FFN2 / 32), nblk = FFN2 / 32;
    const int lr = X.lane >> 3, lc = 4 * (X.lane & 7);
    for (int it0 = X.gw; it0 < I_UP; it0 += 2 * X.NGW) {
        const int it1 = it0 + X.NGW; const bool two = it1 < I_UP;
        v4f v[2][8];
#pragma unroll
        for (int s = 0; s < 2; ++s) { const int it = (s && two) ? it1 : it0; const int kb = it / nblk, nb = it % nblk;
            const GAS float* src = (const GAS float*)w_up + (size_t)(64 * kb + lr) * FFN2 + 32 * nb + lc;
#pragma unroll
            for (int i = 0; i < 8; ++i) v[s][i] = *(const GAS v4f*)(src + (size_t)(8 * i) * FFN2); }
#pragma unroll
        for (int s = 0; s < 2; ++s) {
            if (s && !two) break;
            const int it = s ? it1 : it0; const int kb = it / nblk, nb = it % nblk, k0 = 64 * kb, n0 = 32 * nb;
            const int f = (n0 < FFN) ? (256 * (n0 >> 7) + (n0 & 127)) : (256 * ((n0 - FFN) >> 7) + 128 + ((n0 - FFN) & 127));
#pragma unroll
            for (int i = 0; i < 8; ++i) { LAS float* d = scr + (lr + 8 * i) * 33 + lc; d[0] = v[s][i].x; d[1] = v[s][i].y; d[2] = v[s][i].z; d[3] = v[s][i].w; }
            LDS_WAIT(); asm volatile("" ::: "memory");
            const int c = X.lane & 7;
#pragma unroll
            for (int j = 0; j < 4; ++j) { const int n = (X.lane >> 3) + 8 * j; const LAS float* sp = scr + (8 * c) * 33 + n;
                v4u o; o.x = pkbf(sp[0 * 33], sp[1 * 33]); o.y = pkbf(sp[2 * 33], sp[3 * 33]); o.z = pkbf(sp[4 * 33], sp[5 * 33]); o.w = pkbf(sp[6 * 33], sp[7 * 33]);
                *(GAS v4u*)(Wup + (size_t)(f + n) * D_MODEL + k0 + 8 * c) = o; }
            LDS_WAIT(); asm volatile("" ::: "memory");
        }
    }
}
__device__ __forceinline__ void tail_transposes_mix(const Ctx& X, int first, const float* w_ssm, const float* w_att, const float* w_out, bf16* Wssm, bf16* Watt, bf16* Wout) {
    if ((int)blockIdx.x < first) return;
    LAS float* scr = (LAS float*)(X.lds + X.wave * 16384);
    constexpr int I_SSM = (SSM_DI / 64) * (D_MODEL / 32), I_ATT = (D_MODEL / 64) * (D_MODEL / 32), NIT = I_SSM + 2 * I_ATT;
    const int gwv = ((int)blockIdx.x - first) * NWAVES_C + X.wave, ngw = (X.G - first) * NWAVES_C;
    for (int it = gwv; it < NIT; it += ngw) {
        int r = it;
        if (r < I_SSM) { transpose_item(w_ssm, SSM_DI, D_MODEL, Wssm, 0, scr, r, X.lane); continue; } r -= I_SSM;
        if (r < I_ATT) { transpose_item(w_att, D_MODEL, D_MODEL, Watt, 0, scr, r, X.lane); continue; } r -= I_ATT;
        transpose_item(w_out, D_MODEL, D_MODEL, Wout, 0, scr, r, X.lane);
    }
}
__device__ __forceinline__ void tail_transposes_down(const Ctx& X, int first, const float* w_dn, bf16* Wdn) {
    if ((int)blockIdx.x < first) return;
    LAS float* scr = (LAS float*)(X.lds + X.wave * 16384);
    constexpr int NIT = (FFN / 64) * (D_MODEL / 32);
    const int gwv = ((int)blockIdx.x - first) * NWAVES_C + X.wave, ngw = (X.G - first) * NWAVES_C;
    for (int it = gwv; it < NIT; it += ngw) transpose_item(w_dn, FFN, D_MODEL, Wdn, 0, scr, it, X.lane);
}
__device__ __forceinline__ void phase_mod_reduce(const Ctx& X, const float* part, const float* b_ada, float* mod) {
    const int gt = X.gw * 64 + X.lane;
    for (int i = gt; i < 4 * MOD_LD / 4; i += X.NGW * 64) {
        const int b = i / (MOD_LD / 4), n = (i % (MOD_LD / 4)) * 4;
        v4f s = *(const GAS v4f*)(b_ada + n);
#pragma unroll 8
        for (int kc = 0; kc < 64; ++kc) s += *(const GAS v4f*)(part + ((size_t)(kc * 4 + b)) * MOD_LD + n);
        *(GAS v4f*)(mod + (size_t)b * MOD_LD + n) = s;
    }
}
__device__ __forceinline__ void ln_stats(const v4f (&v)[16], float& mean, float& rstd) {
    float s = 0.f;
#pragma unroll
    for (int j = 0; j < 16; ++j) s += (v[j].x + v[j].y) + (v[j].z + v[j].w);
    mean = wave_sum(s) * (1.f / D_MODEL); float s2 = 0.f;
#pragma unroll
    for (int j = 0; j < 16; ++j) { const v4f d = v[j] - mean; s2 += (d.x * d.x + d.y * d.y) + (d.z * d.z + d.w * d.w); }
    rstd = 1.0f / sqrtf(wave_sum(s2) * (1.f / D_MODEL) + LN_EPS);
}
__device__ __forceinline__ void phase_h(const Ctx& X, const float* x, const float* mod, bf16* h) {
    for (int m = X.gw; m < MTOK; m += X.NGW) {
        const GAS v4f* xr = (const GAS v4f*)(x + (size_t)m * D_MODEL) + X.lane;
        v4f v[16];
#pragma unroll
        for (int j = 0; j < 16; ++j) v[j] = xr[64 * j];
        float mean, rstd; ln_stats(v, mean, rstd);
        const float* mrow = mod + (size_t)(m / SEQ) * MOD_LD;
        const GAS v4f* sh = (const GAS v4f*)(mrow) + X.lane; const GAS v4f* sc = (const GAS v4f*)(mrow + D_MODEL) + X.lane;
        GAS v2u* o = (GAS v2u*)(h + (size_t)m * D_MODEL) + X.lane;
#pragma unroll
        for (int j = 0; j < 16; ++j) { const v4f y = (v[j] - mean) * rstd * (sc[64 * j] + 1.0f) + sh[64 * j]; v2u w; w.x = pkbf(y.x, y.y); w.y = pkbf(y.z, y.w); o[64 * j] = w; }
    }
}
__device__ __forceinline__ void unpack8(const v4u w, float (&f)[8]) { f[0] = bflo(w.x); f[1] = bfhi(w.x); f[2] = bflo(w.y); f[3] = bfhi(w.y); f[4] = bflo(w.z); f[5] = bfhi(w.z); f[6] = bflo(w.w); f[7] = bfhi(w.w); }
__device__ __forceinline__ void phase_xbc_fixup(const Ctx& X, const float* edge, const float* cw, const float* cb, bf16* out) {
    constexpr int NCG = SSM_CONVD / 8, NSEG = MTOK / 128;
    const int gt = X.gw * 64 + X.lane, NT = X.NGW * 64;
    for (int it = gt; it < (NSEG - 1) * NCG; it += NT) {
        const int bd = 1 + it / NCG, c = 8 * (it % NCG);
        if ((bd & 31) == 0) continue;
        const float* e_lm1 = edge + ((size_t)(bd - 1) * 4 + 2) * SSM_CONVD + c; const float* e_l = e_lm1 + SSM_CONVD;
        const float* e_f = edge + ((size_t)bd * 4 + 0) * SSM_CONVD + c; const float* e_f1 = e_f + SSM_CONVD;
        float oa[8], ob[8];
#pragma unroll
        for (int j = 0; j < 8; ++j) { const float w0 = cw[c + j], w1 = cw[SSM_CONVD + c + j], w2 = cw[2 * SSM_CONVD + c + j], bb = cb[c + j];
            oa[j] = siluf_(e_lm1[j] * w0 + e_l[j] * w1 + e_f[j] * w2 + bb);
            ob[j] = siluf_(e_l[j] * w0 + e_f[j] * w1 + e_f1[j] * w2 + bb); }
        v4u w0_, w1_; w0_.x = pkbf(oa[0], oa[1]); w0_.y = pkbf(oa[2], oa[3]); w0_.z = pkbf(oa[4], oa[5]); w0_.w = pkbf(oa[6], oa[7]);
        w1_.x = pkbf(ob[0], ob[1]); w1_.y = pkbf(ob[2], ob[3]); w1_.z = pkbf(ob[4], ob[5]); w1_.w = pkbf(ob[6], ob[7]);
        *(GAS v4u*)(out + (size_t)(128 * bd - 1) * SSM_CONVD + c) = w0_; *(GAS v4u*)(out + (size_t)(128 * bd) * SSM_CONVD + c) = w1_;
    }
}
__device__ __forceinline__ void qk_norm_rope_rows(const Ctx& X, bf16* buf, int nheads, const float* nw, const float* tab) {
    const int total = MTOK * nheads / 4;
    const int sub = X.lane >> 4, j16 = X.lane & 15;
    float wv[8];
#pragma unroll
    for (int e = 0; e < 8; ++e) wv[e] = nw[j16 * 8 + e];
    const int half = j16 >> 3, jj = j16 & 7;
    const bool is_x2 = (jj >= 4);
    const int i0 = (jj & 3) * 8;
    for (int it = X.gw; it < total; it += X.NGW) {
        const int pair = it * 4 + sub, tok = pair / nheads, hd = pair % nheads;
        GAS v4u* p = (GAS v4u*)(buf + ((size_t)tok * nheads + hd) * 128 + j16 * 8);
        float f[8]; unpack8(*p, f);
        float ss = 0.f;
#pragma unroll
        for (int e = 0; e < 8; ++e) ss += f[e] * f[e];
        ss += __shfl_xor(ss, 1); ss += __shfl_xor(ss, 2); ss += __shfl_xor(ss, 4); ss += __shfl_xor(ss, 8);
        const float r = 1.0f / sqrtf(ss * (1.f / 128.f) + RMS_EPS);
#pragma unroll
        for (int e = 0; e < 8; ++e) f[e] = f[e] * r * wv[e];
        const int t = tok % SEQ; const int pos = half ? (t % GRID_W) : (t / GRID_W);
        const GAS v4f* tp = (const GAS v4f*)(tab + (size_t)(pos * 32 + i0) * 2);
        float csn[16];
#pragma unroll
        for (int q4 = 0; q4 < 4; ++q4) { const v4f tv = tp[q4]; csn[q4 * 4 + 0] = tv.x; csn[q4 * 4 + 1] = tv.y; csn[q4 * 4 + 2] = tv.z; csn[q4 * 4 + 3] = tv.w; }
        float o[8];
#pragma unroll
        for (int e = 0; e < 8; ++e) { const float other = __shfl_xor(f[e], 4); const float cs = csn[2 * e], sn = csn[2 * e + 1];
            o[e] = is_x2 ? (f[e] * cs + other * sn) : (f[e] * cs - other * sn); }
        v4u w; w.x = pkbf(o[0], o[1]); w.y = pkbf(o[2], o[3]); w.z = pkbf(o[4], o[5]); w.w = pkbf(o[6], o[7]);
        *p = w;
    }
}
__device__ __forceinline__ void ssd_naive_unit(const Ctx& X, int unit, const bf16* xbc, const float* dtb, const float* a_log, bf16* yout) {
    const int dir = unit & 1, head = (unit >> 1) & 127, b = unit >> 8, grp = head >> 4;
    const int tid = X.tid, p = tid >> 3, ng = tid & 7;
    LAS float* xs = (LAS float*)X.lds;
    LAS float* Bs = xs + 64 * 64;
    LAS float* Cs = Bs + 64 * 128;
    LAS float* dts = Cs + 64 * 128;
    LAS float* as_ = dts + 64;
    LAS float* ys = as_ + 64;
    const float A = -__expf(a_log[dir * SSM_H + head]);
    float h[16];
#pragma unroll
    for (int i = 0; i < 16; ++i) h[i] = 0.f;
    for (int ci = 0; ci < SEQ / 64; ++ci) {
        const int c = dir ? (SEQ / 64 - 1 - ci) : ci; const size_t row0 = (size_t)b * SEQ + (size_t)c * 64;
        { const int tok = tid >> 3, s8 = (tid & 7);
          const bf16* rp = xbc + (row0 + tok) * SSM_CONVD;
          float f[8]; unpack8(*(const GAS v4u*)(rp + head * 64 + s8 * 8), f);
#pragma unroll
          for (int j = 0; j < 8; ++j) xs[tok * 64 + s8 * 8 + j] = f[j];
          unpack8(*(const GAS v4u*)(rp + SSM_DI + grp * 128 + s8 * 16), f);
#pragma unroll
          for (int j = 0; j < 8; ++j) Bs[tok * 128 + s8 * 16 + j] = f[j];
          unpack8(*(const GAS v4u*)(rp + SSM_DI + grp * 128 + s8 * 16 + 8), f);
#pragma unroll
          for (int j = 0; j < 8; ++j) Bs[tok * 128 + s8 * 16 + 8 + j] = f[j];
          unpack8(*(const GAS v4u*)(rp + SSM_DI + 1024 + grp * 128 + s8 * 16), f);
#pragma unroll
          for (int j = 0; j < 8; ++j) Cs[tok * 128 + s8 * 16 + j] = f[j];
          unpack8(*(const GAS v4u*)(rp + SSM_DI + 1024 + grp * 128 + s8 * 16 + 8), f);
#pragma unroll
          for (int j = 0; j < 8; ++j) Cs[tok * 128 + s8 * 16 + 8 + j] = f[j];
          if (tid < 64) { const float dv = dtb[(row0 + tid) * 256 + dir * SSM_H + head]; dts[tid] = dv; as_[tid] = __expf(dv * A); } }
        __syncthreads();
#pragma unroll 2
        for (int ti = 0; ti < 64; ++ti) {
            const int t = dir ? 63 - ti : ti;
            const float av = as_[t], xv = xs[t * 64 + p] * dts[t];
            float part = 0.f;
#pragma unroll
            for (int i4 = 0; i4 < 4; ++i4) { const v4f bv = *(const LAS v4f*)(Bs + t * 128 + ng * 16 + i4 * 4), cv = *(const LAS v4f*)(Cs + t * 128 + ng * 16 + i4 * 4);
#pragma unroll
                for (int j = 0; j < 4; ++j) { h[i4 * 4 + j] = av * h[i4 * 4 + j] + xv * bv[j]; part += cv[j] * h[i4 * 4 + j]; } }
            part += __shfl_xor(part, 1); part += __shfl_xor(part, 2); part += __shfl_xor(part, 4);
            if (ng == 0) ys[t * 64 + p] = part;
        }
        __syncthreads();
        { const int tok = tid >> 3, s8 = tid & 7; const LAS float* yp = ys + tok * 64 + s8 * 8;
          v4u o; o.x = pkbf(yp[0], yp[1]); o.y = pkbf(yp[2], yp[3]); o.z = pkbf(yp[4], yp[5]); o.w = pkbf(yp[6], yp[7]);
          *(GAS v4u*)(yout + (row0 + tok) * SSM_DI + head * 64 + s8 * 8) = o; }
    }
    __syncthreads();
}
__device__ __forceinline__ void phase_ssm_combine(const Ctx& X, const bf16* yf, const bf16* yb, bf16* z, const float* normw) {
    for (int it = X.gw; it < MTOK * SSM_G; it += X.NGW) {
        const int tok = it >> 3, g = it & 7, e0 = g * 1024 + X.lane * 16;
        float y[16];
#pragma unroll
        for (int hh = 0; hh < 2; ++hh) { float a[8], bq[8], zz[8];
            unpack8(*(const GAS v4u*)(yf + (size_t)tok * SSM_DI + e0 + hh * 8), a); unpack8(*(const GAS v4u*)(yb + (size_t)tok * SSM_DI + e0 + hh * 8), bq);
            unpack8(*(const GAS v4u*)(z + (size_t)tok * SSM_DI + e0 + hh * 8), zz);
#pragma unroll
            for (int j = 0; j < 8; ++j) y[hh * 8 + j] = (a[j] + bq[j]) * siluf_(zz[j]); }
        float ss = 0.f;
#pragma unroll
        for (int j = 0; j < 16; ++j) ss += y[j] * y[j];
        const float r = 1.0f / sqrtf(wave_sum(ss) * (1.f / 1024.f) + RMS_EPS);
#pragma unroll
        for (int hh = 0; hh < 2; ++hh) { float o[8];
#pragma unroll
            for (int j = 0; j < 8; ++j) o[j] = y[hh * 8 + j] * r * normw[e0 + hh * 8 + j];
            v4u w; w.x = pkbf(o[0], o[1]); w.y = pkbf(o[2], o[3]); w.z = pkbf(o[4], o[5]); w.w = pkbf(o[6], o[7]);
            *(GAS v4u*)(z + (size_t)tok * SSM_DI + e0 + hh * 8) = w; }
    }
}
__device__ __forceinline__ void phase_ln1(const Ctx& X, const float* r1, const float* g, const float* bt, const float* mod, float* stats, bf16* h2) {
    for (int m = X.gw; m < MTOK; m += X.NGW) {
        const GAS v4f* rr = (const GAS v4f*)(r1 + (size_t)m * D_MODEL) + X.lane;
        v4f v[16];
#pragma unroll
        for (int j = 0; j < 16; ++j) v[j] = rr[64 * j];
        float mean, rstd; ln_stats(v, mean, rstd);
        const float* gl = g; const float* bl = bt; asm volatile("" : "+s"(gl), "+s"(bl));
        const GAS v4f* gp = (const GAS v4f*)gl + X.lane; const GAS v4f* bp = (const GAS v4f*)bl + X.lane;
        if (X.lane == 0) { typedef float f2_ __attribute__((ext_vector_type(2))); *(GAS f2_*)(stats + 2 * (size_t)m) = (f2_){mean, rstd}; }
#pragma unroll
        for (int j = 0; j < 16; ++j) { v[j] = (v[j] - mean) * rstd * gp[64 * j] + bp[64 * j]; if ((j & 3) == 3) asm volatile("" ::: "memory"); }
        ln_stats(v, mean, rstd);
        const float* mrow = mod + (size_t)(m / SEQ) * MOD_LD;
        const GAS v4f* sh = (const GAS v4f*)(mrow + 3 * D_MODEL) + X.lane; const GAS v4f* sc = (const GAS v4f*)(mrow + 4 * D_MODEL) + X.lane;
        GAS v2u* o = (GAS v2u*)(h2 + (size_t)m * D_MODEL) + X.lane;
#pragma unroll
        for (int j = 0; j < 16; ++j) { const v4f y = (v[j] - mean) * rstd * (sc[64 * j] + 1.0f) + sh[64 * j]; v2u w; w.x = pkbf(y.x, y.y); w.y = pkbf(y.z, y.w); o[64 * j] = w; }
    }
}
__device__ __forceinline__ void phase_conv_fixup(const Ctx& X, const float* edge, const float* cw, const float* cb, bf16* act) {
    constexpr int NCG = FFN / 8, NSEG = MTOK / 128;
    const int gt = X.gw * 64 + X.lane, NT = X.NGW * 64;
    for (int it = gt; it < (NSEG - 1) * NCG; it += NT) {
        const int bd = 1 + it / NCG, cg = it % NCG;
        if ((bd & 31) == 0) continue;
        const int c = 8 * cg, tca = 256 * (c >> 7) + (c & 127);
        const float* e_lm1 = edge + ((size_t)(bd - 1) * 4 + 2) * 22016 + tca;
        const float* e_l = e_lm1 + 22016;
        const float* e_f = edge + ((size_t)bd * 4 + 0) * 22016 + tca;
        const float* e_f1 = e_f + 22016;
        float oa[8], ob[8];
#pragma unroll
        for (int j = 0; j < 8; ++j) {
            const float wa0 = cw[c + j], wa1 = cw[FFN2 + c + j], wa2 = cw[2 * FFN2 + c + j], ba = cb[c + j];
            const float wb0 = cw[FFN + c + j], wb1 = cw[FFN2 + FFN + c + j], wb2 = cw[2 * FFN2 + FFN + c + j], bb = cb[FFN + c + j];
            const float a_lm1 = e_lm1[j], a_l = e_l[j], a_f = e_f[j], a_f1 = e_f1[j], b_lm1 = e_lm1[128 + j], b_l = e_l[128 + j], b_f = e_f[128 + j], b_f1 = e_f1[128 + j];
            const float ca0 = a_lm1 * wa0 + a_l * wa1 + a_f * wa2 + ba, cb0 = b_lm1 * wb0 + b_l * wb1 + b_f * wb2 + bb;
            const float ca1 = a_l * wa0 + a_f * wa1 + a_f1 * wa2 + ba, cb1 = b_l * wb0 + b_f * wb1 + b_f1 * wb2 + bb;
            oa[j] = siluf_(ca0) * cb0; ob[j] = siluf_(ca1) * cb1; }
        v4u w0, w1; w0.x = pkbf(oa[0], oa[1]); w0.y = pkbf(oa[2], oa[3]); w0.z = pkbf(oa[4], oa[5]); w0.w = pkbf(oa[6], oa[7]);
        w1.x = pkbf(ob[0], ob[1]); w1.y = pkbf(ob[2], ob[3]); w1.z = pkbf(ob[4], ob[5]); w1.w = pkbf(ob[6], ob[7]);
        *(GAS v4u*)(act + (size_t)(128 * bd - 1) * FFN + c) = w0; *(GAS v4u*)(act + (size_t)(128 * bd) * FFN + c) = w1;
    }
}
__device__ __forceinline__ void phase_ln_final(const Ctx& X, float* io, const float* g, const float* bt) {
    for (int m = X.gw; m < MTOK; m += X.NGW) {
        GAS v4f* rr = (GAS v4f*)(io + (size_t)m * D_MODEL) + X.lane;
        v4f v[16];
#pragma unroll
        for (int j = 0; j < 16; ++j) v[j] = rr[64 * j];
        float mean, rstd; ln_stats(v, mean, rstd);
        const GAS v4f* gp = (const GAS v4f*)g + X.lane; const GAS v4f* bp = (const GAS v4f*)bt + X.lane;
#pragma unroll
        for (int j = 0; j < 16; ++j) rr[64 * j] = (v[j] - mean) * rstd * gp[64 * j] + bp[64 * j];
    }
}
constexpr int N_PHASES = 15;
struct Args { const float* in[26]; float* out; unsigned char* ws; int ph_lo, ph_hi; };
__global__ void __launch_bounds__(NWAVES * 64, 2) mk_fwd(Args args) {
    extern __shared__ __attribute__((aligned(16))) unsigned char lds[];
    volatile LAS unsigned* MISC = (volatile LAS unsigned*)((LAS unsigned char*)lds + MISC_OFF);
    unsigned char* const ws = args.ws;
    for (int u = threadIdx.x; u < (LDS_BYTES - LDS_ZERO_OFF) / 4; u += NWAVES * 64) ((LAS unsigned*)((LAS unsigned char*)lds + LDS_ZERO_OFF))[u] = 0u;
    __syncthreads();
    const int s_wave = __builtin_amdgcn_readfirstlane((int)threadIdx.x >> 6);
#define TIDX() ((s_wave << 6) | lane_id_now())
    XcdBarrier bar = xcd_barrier_post((unsigned*)(ws + WS_CTL), MISC + 8, TIDX());
    const int lo = args.ph_lo, hi = args.ph_hi;
#define IN(k) (lo <= (k) && (k) < hi)
#define SEAM(k) do { if (IN(k) && IN((k) + 1)) xcd_barrier(bar, TIDX()); } while (0)
#define MKCTX() Ctx X; { int t_ = TIDX(); asm volatile("" : "+v"(t_)); X.lds = (LAS unsigned char*)lds; X.tid = t_; X.lane = t_ & 63; X.wave = __builtin_amdgcn_readfirstlane(t_ >> 6); \
        X.G = gridDim.x; X.gw = blockIdx.x * NWAVES + X.wave; X.NGW = X.G * NWAVES; }
#define x_in args.in[0]
#define mod ((float*)(ws + WS_MOD))
#define ropetab ((float*)(ws + WS_MOD + 393216))
#define Wcat ((bf16*)(ws + WS_WCAT))
#define Wssm ((bf16*)(ws + WS_WSSM))
#define Watt ((bf16*)(ws + WS_WATT))
#define Wout ((bf16*)(ws + WS_WOUT))
#define Wup ((bf16*)(ws + WS_WUP))
#define Wdn ((bf16*)(ws + WS_WDN))
#define hbuf ((bf16*)(ws + WS_H))
#define zbuf ((bf16*)(ws + WS_Z))
#define edge1 ((float*)(ws + WS_EDGE1))
#define dtb ((float*)(ws + WS_DT))
#define qb ((bf16*)(ws + WS_Q))
#define kb ((bf16*)(ws + WS_K))
#define vb ((bf16*)(ws + WS_V))
#define gates ((bf16*)(ws + WS_GATES))
#define xbcc ((bf16*)(ws + WS_XBCC))
#define yfb ((bf16*)args.out)
#define ybb ((bf16*)(ws + WS_YB))
#define pm ((bf16*)(ws + WS_PM))
#define r1 ((float*)(ws + WS_R1))
#define st1 ((float*)(ws + WS_ST1))
#define h2 ((bf16*)(ws + WS_H2))
#define edgeb ((float*)(ws + WS_EDGE))
#define act ((bf16*)(ws + WS_ACT))

    if (IN(0)) { MKCTX();
        P0Args A{args.in[1], args.in[2], args.in[3], mod, ropetab, args.in[4], args.in[15], args.in[13], args.in[14], args.in[17], args.in[20], args.in[23], Wcat, Wssm, Watt, Wout, Wup, Wdn};
        phase_prologue(X, A, (unsigned*)(ws + WS_CTL));
    }
    if (IN(0) && IN(2)) arrivals_wait((unsigned*)(ws + WS_CTL), XB_GEMV_DONE, gridDim.x, TIDX());
    if (IN(2)) { MKCTX(); phase_h(X, x_in, mod, hbuf); }
    SEAM(2);
    if (IN(3)) { MKCTX();
        pg8::Gemm g{hbuf, Wcat, MTOK, CAT_COLS, D_MODEL}; pg8::StaticOrder S; S.init(MTOK, CAT_COLS, X.G, (int)blockIdx.x);
        pg8::EpiIn E{zbuf, xbcc, qb, kb, vb, gates, dtb, args.in[8], args.in[16], args.in[5], args.in[6], edge1};
        pg8::gemm_phase<pg8::EpiIn, pg8::StaticOrder, true, true>(X.lds, g, S, E, X.tid);
    }
    if (IN(3)) { MKCTX();
        { const int nwg = (MTOK / 256) * (CAT_COLS / 256), first = nwg % X.G; if (first) tail_transposes_mix(X, first, args.in[13], args.in[14], args.in[17], Wssm, Watt, Wout); else tail_transposes_mix(X, 0, args.in[13], args.in[14], args.in[17], Wssm, Watt, Wout); }
    }
    SEAM(3);
    if (IN(4)) { MKCTX();
        phase_xbc_fixup(X, edge1, args.in[5], args.in[6], xbcc);
        qk_norm_rope_rows(X, kb, AT_HKV, args.in[12], ropetab);
    }
    SEAM(4);
    if (IN(5)) { MKCTX();
        const bool xcd_map = (X.G == 256);
        const int up_pos = ((int)blockIdx.x & 7) % 5; int slot = 0;
        for (int u = blockIdx.x; u < BATCH * SSM_H * 2; u += X.G, ++slot) {
            if (slot == up_pos) { __syncthreads(); transposes_up_share(X, args.in[20], Wup); __syncthreads(); }
            int unit = u;
            if (xcd_map) { const int c = blockIdx.x, r = u >> 8, grp = c & 7, j = c >> 3; unit = ((r * SSM_H + grp * 16 + (j & 15)) << 1) | (j >> 4); }
            ssd::ssd_unit((LAS char*)X.lds, unit, xbcc, dtb, args.in[7], args.in[9], (unit & 1) ? ybb : yfb, X.tid);
        }
        if (slot <= up_pos) { __syncthreads(); transposes_up_share(X, args.in[20], Wup); __syncthreads(); }
        {
            auto unit_ptrs = [&](int u, size_t& qoff, size_t& koff, int& qblk) {
                qblk = u % (SEQ / 256); int hh = (u / (SEQ / 256)) % AT_HQ, b = u / ((SEQ / 256) * AT_HQ);
                if (xcd_map) { const int c = blockIdx.x, r = u >> 8, kvh_ = c & 7, j = (c >> 3) + 32 * (r & 1); b = r >> 1; hh = kvh_ * (AT_HQ / AT_HKV) + (j >> 4); qblk = j & 15; }
                const int kvh = hh / (AT_HQ / AT_HKV);
                qoff = ((size_t)b * SEQ + (size_t)qblk * 256) * (AT_HQ * AT_D) + (size_t)hh * AT_D; koff = (size_t)b * SEQ * (AT_HKV * AT_D) + (size_t)kvh * AT_D; };
            const int NU = BATCH * AT_HQ * (SEQ / 256);
            attn::AttnPre P; size_t qoff, koff; int qblk;
            if ((int)blockIdx.x < NU) { unit_ptrs(blockIdx.x, qoff, koff, qblk); attn::attn_prime(P, qb + qoff, kb + koff, vb + koff, X.tid); }
            for (int u = blockIdx.x; u < NU; u += X.G) {
                const bool has_next = u + X.G < NU; size_t qn = qoff, kn = koff; int qbn = qblk;
                if (has_next) unit_ptrs(u + X.G, qn, kn, qbn);
                attn::attn_dense_body(P, kb + koff, vb + koff, qb + qoff, SEQ, (char*)lds, args.in[11], ropetab, qblk * 256, X.tid, qb + qn, kb + kn, vb + kn, has_next);
                qoff = qn; koff = kn; qblk = qbn;
            }
        }
        __syncthreads();
    }
    SEAM(5);
    if (IN(6)) { MKCTX(); phase_ssm_combine(X, yfb, ybb, zbuf, args.in[10]); }
    SEAM(6);
    if (IN(7)) { MKCTX();
        pg8::Gemm g{zbuf, Wssm, MTOK, D_MODEL, SSM_DI}; pg8::StaticOrder S; S.init(MTOK, D_MODEL, X.G, (int)blockIdx.x);
        pg8::EpiMix E{gates, pm, 0};
        pg8::gemm_phase<pg8::EpiMix, pg8::StaticOrder, true, true>(X.lds, g, S, E, X.tid);
    }
    if (IN(8)) { MKCTX();
        pg8::Gemm g{qb, Watt, MTOK, D_MODEL, D_MODEL}; pg8::StaticOrder S; S.init(MTOK, D_MODEL, X.G, (int)blockIdx.x);
        pg8::EpiMix E{gates, pm, 1};
        pg8::gemm_phase<pg8::EpiMix, pg8::StaticOrder, true, true>(X.lds, g, S, E, X.tid);
    }
    SEAM(8);
    if (IN(9)) { MKCTX();
        pg8::Gemm g{pm, Wout, MTOK, D_MODEL, D_MODEL}; pg8::StaticOrder S; S.init(MTOK, D_MODEL, X.G, (int)blockIdx.x);
        pg8::EpiRes E{x_in, r1, mod + 2 * D_MODEL, DN_ALPHA};
        pg8::gemm_phase<pg8::EpiRes, pg8::StaticOrder, true, true>(X.lds, g, S, E, X.tid);
    }
    SEAM(9);
    if (IN(10)) { MKCTX(); phase_ln1(X, r1, args.in[18], args.in[19], mod, st1, h2); }
    SEAM(10);
    if (IN(11)) { MKCTX();
        pg8::Gemm g{h2, Wup, MTOK, FFN2, D_MODEL}; pg8::StaticOrder S; S.init(MTOK, FFN2, X.G, (int)blockIdx.x);
        pg8::EpiConvGate E{act, edgeb, args.in[21], args.in[22]};
        pg8::gemm_phase<pg8::EpiConvGate, pg8::StaticOrder, true, true>(X.lds, g, S, E, X.tid);
    }
    if (IN(11)) { MKCTX();
        { const int nwg = (MTOK / 256) * (FFN2 / 256), first = nwg % X.G; tail_transposes_down(X, first, args.in[23], Wdn); }
    }
    SEAM(11);
    if (IN(12)) { MKCTX(); phase_conv_fixup(X, edgeb, args.in[21], args.in[22], act); }
    SEAM(12);
    if (IN(13)) { MKCTX();
        pg8::Gemm g{act, Wdn, MTOK, D_MODEL, FFN}; pg8::StaticOrder S; S.init(MTOK, D_MODEL, X.G, (int)blockIdx.x);
        pg8::EpiResLn E{r1, st1, args.in[18], args.in[19], args.out, mod + 5 * D_MODEL, DN_ALPHA};
        pg8::gemm_phase<pg8::EpiResLn, pg8::StaticOrder, true, true>(X.lds, g, S, E, X.tid);
    }
    SEAM(13);
    if (IN(14)) { MKCTX(); phase_ln_final(X, args.out, args.in[24], args.in[25]); }
#undef IN
#undef SEAM
#undef MKCTX
#undef TIDX
#undef x_in
#undef mod
#undef ropetab
#undef Wcat
#undef Wssm
#undef Watt
#undef Wout
#undef Wup
#undef Wdn
#undef hbuf
#undef zbuf
#undef edge1
#undef dtb
#undef qb
#undef kb
#undef vb
#undef gates
#undef xbcc
#undef yfb
#undef ybb
#undef pm
#undef r1
#undef st1
#undef h2
#undef edgeb
#undef act
}

extern "C" void kernel_launch(void* const* d_in, const int* in_sizes, int n_in, void* d_out, int out_size, void* d_ws, size_t ws_size, hipStream_t stream) {
    static int grid = 0;
    if (grid == 0) {
        if (n_in != 26 || in_sizes[0] != MTOK * D_MODEL || out_size != MTOK * D_MODEL || ws_size < WS_END) {
            fprintf(stderr, "kernel_launch: shape mismatch (n_in %d in0 %d out %d ws %zu need %zu); nothing launched\n", n_in, n_in > 0 ? in_sizes[0] : -1, out_size, ws_size, (size_t)WS_END); grid = -1; return; }
        int dev = 0, cus = 0, per_cu = 0;
        if (hipGetDevice(&dev) != hipSuccess || hipDeviceGetAttribute(&cus, hipDeviceAttributeMultiprocessorCount, dev) != hipSuccess) { grid = -1; return; }
        if (hipFuncSetAttribute((const void*)mk_fwd, hipFuncAttributeMaxDynamicSharedMemorySize, LDS_BYTES) != hipSuccess) { fprintf(stderr, "kernel_launch: hipFuncSetAttribute failed\n"); grid = -1; return; }
        if (hipOccupancyMaxActiveBlocksPerMultiprocessor(&per_cu, (const void*)mk_fwd, NWAVES * 64, LDS_BYTES) != hipSuccess || per_cu < 1) { fprintf(stderr, "kernel_launch: occupancy query says %d blocks per CU\n", per_cu); }
        (void)hipGetLastError();
        grid = cus;
    }
    if (grid < 0) return;
    if (hipMemsetAsync((char*)d_ws + WS_CTL, 0, CTL_ZERO_BYTES, stream) != hipSuccess) return;
    Args a{};
    for (int i = 0; i < 26; ++i) a.in[i] = (const float*)d_in[i];
    a.out = (float*)d_out; a.ws = (unsigned char*)d_ws; a.ph_lo = 0; a.ph_hi = N_PHASES;
    hipLaunchKernelGGL(mk_fwd, dim3(grid), dim3(NWAVES * 64), LDS_BYTES, stream, a);
    const hipError_t le = hipPeekAtLastError();
    if (le != hipSuccess) fprintf(stderr, "kernel_launch: launch failed: %s\n", hipGetErrorName(le));
}
```

```cpp
#include <hip/hip_runtime.h>
#include <cstdio>
#include <cstdint>

#define GAS __attribute__((address_space(1)))
#define LAS __attribute__((address_space(3)))
typedef unsigned short bf16;
typedef unsigned v4u __attribute__((ext_vector_type(4)));
typedef unsigned v2u __attribute__((ext_vector_type(2)));
typedef float v4f __attribute__((ext_vector_type(4)));

constexpr int D_MODEL = 4096, BATCH = 4, SEQ = 4096, MTOK = BATCH * SEQ;
constexpr int GRID_W = 64;
constexpr int SSM_DI = 8192, SSM_HD = 64, SSM_H = 128, SSM_G = 8, SSM_N = 128, SSM_CONVD = 10240;
constexpr int AT_D = 128, AT_HQ = 32, AT_HKV = 8;
constexpr int FFN = 11008, FFN2 = 22016;
constexpr int IN_COLS = 24832, CAT_COLS = IN_COLS + 2 * D_MODEL;
constexpr float LN_EPS = 1e-5f, RMS_EPS = 1e-6f;
constexpr float DN_ALPHA = 1.189207115002721f;
constexpr int MOD_LD = 6 * D_MODEL;

__device__ __forceinline__ float bf2f(unsigned b) { return __uint_as_float(b << 16); }
__device__ __forceinline__ float bflo(unsigned w) { return __uint_as_float(w << 16); }
__device__ __forceinline__ float bfhi(unsigned w) { return __uint_as_float(w & 0xffff0000u); }
__device__ __forceinline__ unsigned pkbf(float lo, float hi) { unsigned r; asm volatile("v_cvt_pk_bf16_f32 %0, %1, %2" : "=v"(r) : "v"(lo), "v"(hi)); return r; }
__device__ __forceinline__ float sigmoidf_(float v) { return __builtin_amdgcn_rcpf(1.0f + __expf(-v)); }
__device__ __forceinline__ float siluf_(float v) { return v * __builtin_amdgcn_rcpf(1.0f + __expf(-v)); }
__device__ __forceinline__ float softplusf_(float v) { return v > 20.f ? v : log1pf(__expf(v)); }
__device__ __forceinline__ float wave_sum(float v) {
#pragma unroll
    for (int o = 1; o < 64; o <<= 1) v += __shfl_xor(v, o);
    return v;
}
__device__ __forceinline__ int lane_id_now() { int l; asm volatile("v_mbcnt_lo_u32_b32 %0, -1, 0\n\tv_mbcnt_hi_u32_b32 %0, -1, %0" : "=v"(l)); return l; }
namespace pg8 {
#define PG8_LAS __attribute__((address_space(3)))
typedef unsigned short bf16_t;
typedef short bf16x8 __attribute__((ext_vector_type(8)));
typedef float f32x4 __attribute__((ext_vector_type(4)));
typedef unsigned u32x4 __attribute__((ext_vector_type(4)));
constexpr int BM = 256, BK = 64, HALF = 128, HTB = HALF * BK * 2  , STAGE_BYTES = 8 * HTB, NXCD = 8, WGM = 8;

__host__ __device__ __forceinline__ int lds_byte(int r, int c) { const int st = (r >> 4) * 2 + (c >> 5), rr = r & 15, cc = c & 31, ob = rr * 64 + cc * 2; return st * 1024 + (ob ^ (((ob >> 9) & 1) << 5)); }
__host__ __device__ __forceinline__ void stage_rc(int b, int& R, int& C) { const int st = b / 1024, sb = b % 1024, swz = sb ^ (((sb >> 9) & 1) << 5); R = (st >> 1) * 16 + swz / 64; C = (st & 1) * 32 + (swz % 64) / 2; }
__host__ __device__ __forceinline__ int perm32(int rho) { const int n = rho >> 4, i = rho & 15; return 8 * (i >> 2) + 4 * n + (i & 3); }

struct Unit { int pm, pn; };
struct Gemm { const bf16_t* A; const bf16_t* Bt; int M, N, K; };

struct StaticOrder {
    int nM, nN, nwg, G, c;
    __host__ __device__ void init(int M, int N, int G_, int c_) { nM = M / BM; nN = N / BM; nwg = nM * nN; G = G_; c = c_; }
    __host__ __device__ bool next(int i, Unit& u) const {
        const long L = (long)i * G + c; if (L >= nwg) return false;
        int wgid = (int)L; { const int q = nwg / NXCD, r = nwg % NXCD, xcd = wgid % NXCD, off = wgid / NXCD; wgid = (xcd < r ? xcd * (q + 1) : r * (q + 1) + (xcd - r) * q) + off; }
        const int nig = WGM * nN, gid = wgid / nig, fm = gid * WGM, gsz = (nM - fm) < WGM ? (nM - fm) : WGM;
        u.pm = fm + ((wgid % nig) % gsz); u.pn = (wgid % nig) / gsz; return true;
    }
    __device__ __forceinline__ void a_ready(const Unit&) const {}
    __device__ __forceinline__ void done(const Unit&) const {}
};

__device__ __forceinline__ unsigned cvt_pk_bf16(float lo, float hi) { unsigned r; asm volatile("v_cvt_pk_bf16_f32 %0, %1, %2" : "=v"(r) : "v"(lo), "v"(hi)); return r; }
typedef float f32x2 __attribute__((ext_vector_type(2)));
__device__ __forceinline__ void st8bf(bf16_t* p, const f32x4& v0, const f32x4& v1) {
    u32x4 w; w.x = cvt_pk_bf16(v0[0], v0[1]); w.y = cvt_pk_bf16(v0[2], v0[3]); w.z = cvt_pk_bf16(v1[0], v1[1]); w.w = cvt_pk_bf16(v1[2], v1[3]);
    *(u32x4*)p = w;
}
__device__ __forceinline__ void ld8bf(const bf16_t* p, f32x4& v0, f32x4& v1) {
    const u32x4 w = *(const u32x4*)p;
    v0 = (f32x4){__uint_as_float(w.x << 16), __uint_as_float(w.x & 0xffff0000u), __uint_as_float(w.y << 16), __uint_as_float(w.y & 0xffff0000u)};
    v1 = (f32x4){__uint_as_float(w.z << 16), __uint_as_float(w.z & 0xffff0000u), __uint_as_float(w.w << 16), __uint_as_float(w.w & 0xffff0000u)};
}
__device__ __forceinline__ float epi_sigmoid(float v) { return __builtin_amdgcn_rcpf(1.0f + __expf(-v)); }
__device__ __forceinline__ float epi_softplus(float v) { return v > 20.f ? v : log1pf(__expf(v)); }

__device__ __forceinline__ float dpp_prev(float v) { return __uint_as_float((unsigned)__builtin_amdgcn_update_dpp(0, (int)__float_as_uint(v), 0x111, 0xF, 0xF, true)); }
__device__ __forceinline__ float dpp_next(float v) { return __uint_as_float((unsigned)__builtin_amdgcn_update_dpp(0, (int)__float_as_uint(v), 0x101, 0xF, 0xF, true)); }
__device__ __forceinline__ f32x4 dpp_prev4(const f32x4& v) { return (f32x4){dpp_prev(v[0]), dpp_prev(v[1]), dpp_prev(v[2]), dpp_prev(v[3])}; }
__device__ __forceinline__ f32x4 dpp_next4(const f32x4& v) { return (f32x4){dpp_next(v[0]), dpp_next(v[1]), dpp_next(v[2]), dpp_next(v[3])}; }
struct EpiIn {
    static constexpr bool PERM = true, AFTER_DRAIN = false, APERM = true;
    bf16_t *z, *xbc, *q, *k, *v, *gates; float* dt; const float* dt_bias; const float* b_gate; const float* cw; const float* cb; float* edge;
    __device__ __forceinline__ void operator()(const f32x4 (&acc)[2][2][4][2], const Unit& u, int wr, int wc, int fr, int fq) const {
        const int pn = u.pn, row0 = u.pm * BM + wr * 128 + fr * 8, cw_ = wc * 32 + 8 * fq;
        if (pn == 72) {
#pragma unroll
            for (int bj = 0; bj < 2; ++bj) { const int col = cw_ + bj * HALF; const f32x4 b0 = *(const f32x4*)(dt_bias + col), b1 = *(const f32x4*)(dt_bias + col + 4);
#pragma unroll
                for (int ai = 0; ai < 2; ++ai)
#pragma unroll
                    for (int m = 0; m < 4; ++m) { f32x4 v0 = acc[ai][bj][m][0] + b0, v1 = acc[ai][bj][m][1] + b1;
#pragma unroll
                        for (int j = 0; j < 4; ++j) { v0[j] = epi_softplus(v0[j]); v1[j] = epi_softplus(v1[j]); }
                        float* p = dt + (size_t)(row0 + ai * 4 + m) * 256 + col; *(f32x4*)p = v0; *(f32x4*)(p + 4) = v1; } }
            return;
        }
        if (pn >= 32 && pn < 72) {
            const int seg = 2 * u.pm + wr;
#pragma unroll
            for (int bj = 0; bj < 2; ++bj)
#pragma unroll
                for (int n = 0; n < 2; ++n) {
                    const int ch = (pn - 32) * 256 + bj * HALF + cw_ + 4 * n;
                    const f32x4 w0 = *(const f32x4*)(cw + ch), w1 = *(const f32x4*)(cw + 10240 + ch), w2 = *(const f32x4*)(cw + 2 * 10240 + ch), bb = *(const f32x4*)(cb + ch);
#pragma unroll
                    for (int kk = 0; kk < 8; ++kk) {
                        const f32x4 um = (kk == 0) ? dpp_prev4(acc[1][bj][3][n]) : acc[(kk - 1) >> 2][bj][(kk - 1) & 3][n], up = (kk == 7) ? dpp_next4(acc[0][bj][0][n]) : acc[(kk + 1) >> 2][bj][(kk + 1) & 3][n];
                        const f32x4 c4 = um * w0 + acc[kk >> 2][bj][kk & 3][n] * w1 + up * w2 + bb;
                        typedef unsigned u32x2_ __attribute__((ext_vector_type(2)));
                        u32x2_ w; w.x = cvt_pk_bf16(c4[0] * epi_sigmoid(c4[0]), c4[1] * epi_sigmoid(c4[1])); w.y = cvt_pk_bf16(c4[2] * epi_sigmoid(c4[2]), c4[3] * epi_sigmoid(c4[3]));
                        *(u32x2_*)(xbc + (size_t)(row0 + kk) * 10240 + ch) = w;
                    }
                    if (fr == 0) { float* ep = edge + ((size_t)seg * 4 + 0) * 10240 + ch; *(f32x4*)ep = acc[0][bj][0][n]; *(f32x4*)(ep + 10240) = acc[0][bj][1][n]; }
                    if (fr == 15) { float* ep = edge + ((size_t)seg * 4 + 2) * 10240 + ch; *(f32x4*)ep = acc[1][bj][2][n]; *(f32x4*)(ep + 10240) = acc[1][bj][3][n]; }
                    asm volatile("" ::: "memory");
                }
            return;
        }
        bf16_t* base; int ldc, colt, mode = 0;
        if (pn < 32) { base = z; ldc = 8192; colt = pn * 256; }
        else if (pn < 89) { base = q; ldc = 4096; colt = (pn - 73) * 256; }
        else if (pn < 93) { base = k; ldc = 1024; colt = (pn - 89) * 256; }
        else if (pn < 97) { base = v; ldc = 1024; colt = (pn - 93) * 256; }
        else { base = gates; ldc = 8192; colt = (pn - 97) * 256; mode = 2; }
        f32x4 bv[2][2];
#pragma unroll
        for (int bj = 0; bj < 2; ++bj)
#pragma unroll
            for (int n = 0; n < 2; ++n) bv[bj][n] = (mode == 2) ? *(const f32x4*)(b_gate + colt + cw_ + bj * HALF + 4 * n) : (f32x4){0.f, 0.f, 0.f, 0.f};
#pragma unroll
        for (int ai = 0; ai < 2; ++ai)
#pragma unroll
            for (int m = 0; m < 4; ++m) { bf16_t* rowp = base + (size_t)(row0 + ai * 4 + m) * ldc + colt + cw_;
#pragma unroll
                for (int bj = 0; bj < 2; ++bj) { f32x4 v0 = acc[ai][bj][m][0] + bv[bj][0], v1 = acc[ai][bj][m][1] + bv[bj][1];
                    st8bf(rowp + bj * HALF, v0, v1); } }
    }
};
struct EpiMix {
    static constexpr bool PERM = true, AFTER_DRAIN = false, APERM = false;
    const bf16_t* gates; bf16_t* pm; int second;
    __device__ __forceinline__ void operator()(const f32x4 (&acc)[2][2][4][2], const Unit& u, int wr, int wc, int fr, int fq) const {
        const int row0 = u.pm * BM + wr * 64 + fr, col0 = u.pn * BM + wc * 32 + 8 * fq;
#pragma unroll
        for (int ai = 0; ai < 2; ++ai)
#pragma unroll
            for (int m = 0; m < 4; ++m) { const size_t row = (size_t)(row0 + ai * HALF + m * 16);
#pragma unroll
                for (int bj = 0; bj < 2; ++bj) { const int col = col0 + bj * HALF; f32x4 g0, g1; ld8bf(gates + row * 8192 + second * 4096 + col, g0, g1);
#pragma unroll
                    for (int j = 0; j < 4; ++j) { g0[j] = epi_sigmoid(g0[j]); g1[j] = epi_sigmoid(g1[j]); }

                    f32x4 v0 = acc[ai][bj][m][0] * g0, v1 = acc[ai][bj][m][1] * g1;
                    if (second) { f32x4 p0, p1; ld8bf(pm + row * 4096 + col, p0, p1); v0 += p0; v1 += p1; }
                    st8bf(pm + row * 4096 + col, v0, v1); } }
    }
};
struct EpiRes {
    static constexpr bool PERM = true, AFTER_DRAIN = false, APERM = false;
    const float* base; float* out; const float* gate; float alpha;
    __device__ __forceinline__ void operator()(const f32x4 (&acc)[2][2][4][2], const Unit& u, int wr, int wc, int fr, int fq) const {
        const int row0 = u.pm * BM + wr * 64 + fr, col0 = u.pn * BM + wc * 32 + 8 * fq;
        const float* g = gate + (size_t)(u.pm >> 4) * 24576;
#pragma unroll
        for (int bj = 0; bj < 2; ++bj) { const int col = col0 + bj * HALF; const f32x4 g0 = *(const f32x4*)(g + col), g1 = *(const f32x4*)(g + col + 4);
#pragma unroll
            for (int ai = 0; ai < 2; ++ai)
#pragma unroll
                for (int m = 0; m < 4; ++m) { const size_t off = (size_t)(row0 + ai * HALF + m * 16) * 4096 + col;
                    const f32x4 x0 = *(const f32x4*)(base + off), x1 = *(const f32x4*)(base + off + 4);
                    *(f32x4*)(out + off) = x0 * alpha + g0 * acc[ai][bj][m][0]; *(f32x4*)(out + off + 4) = x1 * alpha + g1 * acc[ai][bj][m][1]; } }
    }
};
struct EpiConvGate {
    static constexpr bool PERM = true, AFTER_DRAIN = false, APERM = true;
    bf16_t* act; float* edge; const float* cw; const float* cb;
    __device__ __forceinline__ void operator()(const f32x4 (&acc)[2][2][4][2], const Unit& u, int wr, int wc, int fr, int fq) const {
        const int tok0 = u.pm * BM + wr * 128 + fr * 8, seg = 2 * u.pm + wr;
#pragma unroll
        for (int n = 0; n < 2; ++n) {
            const int ch = u.pn * 128 + wc * 32 + 8 * fq + 4 * n;
            const f32x4 wa0 = *(const f32x4*)(cw + ch), wa1 = *(const f32x4*)(cw + 22016 + ch), wa2 = *(const f32x4*)(cw + 2 * 22016 + ch), ba = *(const f32x4*)(cb + ch);
            const f32x4 wb0 = *(const f32x4*)(cw + 11008 + ch), wb1 = *(const f32x4*)(cw + 22016 + 11008 + ch), wb2 = *(const f32x4*)(cw + 2 * 22016 + 11008 + ch), bb = *(const f32x4*)(cb + 11008 + ch);
#pragma unroll
            for (int k = 0; k < 8; ++k) {
                const f32x4 ua_m = (k == 0) ? dpp_prev4(acc[1][0][3][n]) : acc[(k - 1) >> 2][0][(k - 1) & 3][n], ua_p = (k == 7) ? dpp_next4(acc[0][0][0][n]) : acc[(k + 1) >> 2][0][(k + 1) & 3][n];
                const f32x4 ub_m = (k == 0) ? dpp_prev4(acc[1][1][3][n]) : acc[(k - 1) >> 2][1][(k - 1) & 3][n], ub_p = (k == 7) ? dpp_next4(acc[0][1][0][n]) : acc[(k + 1) >> 2][1][(k + 1) & 3][n];
                const f32x4 ca = ua_m * wa0 + acc[k >> 2][0][k & 3][n] * wa1 + ua_p * wa2 + ba;
                const f32x4 cb_ = ub_m * wb0 + acc[k >> 2][1][k & 3][n] * wb1 + ub_p * wb2 + bb;
                f32x4 o;
#pragma unroll
                for (int j = 0; j < 4; ++j) o[j] = ca[j] * epi_sigmoid(ca[j]) * cb_[j];
                typedef unsigned u32x2_ __attribute__((ext_vector_type(2)));
                u32x2_ w; w.x = cvt_pk_bf16(o[0], o[1]); w.y = cvt_pk_bf16(o[2], o[3]);
                *(u32x2_*)(act + (size_t)(tok0 + k) * 11008 + ch) = w;
            }
            const int tc = u.pn * 256 + wc * 32 + 8 * fq + 4 * n;
            if (fr == 0) { float* ep = edge + ((size_t)seg * 4 + 0) * 22016 + tc;
                *(f32x4*)ep = acc[0][0][0][n]; *(f32x4*)(ep + 128) = acc[0][1][0][n]; *(f32x4*)(ep + 22016) = acc[0][0][1][n]; *(f32x4*)(ep + 22016 + 128) = acc[0][1][1][n]; }
            if (fr == 15) { float* ep = edge + ((size_t)seg * 4 + 2) * 22016 + tc;
                *(f32x4*)ep = acc[1][0][2][n]; *(f32x4*)(ep + 128) = acc[1][1][2][n]; *(f32x4*)(ep + 22016) = acc[1][0][3][n]; *(f32x4*)(ep + 22016 + 128) = acc[1][1][3][n]; }
            asm volatile("" ::: "memory");
        }
    }
};
struct EpiResLn {
    static constexpr bool PERM = true, AFTER_DRAIN = false, APERM = false;
    const float* r1; const float* stats; const float* ln_g; const float* ln_b; float* out; const float* gate; float alpha;
    __device__ __forceinline__ void operator()(const f32x4 (&acc)[2][2][4][2], const Unit& u, int wr, int wc, int fr, int fq) const {
        typedef float f2_ __attribute__((ext_vector_type(2)));
        const int row0 = u.pm * BM + wr * 64 + fr, col0 = u.pn * BM + wc * 32 + 8 * fq;
        const float* g = gate + (size_t)(u.pm >> 4) * 24576;
#pragma unroll
        for (int bj = 0; bj < 2; ++bj) { const int col = col0 + bj * HALF; const f32x4 g0 = *(const f32x4*)(g + col), g1 = *(const f32x4*)(g + col + 4);
            const f32x4 a0 = *(const f32x4*)(ln_g + col) * alpha, a1 = *(const f32x4*)(ln_g + col + 4) * alpha, b0 = *(const f32x4*)(ln_b + col) * alpha, b1 = *(const f32x4*)(ln_b + col + 4) * alpha;
#pragma unroll
            for (int ai = 0; ai < 2; ++ai)
#pragma unroll
                for (int m = 0; m < 4; ++m) { const size_t row = (size_t)(row0 + ai * HALF + m * 16), off = row * 4096 + col; const f2_ st = *(const f2_*)(stats + 2 * row); const float mean = st.x, rstd = st.y;
                    const f32x4 x0 = (*(const f32x4*)(r1 + off) - mean) * rstd, x1 = (*(const f32x4*)(r1 + off + 4) - mean) * rstd;
                    *(f32x4*)(out + off) = x0 * a0 + b0 + g0 * acc[ai][bj][m][0]; *(f32x4*)(out + off + 4) = x1 * a1 + b1 + g1 * acc[ai][bj][m][1]; } }
    }
};
template <class Epi, class Sched, bool ALIGN_EPI = false, bool SP2 = false>
__device__ __forceinline__ void gemm_phase(PG8_LAS unsigned char* lds, const Gemm g, const Sched& S, const Epi& E, int tid_in) {
    int tid_l = tid_in; asm volatile("" : "+v"(tid_l));
    const int tid = tid_l, wid = __builtin_amdgcn_readfirstlane(tid >> 6), lane = tid & 63, wr = wid >> 2, wc = wid & 3, fr = lane & 15, fq = lane >> 4;
    const int K = g.K, nt = K / BK;
    unsigned voffA[2], voffB[2];
#pragma unroll
    for (int i = 0; i < 2; ++i) { int R, C; stage_rc(tid * 16 + i * 8192, R, C); const int Rb = Epi::PERM ? ((R & ~31) + perm32(R & 31)) : R;
        const int Ra = Epi::APERM ? (128 * (R >> 6) + 8 * (R & 15) + ((R >> 4) & 3)) : R;
        voffA[i] = (unsigned)(Ra * K + C) * 2u; voffB[i] = (unsigned)(Rb * K + C) * 2u; }
    const size_t kstep = (size_t)(BK * 2);
    const size_t hstep = (size_t)HALF * K * 2;
    const size_t tstep = 2 * hstep;
    const size_t hstepA = Epi::APERM ? (size_t)4 * K * 2 : hstep;
    const unsigned ldsw = (unsigned)wid * 1024u;
    const int aoff = lds_byte(wr * 64 + fr, fq * 8), boff = lds_byte(wc * 32 + fr, fq * 8);
#define PG8_SA(b, h) (((b) * 2 + (h)) * HTB)
#define PG8_SB(b, h) ((4 + (b) * 2 + (h)) * HTB)
#define PG8_STAGE(bufoff, gbase, voff) do { _Pragma("unroll") for (int _i = 0; _i < 2; ++_i) \
        __builtin_amdgcn_global_load_lds((const unsigned*)((const char*)(gbase) + (voff)[_i]), (PG8_LAS unsigned*)(lds + (bufoff) + ldsw + _i * 8192), 16, 0, 0); } while (0)
#define PG8_LDA(dst, b, h) do { _Pragma("unroll") for (int m = 0; m < 4; ++m) _Pragma("unroll") for (int k = 0; k < 2; ++k) dst[m][k] = *(const PG8_LAS bf16x8*)(lds + PG8_SA(b, h) + aoff + m * 2048 + k * 1024); } while (0)
#define PG8_LDB(dst, b, h) do { _Pragma("unroll") for (int n = 0; n < 2; ++n) _Pragma("unroll") for (int k = 0; k < 2; ++k) dst[n][k] = *(const PG8_LAS bf16x8*)(lds + PG8_SB(b, h) + boff + n * 2048 + k * 1024); } while (0)
#define PG8_MMA(ai, bj, At, Bt) do { __builtin_amdgcn_s_setprio(1); _Pragma("unroll") for (int m = 0; m < 4; ++m) _Pragma("unroll") for (int n = 0; n < 2; ++n) { _Pragma("unroll") for (int k = 0; k < 2; ++k) \
        acc[ai][bj][m][n] = __builtin_amdgcn_mfma_f32_16x16x32_bf16(Bt[n][k], At[m][k], acc[ai][bj][m][n], 0, 0, 0); __builtin_amdgcn_sched_barrier(0); } __builtin_amdgcn_s_setprio(0); } while (0)
#define PG8_WAIT_V(n) asm volatile("s_waitcnt vmcnt(" #n ")" ::: "memory")
#define PG8_WAIT_L(n) asm volatile("s_waitcnt lgkmcnt(" #n ")" ::: "memory")
#define PG8_BAR __builtin_amdgcn_s_barrier()
#define PG8_SCHED __builtin_amdgcn_sched_barrier(0)
    Unit cur, nxt; int ui = 0;
    if (!S.next(0, cur)) return;
    f32x4 acc[2][2][4][2];
#pragma unroll
    for (int a = 0; a < 2; ++a)
#pragma unroll
        for (int b = 0; b < 2; ++b)
#pragma unroll
            for (int m = 0; m < 4; ++m)
#pragma unroll
                for (int n = 0; n < 2; ++n) acc[a][b][m][n] = (f32x4){0.f, 0.f, 0.f, 0.f};
    bf16x8 At[4][2], B0[2][2], B1[2][2];
    const char* cA = (const char*)g.A + (size_t)cur.pm * tstep; const char* cB = (const char*)g.Bt + (size_t)cur.pn * tstep;
    S.a_ready(cur);
    if constexpr (SP2) {
        PG8_STAGE(PG8_SB(0, 0), cB, voffB); PG8_STAGE(PG8_SB(0, 1), cB + hstep, voffB); PG8_STAGE(PG8_SA(0, 0), cA, voffA); PG8_STAGE(PG8_SA(0, 1), cA + hstepA, voffA);
        if (wr == 1) PG8_BAR;
        PG8_WAIT_V(2); PG8_BAR;
        PG8_STAGE(PG8_SB(1, 0), cB + kstep, voffB); PG8_STAGE(PG8_SA(1, 0), cA + kstep, voffA); PG8_STAGE(PG8_SB(1, 1), cB + hstep + kstep, voffB);
        PG8_WAIT_V(6); PG8_BAR;
    } else {
        PG8_STAGE(PG8_SB(0, 0), cB, voffB); PG8_STAGE(PG8_SA(0, 0), cA, voffA); PG8_STAGE(PG8_SB(0, 1), cB + hstep, voffB); PG8_STAGE(PG8_SA(0, 1), cA + hstepA, voffA);
        if (wr == 1) PG8_BAR;
        PG8_WAIT_V(4); PG8_BAR;
        PG8_STAGE(PG8_SB(1, 0), cB + kstep, voffB); PG8_STAGE(PG8_SA(1, 0), cA + kstep, voffA); PG8_STAGE(PG8_SB(1, 1), cB + hstep + kstep, voffB);
        PG8_WAIT_V(6); PG8_BAR;
    }
    for (;;) {
        const bool has_next = S.next(ui + 1, nxt);
        const char* nA = has_next ? (const char*)g.A + (size_t)nxt.pm * tstep : cA; const char* nB = has_next ? (const char*)g.Bt + (size_t)nxt.pn * tstep : cB;
        for (int t = 0; t < nt; t += 2) {
            const bool last = (t == nt - 2);
            const char* a1 = cA + (size_t)(t + 1) * kstep;
            const char* a2 = last ? nA : cA + (size_t)(t + 2) * kstep; const char* b2 = last ? nB : cB + (size_t)(t + 2) * kstep;
            const char* a3 = a2 + kstep; const char* b3 = b2 + kstep;
            if (last && has_next) S.a_ready(nxt);
            if constexpr (SP2) {
            PG8_LDB(B0, 0, 0); PG8_LDB(B1, 0, 1); PG8_SCHED; PG8_LDA(At, 0, 0); PG8_STAGE(PG8_SA(1, 1), a1 + hstepA, voffA);
            PG8_WAIT_V(8); PG8_WAIT_L(0); PG8_BAR; PG8_MMA(0, 0, At, B0); PG8_MMA(0, 1, At, B1); PG8_BAR; PG8_SCHED;
            PG8_LDA(At, 0, 1); PG8_STAGE(PG8_SB(0, 0), b2, voffB); PG8_STAGE(PG8_SB(0, 1), b2 + hstep, voffB); PG8_STAGE(PG8_SA(0, 0), a2, voffA);
            PG8_WAIT_V(8); PG8_WAIT_L(0); PG8_BAR; PG8_MMA(1, 0, At, B0); PG8_MMA(1, 1, At, B1); PG8_BAR; PG8_SCHED;
            PG8_LDB(B0, 1, 0); PG8_LDB(B1, 1, 1); PG8_SCHED; PG8_LDA(At, 1, 0); PG8_STAGE(PG8_SA(0, 1), a2 + hstepA, voffA);
            PG8_WAIT_V(8); PG8_WAIT_L(0); PG8_BAR; PG8_MMA(0, 0, At, B0); PG8_MMA(0, 1, At, B1); PG8_BAR; PG8_SCHED;
            PG8_LDA(At, 1, 1); PG8_STAGE(PG8_SB(1, 0), b3, voffB); PG8_STAGE(PG8_SB(1, 1), b3 + hstep, voffB); PG8_STAGE(PG8_SA(1, 0), a3, voffA);
            PG8_WAIT_V(8); PG8_WAIT_L(0); PG8_BAR; PG8_MMA(1, 0, At, B0); PG8_MMA(1, 1, At, B1); PG8_BAR; PG8_SCHED;
            } else {
            PG8_LDB(B0, 0, 0); PG8_SCHED; PG8_LDA(At, 0, 0); PG8_STAGE(PG8_SA(1, 1), a1 + hstepA, voffA);
            PG8_WAIT_L(8); PG8_BAR; PG8_WAIT_L(0); PG8_MMA(0, 0, At, B0); PG8_BAR; PG8_SCHED;
            PG8_LDB(B1, 0, 1); PG8_STAGE(PG8_SB(0, 0), b2, voffB);
            PG8_BAR; PG8_WAIT_L(0); PG8_MMA(0, 1, At, B1); PG8_BAR;
            PG8_LDA(At, 0, 1); PG8_STAGE(PG8_SA(0, 0), a2, voffA);
            PG8_BAR; PG8_WAIT_L(0); PG8_MMA(1, 0, At, B0); PG8_BAR; PG8_SCHED;
            PG8_STAGE(PG8_SB(0, 1), b2 + hstep, voffB);
            PG8_WAIT_V(6); PG8_BAR; PG8_MMA(1, 1, At, B1); PG8_BAR;
            PG8_LDB(B0, 1, 0); PG8_SCHED; PG8_LDA(At, 1, 0); PG8_STAGE(PG8_SA(0, 1), a2 + hstepA, voffA);
            PG8_WAIT_L(8); PG8_BAR; PG8_WAIT_L(0); PG8_MMA(0, 0, At, B0); PG8_BAR; PG8_SCHED;
            PG8_LDB(B1, 1, 1); PG8_STAGE(PG8_SB(1, 0), b3, voffB);
            PG8_BAR; PG8_WAIT_L(0); PG8_MMA(0, 1, At, B1); PG8_BAR;
            PG8_LDA(At, 1, 1); PG8_STAGE(PG8_SA(1, 0), a3, voffA);
            PG8_BAR; PG8_WAIT_L(0); PG8_MMA(1, 0, At, B0); PG8_BAR; PG8_SCHED;
            PG8_STAGE(PG8_SB(1, 1), b3 + hstep, voffB);
            PG8_WAIT_V(6); PG8_BAR; PG8_MMA(1, 1, At, B1); PG8_BAR;
            }
        }
        if constexpr (ALIGN_EPI) { if (wr == 0) PG8_BAR; }
        if constexpr (!Epi::AFTER_DRAIN) { E(acc, cur, wr, wc, fr, fq); S.done(cur); }
        if (!has_next) break;
#pragma unroll
        for (int a = 0; a < 2; ++a)
#pragma unroll
            for (int b = 0; b < 2; ++b)
#pragma unroll
                for (int m = 0; m < 4; ++m)
#pragma unroll
                    for (int n = 0; n < 2; ++n) acc[a][b][m][n] = (f32x4){0.f, 0.f, 0.f, 0.f};
        cur = nxt; cA = nA; cB = nB; ++ui;
        if constexpr (ALIGN_EPI) { if (wr == 1) PG8_BAR; }
    }
    PG8_WAIT_V(0);
    if constexpr (!ALIGN_EPI) { if (wr == 0) PG8_BAR; }
    PG8_BAR;
    if constexpr (Epi::AFTER_DRAIN) { E.fused(acc, cur, wr, wc, fr, fq, lds, wid, lane); S.done(cur); }
#undef PG8_SA
#undef PG8_SB
#undef PG8_STAGE
#undef PG8_LDA
#undef PG8_LDB
#undef PG8_MMA
#undef PG8_WAIT_V
#undef PG8_WAIT_L
#undef PG8_BAR
#undef PG8_SCHED
}
}
namespace attn {
constexpr int D = 128, NW = 8, QBLK = 32, KVBLK = 64;
constexpr float SCALE = 0.088388347648318440f;
constexpr float THR = 8.f;
constexpr int SDEPTH = 2;
constexpr int LDQ = AT_HQ * D, LDK = AT_HKV * D, LDO = LDQ;
constexpr size_t SHM_V = KVBLK * D * 2, SHM_K = KVBLK * D * 2, SHM_ATTN = 2 * SHM_V + 2 * SHM_K + NW * 64 * 4;
using bf16x8 = __attribute__((ext_vector_type(8))) short;
using s16x4  = __attribute__((ext_vector_type(4))) short;
using f32x16 = __attribute__((ext_vector_type(16))) float;
using u32x4  = __attribute__((ext_vector_type(4))) unsigned;
#define KSWZ(row, colB) ((row) * 256 + ((colB) ^ (((row) & 7) << 4)))
#define SBAR() __builtin_amdgcn_sched_barrier(0)
__device__ __forceinline__ int crow(int r, int hi) { return (r & 3) + 8 * (r >> 2) + 4 * hi; }
__device__ __forceinline__ unsigned cvtpk(float lo, float hi) { unsigned r; asm volatile("v_cvt_pk_bf16_f32 %0, %1, %2" : "=v"(r) : "v"(lo), "v"(hi)); return r; }
__device__ __forceinline__ bf16x8 ld8(const bf16* p) { return *reinterpret_cast<const bf16x8*>(p); }

__device__ __forceinline__ void partialSM(f32x16& p0, f32x16& p1, float& m_reg, float& mn, float& alpha) {
  constexpr float C = SCALE * 1.4426950408889634f;
  float pmax = p0[0];
#pragma unroll
  for (int r = 1; r < 16; ++r) pmax = fmaxf(pmax, p0[r]);
#pragma unroll
  for (int r = 0; r < 16; ++r) pmax = fmaxf(pmax, p1[r]);
  { auto rr = __builtin_amdgcn_permlane32_swap(__float_as_uint(pmax), __float_as_uint(pmax), false, false);
    pmax = fmaxf(__uint_as_float(rr[0]), __uint_as_float(rr[1])); }
  if (__builtin_expect(__all(pmax - m_reg <= THR / SCALE), 1)) { mn = m_reg; alpha = 1.f; }
  else { mn = fmaxf(m_reg, pmax); alpha = __builtin_amdgcn_exp2f((m_reg - mn) * C); m_reg = mn; }
  float mnC = -mn * C;
#pragma unroll
  for (int r = 0; r < 16; ++r) p0[r] = fmaf(p0[r], C, mnC);
#pragma unroll
  for (int r = 0; r < 16; ++r) p1[r] = fmaf(p1[r], C, mnC);
#pragma unroll
  for (int r = 0; r < 16; ++r) p0[r] = __builtin_amdgcn_exp2f(p0[r]);
}
__device__ __forceinline__ void finishSM(f32x16& p0, f32x16& p1, float alpha, float& l_reg, bf16x8& pa0, bf16x8& pa1, bf16x8& pa2, bf16x8& pa3) {
#pragma unroll
  for (int r = 0; r < 16; ++r) p1[r] = __builtin_amdgcn_exp2f(p1[r]);
  float ps = 0;
#pragma unroll
  for (int r = 0; r < 16; ++r) ps += p0[r];
#pragma unroll
  for (int r = 0; r < 16; ++r) ps += p1[r];
  { auto rr = __builtin_amdgcn_permlane32_swap(__float_as_uint(ps), __float_as_uint(ps), false, false);
    ps = __uint_as_float(rr[0]) + __uint_as_float(rr[1]); }
  l_reg = l_reg * alpha + ps;
#define PK4(P, BASE, OUT) do { unsigned a0 = cvtpk(P[BASE + 0], P[BASE + 1]), a1 = cvtpk(P[BASE + 2], P[BASE + 3]);   \
    unsigned b0 = cvtpk(P[BASE + 4], P[BASE + 5]), b1 = cvtpk(P[BASE + 6], P[BASE + 7]);                              \
    auto r0 = __builtin_amdgcn_permlane32_swap(a0, b0, false, false); auto r1 = __builtin_amdgcn_permlane32_swap(a1, b1, false, false); \
    u32x4 w = {r0[0], r1[0], r0[1], r1[1]}; OUT = *reinterpret_cast<bf16x8*>(&w); } while (0)
  PK4(p0, 0, pa0); PK4(p0, 8, pa1); PK4(p1, 0, pa2); PK4(p1, 8, pa3);
#undef PK4
}
__device__ __forceinline__ void qkt(f32x16& p0, f32x16& p1, const bf16* Ks, const bf16x8* qr, int r32, int hi) {
  p0 = f32x16{}; p1 = f32x16{};
#pragma unroll
  for (int d0 = 0; d0 < 8; ++d0) { int cb = (d0 * 16 + hi * 8) * 2;
    bf16x8 b0 = *reinterpret_cast<const bf16x8*>((const char*)Ks + KSWZ(r32, cb));
    bf16x8 b1 = *reinterpret_cast<const bf16x8*>((const char*)Ks + KSWZ(32 + r32, cb));
    p0 = __builtin_amdgcn_mfma_f32_32x32x16_bf16(b0, qr[d0], p0, 0, 0, 0);
    p1 = __builtin_amdgcn_mfma_f32_32x32x16_bf16(b1, qr[d0], p1, 0, 0, 0); }
}
__device__ __forceinline__ int v_st(int k, int c) { const int kk = (k & ~0xC) | ((k & 4) << 1) | ((k & 8) >> 1); return ((kk >> 3) * 4 + (c >> 5)) * 512 + ((kk & 7) * 32 + (c & 31)) * 2; }
__device__ __forceinline__ int v_rd_base(int lane) { return ((lane & 3) << 3) | (((lane >> 2) & 3) << 6) | (((lane >> 4) & 1) << 5) | (((lane >> 5) & 1) << 8); }
constexpr int v_rd_off(int d0, int ks, int half) { return d0 * 512 + ks * 4096 + half * 2048; }
template <int OFF> __device__ __forceinline__ s16x4 tr_read(int vb) {
  s16x4 r; asm volatile("ds_read_b64_tr_b16 %0, %1 offset:%2" : "=&v"(r) : "v"(vb), "i"(OFF) : "memory"); return r;
}
#define PV_READ(D0, F) do { F[0] = tr_read<v_rd_off(D0, 0, 0)>(vb); F[1] = tr_read<v_rd_off(D0, 0, 1)>(vb); F[2] = tr_read<v_rd_off(D0, 1, 0)>(vb); F[3] = tr_read<v_rd_off(D0, 1, 1)>(vb); \
                            F[4] = tr_read<v_rd_off(D0, 2, 0)>(vb); F[5] = tr_read<v_rd_off(D0, 2, 1)>(vb); F[6] = tr_read<v_rd_off(D0, 3, 0)>(vb); F[7] = tr_read<v_rd_off(D0, 3, 1)>(vb); } while (0)
#define PV_PK(L, H) (bf16x8){L[0], L[1], L[2], L[3], H[0], H[1], H[2], H[3]}
#define PV_MMA(od, F) do { od = __builtin_amdgcn_mfma_f32_32x32x16_bf16(pa0, PV_PK(F[0], F[1]), od, 0, 0, 0); od = __builtin_amdgcn_mfma_f32_32x32x16_bf16(pa1, PV_PK(F[2], F[3]), od, 0, 0, 0); \
                            od = __builtin_amdgcn_mfma_f32_32x32x16_bf16(pa2, PV_PK(F[4], F[5]), od, 0, 0, 0); od = __builtin_amdgcn_mfma_f32_32x32x16_bf16(pa3, PV_PK(F[6], F[7]), od, 0, 0, 0); } while (0)
__device__ __forceinline__ void pv_d0(f32x16* o, int vb, bf16x8 pa0, bf16x8 pa1, bf16x8 pa2, bf16x8 pa3) {
  s16x4 fa[8], fb[8];
  PV_READ(0, fa);
  PV_READ(1, fb); asm volatile("s_waitcnt lgkmcnt(8)" ::: "memory"); SBAR(); PV_MMA(o[0], fa);
  PV_READ(2, fa); asm volatile("s_waitcnt lgkmcnt(8)" ::: "memory"); SBAR(); PV_MMA(o[1], fb);
  PV_READ(3, fb); asm volatile("s_waitcnt lgkmcnt(8)" ::: "memory"); SBAR(); PV_MMA(o[2], fa);
  asm volatile("s_waitcnt lgkmcnt(0)" ::: "memory"); SBAR(); PV_MMA(o[3], fb);
}
#undef PV_READ
#undef PV_PK
#undef PV_MMA

struct AttnPre { bf16x8 qr[8]; bf16x8 vs0[2], vs1[2], ks0[2], ks1[2]; };
__device__ __forceinline__ void attn_prime(AttnPre& P, const bf16* Qb, const bf16* __restrict__ Kh, const bf16* __restrict__ Vh, int tid_in) {
  const int tid = tid_in, wid = __builtin_amdgcn_readfirstlane(tid >> 6), lane = tid & 63, r32 = lane & 31, hi = lane >> 5;
  const int sr = tid >> 4, sc = (tid & 15) * 8;
#pragma unroll
  for (int i = 0; i < 2; ++i) { P.vs0[i] = ld8(&Vh[(long)(i * KVBLK + sr) * LDK + sc]); P.vs1[i] = ld8(&Vh[(long)(i * KVBLK + 32 + sr) * LDK + sc]);
    P.ks0[i] = ld8(&Kh[(long)(i * KVBLK + sr) * LDK + sc]); P.ks1[i] = ld8(&Kh[(long)(i * KVBLK + 32 + sr) * LDK + sc]); }
  const bf16* Qw = Qb + (long)(wid * QBLK + r32) * LDQ + hi * 8;
#pragma unroll
  for (int d0 = 0; d0 < 8; ++d0) P.qr[d0] = ld8(Qw + d0 * 16);
}
__device__ __forceinline__ void attn_dense_body(AttnPre& P, const bf16* __restrict__ Kh, const bf16* __restrict__ Vh, bf16* Ob, int seq, char* lds, const float* qnw, const float* rtab, int t0, int tid_in,
                                                const bf16* Qn, const bf16* __restrict__ Kn, const bf16* __restrict__ Vn, bool has_next) {
  const int tid = tid_in, wid = __builtin_amdgcn_readfirstlane(tid >> 6), lane = tid & 63, r32 = lane & 31, hi = lane >> 5;
  bf16* V_lds = (bf16*)lds; bf16* K_lds = (bf16*)(lds + 2 * SHM_V);
  float* ws = (float*)(lds + 2 * SHM_V + 2 * SHM_K) + wid * 64; float* li_l = ws; float* al_l = ws + 32;
  float m_reg = -1e30f, l_reg = 0; f32x16 o[4] = {}; bf16x8 (&qr)[8] = P.qr;
  {
    float ss = 0.f;
#pragma unroll
    for (int d0 = 0; d0 < 8; ++d0) { const u32x4 w = __builtin_bit_cast(u32x4, qr[d0]);
#pragma unroll
      for (int c = 0; c < 4; ++c) { const float lo = __uint_as_float(w[c] << 16), hi_ = __uint_as_float(w[c] & 0xffff0000u); ss += lo * lo + hi_ * hi_; } }
    ss += __shfl_xor(ss, 32);
    const float rn = 1.0f / sqrtf(ss * (1.f / 128.f) + RMS_EPS);
    const int tq = t0 + wid * QBLK + r32;
    v4f tv[2][2][4], wv[2][2][4];
#pragma unroll
    for (int hf = 0; hf < 2; ++hf) {
      const int pos = hf ? (tq & (GRID_W - 1)) : (tq / GRID_W);
#pragma unroll
      for (int dl = 0; dl < 2; ++dl) {
        const int d1 = 4 * hf + dl, d2 = d1 + 2;
        const float* tp = rtab + (size_t)(pos * 32 + 16 * dl + 8 * hi) * 2;
#pragma unroll
        for (int q4 = 0; q4 < 4; ++q4) tv[hf][dl][q4] = *(const v4f*)(tp + 4 * q4);
        wv[hf][dl][0] = *(const v4f*)(qnw + d1 * 16 + hi * 8); wv[hf][dl][1] = *(const v4f*)(qnw + d1 * 16 + hi * 8 + 4);
        wv[hf][dl][2] = *(const v4f*)(qnw + d2 * 16 + hi * 8); wv[hf][dl][3] = *(const v4f*)(qnw + d2 * 16 + hi * 8 + 4);
      } }
#pragma unroll
    for (int hf = 0; hf < 2; ++hf)
#pragma unroll
      for (int dl = 0; dl < 2; ++dl) {
        const int d1 = 4 * hf + dl, d2 = d1 + 2;
        const u32x4 w1 = __builtin_bit_cast(u32x4, qr[d1]), w2 = __builtin_bit_cast(u32x4, qr[d2]);
        u32x4 o1, o2;
#pragma unroll
        for (int c = 0; c < 4; ++c) {
          const v4f t = tv[hf][dl][c]; const v4f n1 = wv[hf][dl][c >> 1], n2 = wv[hf][dl][2 + (c >> 1)];
          const float a0 = __uint_as_float(w1[c] << 16) * rn * n1[2 * (c & 1)], a1 = __uint_as_float(w1[c] & 0xffff0000u) * rn * n1[2 * (c & 1) + 1];
          const float b0 = __uint_as_float(w2[c] << 16) * rn * n2[2 * (c & 1)], b1 = __uint_as_float(w2[c] & 0xffff0000u) * rn * n2[2 * (c & 1) + 1];
          o1[c] = cvtpk(a0 * t.x - b0 * t.y, a1 * t.z - b1 * t.w);
          o2[c] = cvtpk(b0 * t.x + a0 * t.y, b1 * t.z + a1 * t.w); }
        qr[d1] = __builtin_bit_cast(bf16x8, o1); qr[d2] = __builtin_bit_cast(bf16x8, o2);
      } }
  const int sr = tid >> 4, sc = (tid & 15) * 8, vst0 = v_st(sr, sc), vst1 = v_st(32 + sr, sc);
  const int vb0 = (int)(uintptr_t)V_lds + v_rd_base(lane);
#define SLOADP(i, Kp, Vp, k0) do { P.vs0[i] = ld8(&(Vp)[(long)((k0) + sr) * LDK + sc]); P.vs1[i] = ld8(&(Vp)[(long)((k0) + 32 + sr) * LDK + sc]); \
    P.ks0[i] = ld8(&(Kp)[(long)((k0) + sr) * LDK + sc]); P.ks1[i] = ld8(&(Kp)[(long)((k0) + 32 + sr) * LDK + sc]); } while (0)
#define SLOAD(i, k0) SLOADP(i, Kh, Vh, k0)
#define SWRITE(b, i) do { *(bf16x8*)((char*)V_lds + (b) * SHM_V + vst0) = P.vs0[i];          \
    *(bf16x8*)((char*)V_lds + (b) * SHM_V + vst1) = P.vs1[i]; int kc = sc * 2;               \
    *(bf16x8*)((char*)K_lds + (b) * SHM_K + KSWZ(sr, kc)) = P.ks0[i];                       \
    *(bf16x8*)((char*)K_lds + (b) * SHM_K + KSWZ(32 + sr, kc)) = P.ks1[i]; } while (0)
#define SWAIT() do { asm volatile("s_waitcnt vmcnt(4)" ::: "memory"); } while (0)
#define RESC(a) do { if (__any((a) < 1.f)) { if (hi == 0) al_l[r32] = (a); asm volatile("s_waitcnt lgkmcnt(0)" ::: "memory"); \
    _Pragma("unroll") for (int d = 0; d < 4; ++d) _Pragma("unroll") for (int r = 0; r < 16; ++r) o[d][r] *= al_l[crow(r, hi)]; } } while (0)
  f32x16 pA0, pA1, pB0, pB1; float mnA, mnB, alA, alB; bf16x8 pa0, pa1, pa2, pa3; const int NT = seq / KVBLK;
  constexpr int SE = 0, SO = SDEPTH - 1;
  __syncthreads();
  SWRITE(0, SE); __syncthreads();
  qkt(pA0, pA1, K_lds, qr, r32, hi); partialSM(pA0, pA1, m_reg, mnA, alA);
  if (2 < NT) SLOAD(SE, 2 * KVBLK);
  SWAIT(); SWRITE(1, SO); __syncthreads();
  for (int j = 1; j + 1 < NT; j += 2) {
    SBAR(); qkt(pB0, pB1, (bf16*)((char*)K_lds + SHM_K), qr, r32, hi);
    finishSM(pA0, pA1, alA, l_reg, pa0, pa1, pa2, pa3); SBAR();
    SLOAD(SO, (j + SDEPTH) * KVBLK); SBAR();
    pv_d0(o, vb0, pa0, pa1, pa2, pa3); partialSM(pB0, pB1, m_reg, mnB, alB);
    __syncthreads(); SWAIT(); SWRITE(0, SE);
    RESC(alB); __syncthreads();
    SBAR(); qkt(pA0, pA1, K_lds, qr, r32, hi);
    finishSM(pB0, pB1, alB, l_reg, pa0, pa1, pa2, pa3); SBAR();
    if (j + 3 < NT) SLOAD(SE, (j + 1 + SDEPTH) * KVBLK); SBAR();
    pv_d0(o, vb0 + (int)SHM_V, pa0, pa1, pa2, pa3); partialSM(pA0, pA1, m_reg, mnA, alA);
    __syncthreads(); SWAIT(); SWRITE(1, SO);
    RESC(alA); __syncthreads();
  }
  if (has_next) {
    const int t2 = (wid << 6) | lane_id_now(), sr2 = t2 >> 4, sc2 = (t2 & 15) * 8; const unsigned o2 = (unsigned)(sr2 * LDK + sc2) * 2u;
#pragma unroll
    for (int i = 0; i < 2; ++i) { const char* vp = (const char*)Vn + (size_t)(i * KVBLK * LDK * 2); const char* kp = (const char*)Kn + (size_t)(i * KVBLK * LDK * 2);
      P.vs0[i] = *(const bf16x8*)(vp + o2); P.vs1[i] = *(const bf16x8*)(vp + o2 + 32 * LDK * 2); P.ks0[i] = *(const bf16x8*)(kp + o2); P.ks1[i] = *(const bf16x8*)(kp + o2 + 32 * LDK * 2); } }
  SBAR(); qkt(pB0, pB1, (bf16*)((char*)K_lds + SHM_K), qr, r32, hi);
  finishSM(pA0, pA1, alA, l_reg, pa0, pa1, pa2, pa3); SBAR();
  if (has_next) { const int l2 = lane_id_now(); const unsigned qo2 = (unsigned)((wid * QBLK + (l2 & 31)) * LDQ + (l2 >> 5) * 8) * 2u;
#pragma unroll
    for (int d0 = 0; d0 < 8; ++d0) qr[d0] = *(const bf16x8*)((const char*)Qn + qo2 + d0 * 32); }
  SBAR();
  pv_d0(o, vb0, pa0, pa1, pa2, pa3); partialSM(pB0, pB1, m_reg, mnB, alB);
  __syncthreads(); RESC(alB);
  finishSM(pB0, pB1, alB, l_reg, pa0, pa1, pa2, pa3); SBAR();
  pv_d0(o, vb0 + (int)SHM_V, pa0, pa1, pa2, pa3);
  if (hi == 0) li_l[r32] = l_reg; asm volatile("s_waitcnt lgkmcnt(0)" ::: "memory");
  float rli[16];
#pragma unroll
  for (int r = 0; r < 16; ++r) rli[r] = __builtin_amdgcn_rcpf(li_l[crow(r, hi)]);
  bf16* Ow = Ob + (long)(wid * QBLK) * LDO;
#pragma unroll
  for (int r = 0; r < 16; ++r) { int orow = crow(r, hi);
#pragma unroll
    for (int d0 = 0; d0 < 4; ++d0) Ow[(long)orow * LDO + d0 * 32 + r32] = (bf16)(cvtpk(o[d0][r] * rli[r], 0.f) & 0xffffu); }
#undef SLOAD
#undef SLOADP
#undef SWRITE
#undef SWAIT
#undef RESC
}
#undef KSWZ
#undef SBAR
}
constexpr int NWAVES = 8;
constexpr size_t MiB = 1u << 20;
constexpr size_t WS_CTL = 0, CTL_ZERO_BYTES = 1 * MiB;
constexpr size_t WS_MOD = 512 * 1024;
constexpr size_t WS_WCAT = 1 * MiB;
constexpr size_t WS_H = 259 * MiB;
constexpr size_t WS_WSSM = 387 * MiB;
constexpr size_t WS_WATT = 451 * MiB;
constexpr size_t WS_WOUT = 483 * MiB;
constexpr size_t WS_WUP = 515 * MiB;
constexpr size_t WS_WDN = 687 * MiB;
constexpr size_t WS_Z = 773 * MiB;
constexpr size_t WS_XBCC = 1029 * MiB;
constexpr size_t WS_DT = 1349 * MiB;
constexpr size_t WS_Q = 1365 * MiB;
constexpr size_t WS_K = 1493 * MiB;
constexpr size_t WS_V = 1525 * MiB;
constexpr size_t WS_GATES = 1557 * MiB;
constexpr size_t WS_PART = WS_Z;
constexpr size_t WS_EDGE1 = 687 * MiB;
constexpr size_t WS_YB = 1 * MiB;
constexpr size_t WS_PM = WS_XBCC;
constexpr size_t WS_R1 = 1 * MiB;
constexpr size_t WS_ST1 = WS_Z;
constexpr size_t WS_H2 = WS_XBCC;
constexpr size_t WS_EDGE = 1157 * MiB;
constexpr size_t WS_ACT = 1202 * MiB;
constexpr size_t WS_END = 1557 * MiB + 256 * MiB;

constexpr int LDS_BYTES = 147456;
constexpr int LDS_ZERO_OFF = 143360, MISC_OFF = LDS_ZERO_OFF + 320;

typedef GAS unsigned gu32;
#define RLX_AGENT __ATOMIC_RELAXED, __HIP_MEMORY_SCOPE_AGENT
#define LDS_WAIT() asm volatile("s_waitcnt lgkmcnt(0)" ::: "memory")
#define VM_WAIT() asm volatile("s_waitcnt vmcnt(0)" ::: "memory")
namespace ssd {
using bf16x8 = __attribute__((ext_vector_type(8))) short;
using s16x4  = __attribute__((ext_vector_type(4))) short;
using f32x16 = __attribute__((ext_vector_type(16))) float;
typedef float f2 __attribute__((ext_vector_type(2)));
constexpr int B_OFF = 0, C_OFF = 32768, XX_OFF = 65536, H_OFF = 98304, TBL_OFF = 114688, TBL_BYTES = 2048, MX_OFF = TBL_OFF + 2 * TBL_BYTES, SSD_LDS = MX_OFF + 10 * 2048;
constexpr int T_CUM = 0, T_DT = 512, T_WT = 1024, T_ETOT = 1536;
__device__ __forceinline__ int off_b(int row, int ch) { return 256 * row + 16 * (ch ^ (((row & 3) << 2) | ((row >> 2) & 3))); }
template <int OFF> __device__ __forceinline__ s16x4 tr_read(int addr) {
    s16x4 r; asm volatile("ds_read_b64_tr_b16 %0, %1 offset:%2" : "=&v"(r) : "v"(addr), "i"(OFF) : "memory"); return r;
}
#define SSD_PK(L, H) (bf16x8){L[0], L[1], L[2], L[3], H[0], H[1], H[2], H[3]}
#define SSD_LGKM0() do { asm volatile("s_waitcnt lgkmcnt(0)" ::: "memory"); __builtin_amdgcn_sched_barrier(0); } while (0)
#define SSD_MFMA(a, b, c) __builtin_amdgcn_mfma_f32_32x32x16_bf16(a, b, c, 0, 0, 0)

template <int SB, int LB>
__device__ __forceinline__ void decay_tile(const f32x16& g, bf16x8& m0, bf16x8& m1, LAS const char* tbl, int l31, int h, float cl) {
    const LAS float* cs2 = (const LAS float*)(tbl + T_DT); const float cl2 = cl * 1.4426950408889634f;
    float m[16];
#pragma unroll
    for (int q = 0; q < 4; ++q) { const v4f c4 = *(const LAS v4f*)(cs2 + 32 * SB + 8 * q + 4 * h);
#pragma unroll
        for (int e = 0; e < 4; ++e) { const float v = g[4 * q + e] * __builtin_amdgcn_exp2f(cl2 - c4[e]);
            m[4 * q + e] = (SB != LB || (8 * q + 4 * h + e) <= l31) ? v : 0.f; } }
    { v4u w; w.x = pkbf(m[0], m[1]); w.y = pkbf(m[2], m[3]); w.z = pkbf(m[4], m[5]); w.w = pkbf(m[6], m[7]); m0 = __builtin_bit_cast(bf16x8, w); }
    { v4u w; w.x = pkbf(m[8], m[9]); w.y = pkbf(m[10], m[11]); w.z = pkbf(m[12], m[13]); w.w = pkbf(m[14], m[15]); m1 = __builtin_bit_cast(bf16x8, w); }
}
#define SSD_RRO(s) (rr0 ^ (32 * (s)))
#define SSD_BROW(SB, s) (*(const LAS bf16x8*)(L + B_OFF + 8192 * (SB) + SSD_RRO(s)))

#define SSD_XF(SB, xf) do { xf[0] = tr_read<256 * (32 * (SB) + 0)>(xtr0); xf[1] = tr_read<256 * (32 * (SB) + 8)>(xtr1); xf[2] = tr_read<256 * (32 * (SB) + 16)>(xtr0); xf[3] = tr_read<256 * (32 * (SB) + 24)>(xtr1); } while (0)
#define SSD_MXA(LB_, SB_, KS_) (MX_OFF + ((((LB_) * ((LB_) + 1) / 2 + (SB_)) * 2 + (KS_)) << 10))
template <int LB, int PB>
__device__ __forceinline__ void chunk_y1(f32x16& yi, LAS char* L, LAS const char* tbl, int rr0, int pb, int lane, int l31, int h) {
    constexpr bool HAS_A = (PB <= LB), HAS_B = (PB + 2 <= LB);
    bf16x8 Cfr[8];
#pragma unroll
    for (int s = 0; s < 8; ++s) { LAS const char* as_ = L + SSD_RRO(s); Cfr[s] = *(const LAS bf16x8*)(as_ + (C_OFF + 8192 * LB)); }
    const float cl = *(const LAS float*)(tbl + T_CUM + 4 * (32 * LB + l31));
    f32x16 ga = {}, gb = {}; yi = (f32x16){};
#pragma unroll
    for (int s = 0; s < 8; ++s) {
        LAS const char* as_ = L + SSD_RRO(s);
        const bf16x8 hfr = *(const LAS bf16x8*)(as_ + (H_OFF + 8192 * PB)); yi = SSD_MFMA(hfr, Cfr[s], yi);
        if constexpr (HAS_A) { const bf16x8 ba = *(const LAS bf16x8*)(as_ + (B_OFF + 8192 * PB)); ga = SSD_MFMA(ba, Cfr[s], ga); }
        if constexpr (HAS_B) { const bf16x8 bb = *(const LAS bf16x8*)(as_ + (B_OFF + 8192 * (PB + 2))); gb = SSD_MFMA(bb, Cfr[s], gb); }
    }
    { const float el = __expf(cl);
#pragma unroll
      for (int r = 0; r < 16; ++r) yi[r] *= el; }
    if constexpr (HAS_A) { bf16x8 m0, m1; decay_tile<PB, LB>(ga, m0, m1, tbl, l31, h, cl);
        *(LAS bf16x8*)(L + SSD_MXA(LB, PB, 0) + 16 * lane) = m0; *(LAS bf16x8*)(L + SSD_MXA(LB, PB, 1) + 16 * lane) = m1; }
    if constexpr (HAS_B) { bf16x8 m0, m1; decay_tile<PB + 2, LB>(gb, m0, m1, tbl, l31, h, cl);
        *(LAS bf16x8*)(L + SSD_MXA(LB, PB + 2, 0) + 16 * lane) = m0; *(LAS bf16x8*)(L + SSD_MXA(LB, PB + 2, 1) + 16 * lane) = m1; }
}
template <int LB>
__device__ __forceinline__ void chunk_y2(f32x16& acc_y, LAS const char* L, int xtr0, int xtr1, int lane) {
    s16x4 xf[LB + 1][4]; bf16x8 mf[LB + 1][2];
    SSD_XF(0, xf[0]);
    if constexpr (LB >= 1) SSD_XF(1, xf[1]);
    if constexpr (LB >= 2) SSD_XF(2, xf[2]);
    if constexpr (LB >= 3) SSD_XF(3, xf[3]);
#pragma unroll
    for (int sb = 0; sb <= LB; ++sb) { mf[sb][0] = *(const LAS bf16x8*)(L + SSD_MXA(LB, sb, 0) + 16 * lane); mf[sb][1] = *(const LAS bf16x8*)(L + SSD_MXA(LB, sb, 1) + 16 * lane); }
    SSD_LGKM0();
#pragma unroll
    for (int sb = 0; sb <= LB; ++sb) { acc_y = SSD_MFMA(SSD_PK(xf[sb][0], xf[sb][1]), mf[sb][0], acc_y); acc_y = SSD_MFMA(SSD_PK(xf[sb][2], xf[sb][3]), mf[sb][1], acc_y); }
}
#undef SSD_XF

__device__ __forceinline__ void ssd_unit(LAS char* L, int unit, const bf16* xbc, const float* dtb, const float* a_log, const float* dskip, bf16* yout, int tid_in) {
    const int dir = unit & 1, head = (unit >> 1) & 127, b = unit >> 8, grp = head >> 4;
    asm volatile("" : "+s"(xbc), "+s"(dtb), "+s"(yout));
    int tid_l = tid_in; asm volatile("" : "+v"(tid_l));
    const int tid = tid_l, lane = tid & 63, w = __builtin_amdgcn_readfirstlane(tid >> 6), h = lane >> 5, l31 = lane & 31;
    const int pb = (w < 4) ? 0 : 1, lb = (w < 4) ? w : 7 - w, nb = w & 3, pb2 = w >> 2;
    constexpr int SCANW = 7;
    const float A = -__expf(a_log[dir * SSM_H + head]); const float dsk_eff = (dir == 0) ? dskip[head] : 0.f;
    const int rr0 = 256 * l31 + 16 * (h ^ (((l31 & 3) << 2) | ((l31 >> 2) & 3)));
    const int tq = (lane & 15) >> 2, tp = lane & 3, tblk = (lane >> 4) & 1;
    const int Lb = (int)(uintptr_t)L;
    const int xtr0 = Lb + XX_OFF + 256 * (4 * h + tq) + 16 * ((4 * pb + 2 * tblk + (tp >> 1)) ^ ((tq << 2) | ((0 + h) & 3))) + 8 * (tp & 1);
    const int xtr1 = Lb + XX_OFF + 256 * (4 * h + tq) + 16 * ((4 * pb + 2 * tblk + (tp >> 1)) ^ ((tq << 2) | ((2 + h) & 3))) + 8 * (tp & 1);
    const int btr0 = Lb + B_OFF + 256 * (8 * h + tq) + 16 * ((4 * nb + 2 * tblk + (tp >> 1)) ^ ((tq << 2) | (2 * h + 0))) + 8 * (tp & 1);
    const int btr1 = Lb + B_OFF + 256 * (8 * h + tq) + 16 * ((4 * nb + 2 * tblk + (tp >> 1)) ^ ((tq << 2) | (2 * h + 1))) + 8 * (tp & 1);
    const int wtr0 = Lb + XX_OFF + 256 * (8 * h + tq) + 16 * ((4 * (2 + pb2) + 2 * tblk + (tp >> 1)) ^ ((tq << 2) | (2 * h + 0))) + 8 * (tp & 1);
    const int wtr1 = Lb + XX_OFF + 256 * (8 * h + tq) + 16 * ((4 * (2 + pb2) + 2 * tblk + (tp >> 1)) ^ ((tq << 2) | (2 * h + 1))) + 8 * (tp & 1);

    { unsigned z0; asm volatile("v_mov_b32 %0, 0" : "=v"(z0)); const v4u zz = (v4u){z0, z0, z0, z0};
      for (int i = tid; i < 16384 / 16; i += 512) *(LAS v4u*)(L + H_OFF + i * 16) = zz; }
    f32x16 acc_h = {};
    v4u xr[2], br[4], cr[4]; float dtr0 = 0.f, dtr1 = 0.f, dtn0 = 0.f, dtn1 = 0.f;
    const size_t brow = (size_t)b * SEQ; const int sgn = dir ? -1 : 1;
#define SSD_TOK(ci, tau) (dir ? ((SEQ / 128 - 1 - (ci)) * 128 + 127 - (tau)) : ((ci) * 128 + (tau)))
#define SSD_TB(ci) ((int)brow + (dir ? ((SEQ / 128 - 1 - (ci)) * 128 + 127) : ((ci) * 128)))
#define SSD_PREFETCH(ci) do { const int tb_ = SSD_TB(ci); \
        { const unsigned ox = (unsigned)((tb_ + sgn * (tidl >> 3)) * (SSM_CONVD * 2) + (head * 64 + (tidl & 7) * 8) * 2); const unsigned sx = (unsigned)(sgn * 64 * SSM_CONVD * 2); \
          _Pragma("unroll") for (int i = 0; i < 2; ++i) xr[i] = *(const GAS v4u*)((const char*)xbc + (ox + (unsigned)i * sx)); } \
        { const unsigned ob = (unsigned)((tb_ + sgn * (tidl >> 4)) * (SSM_CONVD * 2) + (SSM_DI + grp * 128 + (tidl & 15) * 8) * 2); const unsigned sb = (unsigned)(sgn * 32 * SSM_CONVD * 2); \
          _Pragma("unroll") for (int i = 0; i < 4; ++i) { const char* rp = (const char*)xbc + (ob + (unsigned)i * sb); br[i] = *(const GAS v4u*)rp; cr[i] = *(const GAS v4u*)(rp + 2048); } } } while (0)
#define SSD_DTLOAD(ci, d0, d1) do { if (w == SCANW) { const unsigned od = (unsigned)((SSD_TB(ci) + sgn * 2 * lane) * 256 + dir * SSM_H + head) * 4u; \
        d0 = *(const GAS float*)((const char*)dtb + od); d1 = *(const GAS float*)((const char*)dtb + (od + (unsigned)(sgn * 1024))); } } while (0)
#define SSD_SCAN(TB) do { if (w == SCANW) { LAS char* tb_ = L + TBL_OFF + (TB) * TBL_BYTES; \
        const float a0 = dtr0 * A, a1 = dtr1 * A; float inc = a0 + a1; \
        _Pragma("unroll") for (int o = 1; o < 64; o <<= 1) { const float v = __shfl_up(inc, o); if (lane >= o) inc += v; } \
        const float c1 = inc, c0 = inc - a1; const float total = __shfl(inc, 63); \
        *(LAS f2*)(tb_ + T_CUM + 8 * lane) = (f2){c0, c1}; *(LAS f2*)(tb_ + T_DT + 8 * lane) = (f2){(c0 - __logf(dtr0)) * 1.4426950408889634f, (c1 - __logf(dtr1)) * 1.4426950408889634f}; \
        *(LAS f2*)(tb_ + T_WT + 8 * lane) = (f2){__expf(total - c0) * dtr0, __expf(total - c1) * dtr1}; if (lane == 0) *(LAS float*)(tb_ + T_ETOT) = __expf(total); } } while (0)
#define SSD_STAGE(TB) do { const LAS char* tb_ = L + TBL_OFF + (TB) * TBL_BYTES; \
        { const int obc = off_b(tidl >> 4, tidl & 15);                    \
          _Pragma("unroll") for (int i = 0; i < 4; ++i) { *(LAS v4u*)(L + B_OFF + obc + 8192 * i) = br[i]; *(LAS v4u*)(L + C_OFF + obc + 8192 * i) = cr[i]; } } \
        { const int oxx = off_b(tidl >> 3, tidl & 7);                     \
          _Pragma("unroll") for (int i = 0; i < 2; ++i) { const float wt = *(const LAS float*)(tb_ + T_WT + 4 * (tidl >> 3) + 256 * i); \
            *(LAS v4u*)(L + XX_OFF + oxx + 16384 * i) = xr[i]; \
            v4u o; o.x = pkbf(bflo(xr[i].x) * wt, bfhi(xr[i].x) * wt); o.y = pkbf(bflo(xr[i].y) * wt, bfhi(xr[i].y) * wt); o.z = pkbf(bflo(xr[i].z) * wt, bfhi(xr[i].z) * wt); o.w = pkbf(bflo(xr[i].w) * wt, bfhi(xr[i].w) * wt); \
            *(LAS v4u*)(L + XX_OFF + (oxx ^ 128) + 16384 * i) = o; } } } while (0)

    int tidl = tid; asm volatile("" : "+v"(tidl));
    SSD_DTLOAD(0, dtr0, dtr1);
    SSD_PREFETCH(0);
    SSD_SCAN(0);
    SSD_DTLOAD(1, dtr0, dtr1);
    __syncthreads();
    SSD_STAGE(0);
    SSD_PREFETCH(1);
    __syncthreads();
    for (int ci = 0; ci < SEQ / 128; ++ci) {
        const bool more = (ci + 1 < SEQ / 128);
        tidl = tid; asm volatile("" : "+v"(tidl));
        LAS const char* tbl = L + TBL_OFF + (ci & 1) * TBL_BYTES;
        if (ci + 2 < SEQ / 128) SSD_DTLOAD(ci + 2, dtn0, dtn1);
        if (more) SSD_SCAN((ci + 1) & 1);
        const float e_tot = *(const LAS float*)(tbl + T_ETOT);
        f32x16 acc_y;
        if (pb == 0) { if (lb == 0) chunk_y1<0, 0>(acc_y, L, tbl, rr0, pb, lane, l31, h); else if (lb == 1) chunk_y1<1, 0>(acc_y, L, tbl, rr0, pb, lane, l31, h);
                       else if (lb == 2) chunk_y1<2, 0>(acc_y, L, tbl, rr0, pb, lane, l31, h); else chunk_y1<3, 0>(acc_y, L, tbl, rr0, pb, lane, l31, h); }
        else         { if (lb == 0) chunk_y1<0, 1>(acc_y, L, tbl, rr0, pb, lane, l31, h); else if (lb == 1) chunk_y1<1, 1>(acc_y, L, tbl, rr0, pb, lane, l31, h);
                       else if (lb == 2) chunk_y1<2, 1>(acc_y, L, tbl, rr0, pb, lane, l31, h); else chunk_y1<3, 1>(acc_y, L, tbl, rr0, pb, lane, l31, h); }
        __syncthreads();
        if (lb == 0) chunk_y2<0>(acc_y, L, xtr0, xtr1, lane); else if (lb == 1) chunk_y2<1>(acc_y, L, xtr0, xtr1, lane);
        else if (lb == 2) chunk_y2<2>(acc_y, L, xtr0, xtr1, lane); else chunk_y2<3>(acc_y, L, xtr0, xtr1, lane);
        s16x4 sa[8][2], sb_[8][2];
#define SSD_ST_RD(KS) do { sa[KS][0] = tr_read<256 * (16 * (KS) + 0)>(btr0); sa[KS][1] = tr_read<256 * (16 * (KS) + 4)>(btr1); \
                           sb_[KS][0] = tr_read<256 * (16 * (KS) + 0)>(wtr0); sb_[KS][1] = tr_read<256 * (16 * (KS) + 4)>(wtr1); } while (0)
        SSD_ST_RD(0); SSD_ST_RD(1); SSD_ST_RD(2); SSD_ST_RD(3); SSD_ST_RD(4); SSD_ST_RD(5); SSD_ST_RD(6); SSD_ST_RD(7);
#undef SSD_ST_RD
        { char* yp = (char*)yout + (unsigned)((SSD_TB(ci) + sgn * (32 * lb + l31)) * SSM_DI + head * 64 + 32 * pb + 4 * h) * 2u;
          if (dir == 0) { const int x0 = off_b(32 * lb + l31, 4 * pb) + 8 * h;
#pragma unroll
            for (int q = 0; q < 4; ++q) { const v2u xq = *(const LAS v2u*)(L + XX_OFF + (x0 ^ (16 * q)));
              v2u o; o.x = pkbf(acc_y[4 * q] + dsk_eff * bflo(xq.x), acc_y[4 * q + 1] + dsk_eff * bfhi(xq.x)); o.y = pkbf(acc_y[4 * q + 2] + dsk_eff * bflo(xq.y), acc_y[4 * q + 3] + dsk_eff * bfhi(xq.y));
              *(GAS v2u*)(yp + 16 * q) = o; }
          } else {
#pragma unroll
            for (int q = 0; q < 4; ++q) { v2u o; o.x = pkbf(acc_y[4 * q], acc_y[4 * q + 1]); o.y = pkbf(acc_y[4 * q + 2], acc_y[4 * q + 3]); *(GAS v2u*)(yp + 16 * q) = o; } } }
        dtr0 = dtn0; dtr1 = dtn1;
        SSD_LGKM0();
        __syncthreads();
        { f32x16 ha = {}, hb = {};
          __builtin_amdgcn_s_setprio(1);
          ha = SSD_MFMA(SSD_PK(sa[0][0], sa[0][1]), SSD_PK(sb_[0][0], sb_[0][1]), ha); hb = SSD_MFMA(SSD_PK(sa[1][0], sa[1][1]), SSD_PK(sb_[1][0], sb_[1][1]), hb);
          ha = SSD_MFMA(SSD_PK(sa[2][0], sa[2][1]), SSD_PK(sb_[2][0], sb_[2][1]), ha); hb = SSD_MFMA(SSD_PK(sa[3][0], sa[3][1]), SSD_PK(sb_[3][0], sb_[3][1]), hb);
          ha = SSD_MFMA(SSD_PK(sa[4][0], sa[4][1]), SSD_PK(sb_[4][0], sb_[4][1]), ha); hb = SSD_MFMA(SSD_PK(sa[5][0], sa[5][1]), SSD_PK(sb_[5][0], sb_[5][1]), hb);
          ha = SSD_MFMA(SSD_PK(sa[6][0], sa[6][1]), SSD_PK(sb_[6][0], sb_[6][1]), ha); hb = SSD_MFMA(SSD_PK(sa[7][0], sa[7][1]), SSD_PK(sb_[7][0], sb_[7][1]), hb);
          __builtin_amdgcn_s_setprio(0);
#pragma unroll
          for (int r = 0; r < 16; ++r) acc_h[r] = acc_h[r] * e_tot + (ha[r] + hb[r]); }
        tidl = tid; asm volatile("" : "+v"(tidl));
        if (more) {
            const int a0 = off_b(32 * pb2 + l31, 4 * nb) + 8 * h;
#pragma unroll
            for (int q = 0; q < 4; ++q) { v2u o; o.x = pkbf(acc_h[4 * q], acc_h[4 * q + 1]); o.y = pkbf(acc_h[4 * q + 2], acc_h[4 * q + 3]);
                *(LAS v2u*)(L + H_OFF + (a0 ^ (16 * q))) = o; }
            SSD_STAGE((ci + 1) & 1);
            if (ci + 2 < SEQ / 128) SSD_PREFETCH(ci + 2);
        }
        __syncthreads();
    }
#undef SSD_TOK
#undef SSD_PREFETCH
#undef SSD_DTLOAD
#undef SSD_SCAN
#undef SSD_STAGE
}
#undef SSD_PK
#undef SSD_LGKM0
#undef SSD_MFMA
#undef SSD_BROW
#undef SSD_RRO
#undef SSD_MXA
}
#define XB_TMO      128
#define XB_XCNT(j)  (256  + 64 * (j))
#define XB_XSUB(j)  (1280 + 64 * (j))
#define XB_XGEN(j)  (2304 + 64 * (j))
#define XB_TOP      3328
#define XB_TOPGEN   3392
#define XCD_BAR_WORDS 3456
#define XB_SPIN_CAP (1u << 18)

__device__ __forceinline__ unsigned xb_ld(unsigned* p)              { return __hip_atomic_load(p, __ATOMIC_RELAXED, __HIP_MEMORY_SCOPE_AGENT); }
__device__ __forceinline__ unsigned xb_add(unsigned* p, unsigned v) { return __hip_atomic_fetch_add(p, v, __ATOMIC_RELAXED, __HIP_MEMORY_SCOPE_AGENT); }
__device__ __forceinline__ unsigned xb_xcc_id() { return (unsigned)__builtin_amdgcn_s_getreg((3 << 11) | 20) & 0xFu; }
#define XB_SPIN(cond, bar) do { unsigned _sp = 0; while (cond) { __builtin_amdgcn_s_sleep(1); \
    if ((++_sp & 255u) == 0u) { if (xb_ld(&(bar)[XB_TMO])) break; if (_sp > XB_SPIN_CAP) { atomicAdd(&(bar)[XB_TMO], 1u); break; } } } } while (0)

struct XcdBarrier {
    unsigned* bar; unsigned x;
    volatile LAS unsigned* st;
};

__device__ __forceinline__ XcdBarrier xcd_barrier_post(unsigned* bar, volatile LAS unsigned* st, int tid) {
    XcdBarrier b; b.bar = bar; b.x = xb_xcc_id(); b.st = st;
    if (tid == 0) (void)xb_add(&bar[XB_XCNT(b.x)], 1u);
    return b;
}
__device__ __forceinline__ void xcd_barrier_complete(unsigned* bar, unsigned x, unsigned& nloc, unsigned& nx) {
    const unsigned G = gridDim.x * gridDim.y * gridDim.z;
    unsigned sum, cnt, mine, sp = 0u;
    for (;;) {
        sum = 0u; cnt = 0u; mine = 0u;
#pragma unroll
        for (unsigned j = 0; j < 16; ++j) { const unsigned c = xb_ld(&bar[XB_XCNT(j)]); sum += c; cnt += (c > 0u) ? 1u : 0u; mine = (j == x) ? c : mine; }
        if (sum == G) break;
        __builtin_amdgcn_s_sleep(1);
        if ((++sp & 255u) == 0u) { if (xb_ld(&bar[XB_TMO])) break; if (sp > XB_SPIN_CAP) { atomicAdd(&bar[XB_TMO], 1u); break; } }
    }
    nloc = mine > 0u ? mine : 1u; nx = cnt > 0u ? cnt : 1u;
}

__device__ __forceinline__ void xcd_barrier(const XcdBarrier& b, int tid) {
    asm volatile("s_waitcnt vmcnt(0)" ::: "memory");
    __syncthreads();
    if (tid == 0) {
        unsigned* bar = b.bar;
        __builtin_amdgcn_s_waitcnt(0);
        unsigned nloc = b.st[0], nx = b.st[1];
        if (nloc == 0u) { xcd_barrier_complete(bar, b.x, nloc, nx); b.st[0] = nloc; b.st[1] = nx; }
        const unsigned old = xb_add(&bar[XB_XSUB(b.x)], 1u);
        const unsigned gen = old / nloc;
        if (old + 1u == (gen + 1u) * nloc) {
            __builtin_amdgcn_fence(__ATOMIC_RELEASE, "agent");
            asm volatile("s_waitcnt vmcnt(0)" ::: "memory");
            const unsigned og = xb_add(&bar[XB_TOP], 1u);
            const unsigned tg = og / nx;
            if (og + 1u == (tg + 1u) * nx) xb_add(&bar[XB_TOPGEN], 1u);
            else XB_SPIN(xb_ld(&bar[XB_TOPGEN]) == tg, bar);
            __builtin_amdgcn_fence(__ATOMIC_ACQUIRE, "agent");
            xb_add(&bar[XB_XGEN(b.x)], 1u);
            asm volatile("s_waitcnt vmcnt(0)" ::: "memory");
        } else {
            XB_SPIN(xb_ld(&bar[XB_XGEN(b.x)]) == gen, bar);
            __builtin_amdgcn_fence(__ATOMIC_ACQUIRE, "agent");
            asm volatile("s_waitcnt vmcnt(0)" ::: "memory");
        }
    }
    __syncthreads();
}
struct Ctx { LAS unsigned char* lds; int tid, lane, wave, gw, NGW, G; };
constexpr int NWAVES_C = 8;

__device__ __forceinline__ void transpose_item(const float* W, int K, int N, bf16* WT, int row_off, LAS float* scr, int item, int lane) {
    const int nblk = N / 32, kb = item / nblk, nb = item % nblk, k0 = 64 * kb, n0 = 32 * nb;
#pragma unroll 8
    for (int i = 0; i < 32; ++i) { const int kk = 2 * i + (lane >> 5); scr[kk * 33 + (lane & 31)] = W[(size_t)(k0 + kk) * N + n0 + (lane & 31)]; }
    LDS_WAIT(); asm volatile("" ::: "memory");
    const int c = lane & 7;
#pragma unroll
    for (int j = 0; j < 4; ++j) { const int n = (lane >> 3) + 8 * j; const LAS float* s = scr + (8 * c) * 33 + n;
        v4u o; o.x = pkbf(s[0 * 33], s[1 * 33]); o.y = pkbf(s[2 * 33], s[3 * 33]); o.z = pkbf(s[4 * 33], s[5 * 33]); o.w = pkbf(s[6 * 33], s[7 * 33]);
        *(GAS v4u*)(WT + (size_t)(row_off + n0 + n) * K + k0 + 8 * c) = o; }
    LDS_WAIT(); asm volatile("" ::: "memory");
}

struct P0Args { const float *c, *w_ada, *b_ada; float* mod; float* ropetab; const float *w_in, *w_gate, *w_ssm, *w_att, *w_out, *w_up, *w_dn; bf16 *Wcat, *Wssm, *Watt, *Wout, *Wup, *Wdn; };
__device__ __forceinline__ void phase_prologue(const Ctx& X, const P0Args& A) {
    for (int it = X.gw; it < 96 * 64; it += X.NGW) {
        const int nb = it % 96, kc = it / 96, n0 = nb * 256 + X.lane * 4, k0 = kc * 64;
        float sc[4];
#pragma unroll
        for (int b = 0; b < 4; ++b) sc[b] = siluf_(A.c[b * D_MODEL + k0 + X.lane]);
        v4f acc[4];
#pragma unroll
        for (int b = 0; b < 4; ++b) acc[b] = (v4f){0.f, 0.f, 0.f, 0.f};
        const float* wp = A.w_ada + (size_t)k0 * MOD_LD + n0;
#pragma unroll 1
        for (int kq = 0; kq < 4; ++kq) {
            v4f w[16];
#pragma unroll
            for (int kk = 0; kk < 16; ++kk) w[kk] = *(const GAS v4f*)(wp + (size_t)(kq * 16 + kk) * MOD_LD);
#pragma unroll
            for (int kk = 0; kk < 16; ++kk)
#pragma unroll
                for (int b = 0; b < 4; ++b) { const float s = __uint_as_float(__builtin_amdgcn_readlane(__float_as_uint(sc[b]), kq * 16 + kk)); acc[b] += w[kk] * s; }
        }
        if (kc == 0) { const v4f bb = *(const GAS v4f*)(A.b_ada + n0);
#pragma unroll
            for (int b = 0; b < 4; ++b) acc[b] += bb; }
#pragma unroll
        for (int b = 0; b < 4; ++b) { float* mp = A.mod + (size_t)b * MOD_LD + n0;
            unsafeAtomicAdd(mp, acc[b].x); unsafeAtomicAdd(mp + 1, acc[b].y); unsafeAtomicAdd(mp + 2, acc[b].z); unsafeAtomicAdd(mp + 3, acc[b].w); }
    }
    { const int gt = X.gw * 64 + X.lane;
      if (gt < 64 * 32) { const int pos = gt >> 5, i = gt & 31; const float ang = (float)pos * exp2f(-(float)i * (13.287712379549449f / 32.0f)); float sn, cs; sincosf(ang, &sn, &cs);
          A.ropetab[2 * gt] = cs; A.ropetab[2 * gt + 1] = sn; } }
    LAS float* scr = (LAS float*)(X.lds + X.wave * 16384);
    constexpr int I_IN = (D_MODEL / 64) * (IN_COLS / 32), I_GATE = (D_MODEL / 64) * (2 * D_MODEL / 32);
    constexpr int NITEMS = I_IN + I_GATE;
    for (int it = X.gw; it < NITEMS; it += X.NGW) {
        int r = it;
        if (r < I_IN) { transpose_item(A.w_in, D_MODEL, IN_COLS, A.Wcat, 0, scr, r, X.lane); continue; } r -= I_IN;
        transpose_item(A.w_gate, D_MODEL, 2 * D_MODEL, A.Wcat, IN_COLS, scr, r, X.lane);
    }
}
__device__ __forceinline__ void transposes_up_share(const Ctx& X, const float* w_up, bf16* Wup) {
    LAS float* scr = (LAS float*)(X.lds + X.wave * 16384);
    constexpr int I_UP = (D_MODEL / 64) * (FFN2 / 32), nblk = FFN2 / 32;
    const int lr = X.lane >> 3, lc = 4 * (X.lane & 7);
    for (int it0 = X.gw; it0 < I_UP; it0 += 2 * X.NGW) {
        const int it1 = it0 + X.NGW; const bool two = it1 < I_UP;
        v4f v[2][8];
#pragma unroll
        for (int s = 0; s < 2; ++s) { const int it = (s && two) ? it1 : it0; const int kb = it / nblk, nb = it % nblk;
            const GAS float* src = (const GAS float*)w_up + (size_t)(64 * kb + lr) * FFN2 + 32 * nb + lc;
#pragma unroll
            for (int i = 0; i < 8; ++i) v[s][i] = *(const GAS v4f*)(src + (size_t)(8 * i) * FFN2); }
#pragma unroll
        for (int s = 0; s < 2; ++s) {
            if (s && !two) break;
            const int it = s ? it1 : it0; const int kb = it / nblk, nb = it % nblk, k0 = 64 * kb, n0 = 32 * nb;
            const int f = (n0 < FFN) ? (256 * (n0 >> 7) + (n0 & 127)) : (256 * ((n0 - FFN) >> 7) + 128 + ((n0 - FFN) & 127));
#pragma unroll
            for (int i = 0; i < 8; ++i) { LAS float* d = scr + (lr + 8 * i) * 33 + lc; d[0] = v[s][i].x; d[1] = v[s][i].y; d[2] = v[s][i].z; d[3] = v[s][i].w; }
            LDS_WAIT(); asm volatile("" ::: "memory");
            const int c = X.lane & 7;
#pragma unroll
            for (int j = 0; j < 4; ++j) { const int n = (X.lane >> 3) + 8 * j; const LAS float* sp = scr + (8 * c) * 33 + n;
                v4u o; o.x = pkbf(sp[0 * 33], sp[1 * 33]); o.y = pkbf(sp[2 * 33], sp[3 * 33]); o.z = pkbf(sp[4 * 33], sp[5 * 33]); o.w = pkbf(sp[6 * 33], sp[7 * 33]);
                *(GAS v4u*)(Wup + (size_t)(f + n) * D_MODEL + k0 + 8 * c) = o; }
            LDS_WAIT(); asm volatile("" ::: "memory");
        }
    }
}
__device__ __forceinline__ void tail_transposes_mix(const Ctx& X, int first, const float* w_ssm, const float* w_att, const float* w_out, bf16* Wssm, bf16* Watt, bf16* Wout) {
    if ((int)blockIdx.x < first) return;
    LAS float* scr = (LAS float*)(X.lds + X.wave * 16384);
    constexpr int I_SSM = (SSM_DI / 64) * (D_MODEL / 32), I_ATT = (D_MODEL / 64) * (D_MODEL / 32), NIT = I_SSM + 2 * I_ATT;
    const int gwv = ((int)blockIdx.x - first) * NWAVES_C + X.wave, ngw = (X.G - first) * NWAVES_C;
    for (int it = gwv; it < NIT; it += ngw) {
        int r = it;
        if (r < I_SSM) { transpose_item(w_ssm, SSM_DI, D_MODEL, Wssm, 0, scr, r, X.lane); continue; } r -= I_SSM;
        if (r < I_ATT) { transpose_item(w_att, D_MODEL, D_MODEL, Watt, 0, scr, r, X.lane); continue; } r -= I_ATT;
        transpose_item(w_out, D_MODEL, D_MODEL, Wout, 0, scr, r, X.lane);
    }
}
__device__ __forceinline__ void tail_transposes_down(const Ctx& X, int first, const float* w_dn, bf16* Wdn) {
    if ((int)blockIdx.x < first) return;
    LAS float* scr = (LAS float*)(X.lds + X.wave * 16384);
    constexpr int NIT = (FFN / 64) * (D_MODEL / 32);
    const int gwv = ((int)blockIdx.x - first) * NWAVES_C + X.wave, ngw = (X.G - first) * NWAVES_C;
    for (int it = gwv; it < NIT; it += ngw) transpose_item(w_dn, FFN, D_MODEL, Wdn, 0, scr, it, X.lane);
}
__device__ __forceinline__ void phase_mod_reduce(const Ctx& X, const float* part, const float* b_ada, float* mod) {
    const int gt = X.gw * 64 + X.lane;
    for (int i = gt; i < 4 * MOD_LD / 4; i += X.NGW * 64) {
        const int b = i / (MOD_LD / 4), n = (i % (MOD_LD / 4)) * 4;
        v4f s = *(const GAS v4f*)(b_ada + n);
#pragma unroll 8
        for (int kc = 0; kc < 64; ++kc) s += *(const GAS v4f*)(part + ((size_t)(kc * 4 + b)) * MOD_LD + n);
        *(GAS v4f*)(mod + (size_t)b * MOD_LD + n) = s;
    }
}
__device__ __forceinline__ void ln_stats(const v4f (&v)[16], float& mean, float& rstd) {
    float s = 0.f;
#pragma unroll
    for (int j = 0; j < 16; ++j) s += (v[j].x + v[j].y) + (v[j].z + v[j].w);
    mean = wave_sum(s) * (1.f / D_MODEL); float s2 = 0.f;
#pragma unroll
    for (int j = 0; j < 16; ++j) { const v4f d = v[j] - mean; s2 += (d.x * d.x + d.y * d.y) + (d.z * d.z + d.w * d.w); }
    rstd = 1.0f / sqrtf(wave_sum(s2) * (1.f / D_MODEL) + LN_EPS);
}
__device__ __forceinline__ void phase_h(const Ctx& X, const float* x, const float* mod, bf16* h) {
    for (int m = X.gw; m < MTOK; m += X.NGW) {
        const GAS v4f* xr = (const GAS v4f*)(x + (size_t)m * D_MODEL) + X.lane;
        v4f v[16];
#pragma unroll
        for (int j = 0; j < 16; ++j) v[j] = xr[64 * j];
        float mean, rstd; ln_stats(v, mean, rstd);
        const float* mrow = mod + (size_t)(m / SEQ) * MOD_LD;
        const GAS v4f* sh = (const GAS v4f*)(mrow) + X.lane; const GAS v4f* sc = (const GAS v4f*)(mrow + D_MODEL) + X.lane;
        GAS v2u* o = (GAS v2u*)(h + (size_t)m * D_MODEL) + X.lane;
#pragma unroll
        for (int j = 0; j < 16; ++j) { const v4f y = (v[j] - mean) * rstd * (sc[64 * j] + 1.0f) + sh[64 * j]; v2u w; w.x = pkbf(y.x, y.y); w.y = pkbf(y.z, y.w); o[64 * j] = w; }
    }
}
__device__ __forceinline__ void unpack8(const v4u w, float (&f)[8]) { f[0] = bflo(w.x); f[1] = bfhi(w.x); f[2] = bflo(w.y); f[3] = bfhi(w.y); f[4] = bflo(w.z); f[5] = bfhi(w.z); f[6] = bflo(w.w); f[7] = bfhi(w.w); }
__device__ __forceinline__ void phase_xbc_fixup(const Ctx& X, const float* edge, const float* cw, const float* cb, bf16* out) {
    constexpr int NCG = SSM_CONVD / 8, NSEG = MTOK / 128;
    const int gt = X.gw * 64 + X.lane, NT = X.NGW * 64;
    for (int it = gt; it < (NSEG - 1) * NCG; it += NT) {
        const int bd = 1 + it / NCG, c = 8 * (it % NCG);
        if ((bd & 31) == 0) continue;
        const float* e_lm1 = edge + ((size_t)(bd - 1) * 4 + 2) * SSM_CONVD + c; const float* e_l = e_lm1 + SSM_CONVD;
        const float* e_f = edge + ((size_t)bd * 4 + 0) * SSM_CONVD + c; const float* e_f1 = e_f + SSM_CONVD;
        float oa[8], ob[8];
#pragma unroll
        for (int j = 0; j < 8; ++j) { const float w0 = cw[c + j], w1 = cw[SSM_CONVD + c + j], w2 = cw[2 * SSM_CONVD + c + j], bb = cb[c + j];
            oa[j] = siluf_(e_lm1[j] * w0 + e_l[j] * w1 + e_f[j] * w2 + bb);
            ob[j] = siluf_(e_l[j] * w0 + e_f[j] * w1 + e_f1[j] * w2 + bb); }
        v4u w0_, w1_; w0_.x = pkbf(oa[0], oa[1]); w0_.y = pkbf(oa[2], oa[3]); w0_.z = pkbf(oa[4], oa[5]); w0_.w = pkbf(oa[6], oa[7]);
        w1_.x = pkbf(ob[0], ob[1]); w1_.y = pkbf(ob[2], ob[3]); w1_.z = pkbf(ob[4], ob[5]); w1_.w = pkbf(ob[6], ob[7]);
        *(GAS v4u*)(out + (size_t)(128 * bd - 1) * SSM_CONVD + c) = w0_; *(GAS v4u*)(out + (size_t)(128 * bd) * SSM_CONVD + c) = w1_;
    }
}
__device__ __forceinline__ void qk_norm_rope_rows(const Ctx& X, bf16* buf, int nheads, const float* nw, const float* tab) {
    const int total = MTOK * nheads / 4;
    const int sub = X.lane >> 4, j16 = X.lane & 15;
    float wv[8];
#pragma unroll
    for (int e = 0; e < 8; ++e) wv[e] = nw[j16 * 8 + e];
    const int half = j16 >> 3, jj = j16 & 7;
    const bool is_x2 = (jj >= 4);
    const int i0 = (jj & 3) * 8;
    for (int it = X.gw; it < total; it += X.NGW) {
        const int pair = it * 4 + sub, tok = pair / nheads, hd = pair % nheads;
        GAS v4u* p = (GAS v4u*)(buf + ((size_t)tok * nheads + hd) * 128 + j16 * 8);
        float f[8]; unpack8(*p, f);
        float ss = 0.f;
#pragma unroll
        for (int e = 0; e < 8; ++e) ss += f[e] * f[e];
        ss += __shfl_xor(ss, 1); ss += __shfl_xor(ss, 2); ss += __shfl_xor(ss, 4); ss += __shfl_xor(ss, 8);
        const float r = 1.0f / sqrtf(ss * (1.f / 128.f) + RMS_EPS);
#pragma unroll
        for (int e = 0; e < 8; ++e) f[e] = f[e] * r * wv[e];
        const int t = tok % SEQ; const int pos = half ? (t % GRID_W) : (t / GRID_W);
        const GAS v4f* tp = (const GAS v4f*)(tab + (size_t)(pos * 32 + i0) * 2);
        float csn[16];
#pragma unroll
        for (int q4 = 0; q4 < 4; ++q4) { const v4f tv = tp[q4]; csn[q4 * 4 + 0] = tv.x; csn[q4 * 4 + 1] = tv.y; csn[q4 * 4 + 2] = tv.z; csn[q4 * 4 + 3] = tv.w; }
        float o[8];
#pragma unroll
        for (int e = 0; e < 8; ++e) { const float other = __shfl_xor(f[e], 4); const float cs = csn[2 * e], sn = csn[2 * e + 1];
            o[e] = is_x2 ? (f[e] * cs + other * sn) : (f[e] * cs - other * sn); }
        v4u w; w.x = pkbf(o[0], o[1]); w.y = pkbf(o[2], o[3]); w.z = pkbf(o[4], o[5]); w.w = pkbf(o[6], o[7]);
        *p = w;
    }
}
__device__ __forceinline__ void ssd_naive_unit(const Ctx& X, int unit, const bf16* xbc, const float* dtb, const float* a_log, bf16* yout) {
    const int dir = unit & 1, head = (unit >> 1) & 127, b = unit >> 8, grp = head >> 4;
    const int tid = X.tid, p = tid >> 3, ng = tid & 7;
    LAS float* xs = (LAS float*)X.lds;
    LAS float* Bs = xs + 64 * 64;
    LAS float* Cs = Bs + 64 * 128;
    LAS float* dts = Cs + 64 * 128;
    LAS float* as_ = dts + 64;
    LAS float* ys = as_ + 64;
    const float A = -__expf(a_log[dir * SSM_H + head]);
    float h[16];
#pragma unroll
    for (int i = 0; i < 16; ++i) h[i] = 0.f;
    for (int ci = 0; ci < SEQ / 64; ++ci) {
        const int c = dir ? (SEQ / 64 - 1 - ci) : ci; const size_t row0 = (size_t)b * SEQ + (size_t)c * 64;
        { const int tok = tid >> 3, s8 = (tid & 7);
          const bf16* rp = xbc + (row0 + tok) * SSM_CONVD;
          float f[8]; unpack8(*(const GAS v4u*)(rp + head * 64 + s8 * 8), f);
#pragma unroll
          for (int j = 0; j < 8; ++j) xs[tok * 64 + s8 * 8 + j] = f[j];
          unpack8(*(const GAS v4u*)(rp + SSM_DI + grp * 128 + s8 * 16), f);
#pragma unroll
          for (int j = 0; j < 8; ++j) Bs[tok * 128 + s8 * 16 + j] = f[j];
          unpack8(*(const GAS v4u*)(rp + SSM_DI + grp * 128 + s8 * 16 + 8), f);
#pragma unroll
          for (int j = 0; j < 8; ++j) Bs[tok * 128 + s8 * 16 + 8 + j] = f[j];
          unpack8(*(const GAS v4u*)(rp + SSM_DI + 1024 + grp * 128 + s8 * 16), f);
#pragma unroll
          for (int j = 0; j < 8; ++j) Cs[tok * 128 + s8 * 16 + j] = f[j];
          unpack8(*(const GAS v4u*)(rp + SSM_DI + 1024 + grp * 128 + s8 * 16 + 8), f);
#pragma unroll
          for (int j = 0; j < 8; ++j) Cs[tok * 128 + s8 * 16 + 8 + j] = f[j];
          if (tid < 64) { const float dv = dtb[(row0 + tid) * 256 + dir * SSM_H + head]; dts[tid] = dv; as_[tid] = __expf(dv * A); } }
        __syncthreads();
#pragma unroll 2
        for (int ti = 0; ti < 64; ++ti) {
            const int t = dir ? 63 - ti : ti;
            const float av = as_[t], xv = xs[t * 64 + p] * dts[t];
            float part = 0.f;
#pragma unroll
            for (int i4 = 0; i4 < 4; ++i4) { const v4f bv = *(const LAS v4f*)(Bs + t * 128 + ng * 16 + i4 * 4), cv = *(const LAS v4f*)(Cs + t * 128 + ng * 16 + i4 * 4);
#pragma unroll
                for (int j = 0; j < 4; ++j) { h[i4 * 4 + j] = av * h[i4 * 4 + j] + xv * bv[j]; part += cv[j] * h[i4 * 4 + j]; } }
            part += __shfl_xor(part, 1); part += __shfl_xor(part, 2); part += __shfl_xor(part, 4);
            if (ng == 0) ys[t * 64 + p] = part;
        }
        __syncthreads();
        { const int tok = tid >> 3, s8 = tid & 7; const LAS float* yp = ys + tok * 64 + s8 * 8;
          v4u o; o.x = pkbf(yp[0], yp[1]); o.y = pkbf(yp[2], yp[3]); o.z = pkbf(yp[4], yp[5]); o.w = pkbf(yp[6], yp[7]);
          *(GAS v4u*)(yout + (row0 + tok) * SSM_DI + head * 64 + s8 * 8) = o; }
    }
    __syncthreads();
}
__device__ __forceinline__ void phase_ssm_combine(const Ctx& X, const bf16* yf, const bf16* yb, bf16* z, const float* normw) {
    for (int it = X.gw; it < MTOK * SSM_G; it += X.NGW) {
        const int tok = it >> 3, g = it & 7, e0 = g * 1024 + X.lane * 16;
        float y[16];
#pragma unroll
        for (int hh = 0; hh < 2; ++hh) { float a[8], bq[8], zz[8];
            unpack8(*(const GAS v4u*)(yf + (size_t)tok * SSM_DI + e0 + hh * 8), a); unpack8(*(const GAS v4u*)(yb + (size_t)tok * SSM_DI + e0 + hh * 8), bq);
            unpack8(*(const GAS v4u*)(z + (size_t)tok * SSM_DI + e0 + hh * 8), zz);
#pragma unroll
            for (int j = 0; j < 8; ++j) y[hh * 8 + j] = (a[j] + bq[j]) * siluf_(zz[j]); }
        float ss = 0.f;
#pragma unroll
        for (int j = 0; j < 16; ++j) ss += y[j] * y[j];
        const float r = 1.0f / sqrtf(wave_sum(ss) * (1.f / 1024.f) + RMS_EPS);
#pragma unroll
        for (int hh = 0; hh < 2; ++hh) { float o[8];
#pragma unroll
            for (int j = 0; j < 8; ++j) o[j] = y[hh * 8 + j] * r * normw[e0 + hh * 8 + j];
            v4u w; w.x = pkbf(o[0], o[1]); w.y = pkbf(o[2], o[3]); w.z = pkbf(o[4], o[5]); w.w = pkbf(o[6], o[7]);
            *(GAS v4u*)(z + (size_t)tok * SSM_DI + e0 + hh * 8) = w; }
    }
}
__device__ __forceinline__ void phase_ln1(const Ctx& X, const float* r1, const float* g, const float* bt, const float* mod, float* stats, bf16* h2) {
    for (int m = X.gw; m < MTOK; m += X.NGW) {
        const GAS v4f* rr = (const GAS v4f*)(r1 + (size_t)m * D_MODEL) + X.lane;
        v4f v[16];
#pragma unroll
        for (int j = 0; j < 16; ++j) v[j] = rr[64 * j];
        float mean, rstd; ln_stats(v, mean, rstd);
        const float* gl = g; const float* bl = bt; asm volatile("" : "+s"(gl), "+s"(bl));
        const GAS v4f* gp = (const GAS v4f*)gl + X.lane; const GAS v4f* bp = (const GAS v4f*)bl + X.lane;
        if (X.lane == 0) { typedef float f2_ __attribute__((ext_vector_type(2))); *(GAS f2_*)(stats + 2 * (size_t)m) = (f2_){mean, rstd}; }
#pragma unroll
        for (int j = 0; j < 16; ++j) { v[j] = (v[j] - mean) * rstd * gp[64 * j] + bp[64 * j]; if ((j & 3) == 3) asm volatile("" ::: "memory"); }
        ln_stats(v, mean, rstd);
        const float* mrow = mod + (size_t)(m / SEQ) * MOD_LD;
        const GAS v4f* sh = (const GAS v4f*)(mrow + 3 * D_MODEL) + X.lane; const GAS v4f* sc = (const GAS v4f*)(mrow + 4 * D_MODEL) + X.lane;
        GAS v2u* o = (GAS v2u*)(h2 + (size_t)m * D_MODEL) + X.lane;
#pragma unroll
        for (int j = 0; j < 16; ++j) { const v4f y = (v[j] - mean) * rstd * (sc[64 * j] + 1.0f) + sh[64 * j]; v2u w; w.x = pkbf(y.x, y.y); w.y = pkbf(y.z, y.w); o[64 * j] = w; }
    }
}
__device__ __forceinline__ void phase_conv_fixup(const Ctx& X, const float* edge, const float* cw, const float* cb, bf16* act) {
    constexpr int NCG = FFN / 8, NSEG = MTOK / 128;
    const int gt = X.gw * 64 + X.lane, NT = X.NGW * 64;
    for (int it = gt; it < (NSEG - 1) * NCG; it += NT) {
        const int bd = 1 + it / NCG, cg = it % NCG;
        if ((bd & 31) == 0) continue;
        const int c = 8 * cg, tca = 256 * (c >> 7) + (c & 127);
        const float* e_lm1 = edge + ((size_t)(bd - 1) * 4 + 2) * 22016 + tca;
        const float* e_l = e_lm1 + 22016;
        const float* e_f = edge + ((size_t)bd * 4 + 0) * 22016 + tca;
        const float* e_f1 = e_f + 22016;
        float oa[8], ob[8];
#pragma unroll
        for (int j = 0; j < 8; ++j) {
            const float wa0 = cw[c + j], wa1 = cw[FFN2 + c + j], wa2 = cw[2 * FFN2 + c + j], ba = cb[c + j];
            const float wb0 = cw[FFN + c + j], wb1 = cw[FFN2 + FFN + c + j], wb2 = cw[2 * FFN2 + FFN + c + j], bb = cb[FFN + c + j];
            const float a_lm1 = e_lm1[j], a_l = e_l[j], a_f = e_f[j], a_f1 = e_f1[j], b_lm1 = e_lm1[128 + j], b_l = e_l[128 + j], b_f = e_f[128 + j], b_f1 = e_f1[128 + j];
            const float ca0 = a_lm1 * wa0 + a_l * wa1 + a_f * wa2 + ba, cb0 = b_lm1 * wb0 + b_l * wb1 + b_f * wb2 + bb;
            const float ca1 = a_l * wa0 + a_f * wa1 + a_f1 * wa2 + ba, cb1 = b_l * wb0 + b_f * wb1 + b_f1 * wb2 + bb;
            oa[j] = siluf_(ca0) * cb0; ob[j] = siluf_(ca1) * cb1; }
        v4u w0, w1; w0.x = pkbf(oa[0], oa[1]); w0.y = pkbf(oa[2], oa[3]); w0.z = pkbf(oa[4], oa[5]); w0.w = pkbf(oa[6], oa[7]);
        w1.x = pkbf(ob[0], ob[1]); w1.y = pkbf(ob[2], ob[3]); w1.z = pkbf(ob[4], ob[5]); w1.w = pkbf(ob[6], ob[7]);
        *(GAS v4u*)(act + (size_t)(128 * bd - 1) * FFN + c) = w0; *(GAS v4u*)(act + (size_t)(128 * bd) * FFN + c) = w1;
    }
}
__device__ __forceinline__ void phase_ln_final(const Ctx& X, float* io, const float* g, const float* bt) {
    for (int m = X.gw; m < MTOK; m += X.NGW) {
        GAS v4f* rr = (GAS v4f*)(io + (size_t)m * D_MODEL) + X.lane;
        v4f v[16];
#pragma unroll
        for (int j = 0; j < 16; ++j) v[j] = rr[64 * j];
        float mean, rstd; ln_stats(v, mean, rstd);
        const GAS v4f* gp = (const GAS v4f*)g + X.lane; const GAS v4f* bp = (const GAS v4f*)bt + X.lane;
#pragma unroll
        for (int j = 0; j < 16; ++j) rr[64 * j] = (v[j] - mean) * rstd * gp[64 * j] + bp[64 * j];
    }
}
constexpr int N_PHASES = 15;
struct Args { const float* in[26]; float* out; unsigned char* ws; int ph_lo, ph_hi; };
__global__ void __launch_bounds__(NWAVES * 64, 2) mk_fwd(Args args) {
    extern __shared__ __attribute__((aligned(16))) unsigned char lds[];
    volatile LAS unsigned* MISC = (volatile LAS unsigned*)((LAS unsigned char*)lds + MISC_OFF);
    unsigned char* const ws = args.ws;
    for (int u = threadIdx.x; u < (LDS_BYTES - LDS_ZERO_OFF) / 4; u += NWAVES * 64) ((LAS unsigned*)((LAS unsigned char*)lds + LDS_ZERO_OFF))[u] = 0u;
    __syncthreads();
    const int s_wave = __builtin_amdgcn_readfirstlane((int)threadIdx.x >> 6);
#define TIDX() ((s_wave << 6) | lane_id_now())
    XcdBarrier bar = xcd_barrier_post((unsigned*)(ws + WS_CTL), MISC + 8, TIDX());
    const int lo = args.ph_lo, hi = args.ph_hi;
#define IN(k) (lo <= (k) && (k) < hi)
#define SEAM(k) do { if (IN(k) && IN((k) + 1)) xcd_barrier(bar, TIDX()); } while (0)
#define MKCTX() Ctx X; { int t_ = TIDX(); asm volatile("" : "+v"(t_)); X.lds = (LAS unsigned char*)lds; X.tid = t_; X.lane = t_ & 63; X.wave = __builtin_amdgcn_readfirstlane(t_ >> 6); \
        X.G = gridDim.x; X.gw = blockIdx.x * NWAVES + X.wave; X.NGW = X.G * NWAVES; }
#define x_in args.in[0]
#define mod ((float*)(ws + WS_MOD))
#define ropetab ((float*)(ws + WS_MOD + 393216))
#define Wcat ((bf16*)(ws + WS_WCAT))
#define Wssm ((bf16*)(ws + WS_WSSM))
#define Watt ((bf16*)(ws + WS_WATT))
#define Wout ((bf16*)(ws + WS_WOUT))
#define Wup ((bf16*)(ws + WS_WUP))
#define Wdn ((bf16*)(ws + WS_WDN))
#define hbuf ((bf16*)(ws + WS_H))
#define zbuf ((bf16*)(ws + WS_Z))
#define edge1 ((float*)(ws + WS_EDGE1))
#define dtb ((float*)(ws + WS_DT))
#define qb ((bf16*)(ws + WS_Q))
#define kb ((bf16*)(ws + WS_K))
#define vb ((bf16*)(ws + WS_V))
#define gates ((bf16*)(ws + WS_GATES))
#define xbcc ((bf16*)(ws + WS_XBCC))
#define yfb ((bf16*)args.out)
#define ybb ((bf16*)(ws + WS_YB))
#define pm ((bf16*)(ws + WS_PM))
#define r1 ((float*)(ws + WS_R1))
#define st1 ((float*)(ws + WS_ST1))
#define h2 ((bf16*)(ws + WS_H2))
#define edgeb ((float*)(ws + WS_EDGE))
#define act ((bf16*)(ws + WS_ACT))

    if (IN(0)) { MKCTX();
        P0Args A{args.in[1], args.in[2], args.in[3], mod, ropetab, args.in[4], args.in[15], args.in[13], args.in[14], args.in[17], args.in[20], args.in[23], Wcat, Wssm, Watt, Wout, Wup, Wdn};
        phase_prologue(X, A);
    }
    SEAM(0);
    if (IN(2)) { MKCTX(); phase_h(X, x_in, mod, hbuf); }
    SEAM(2);
    if (IN(3)) { MKCTX();
        pg8::Gemm g{hbuf, Wcat, MTOK, CAT_COLS, D_MODEL}; pg8::StaticOrder S; S.init(MTOK, CAT_COLS, X.G, (int)blockIdx.x);
        pg8::EpiIn E{zbuf, xbcc, qb, kb, vb, gates, dtb, args.in[8], args.in[16], args.in[5], args.in[6], edge1};
        pg8::gemm_phase<pg8::EpiIn, pg8::StaticOrder, true, true>(X.lds, g, S, E, X.tid);
    }
    if (IN(3)) { MKCTX();
        { const int nwg = (MTOK / 256) * (CAT_COLS / 256), first = nwg % X.G; if (first) tail_transposes_mix(X, first, args.in[13], args.in[14], args.in[17], Wssm, Watt, Wout); else tail_transposes_mix(X, 0, args.in[13], args.in[14], args.in[17], Wssm, Watt, Wout); }
    }
    SEAM(3);
    if (IN(4)) { MKCTX();
        phase_xbc_fixup(X, edge1, args.in[5], args.in[6], xbcc);
        qk_norm_rope_rows(X, kb, AT_HKV, args.in[12], ropetab);
    }
    SEAM(4);
    if (IN(5)) { MKCTX();
        const bool xcd_map = (X.G == 256);
        const int up_pos = ((int)blockIdx.x & 7) % 5; int slot = 0;
        for (int u = blockIdx.x; u < BATCH * SSM_H * 2; u += X.G, ++slot) {
            if (slot == up_pos) { __syncthreads(); transposes_up_share(X, args.in[20], Wup); __syncthreads(); }
            int unit = u;
            if (xcd_map) { const int c = blockIdx.x, r = u >> 8, grp = c & 7, j = c >> 3; unit = ((r * SSM_H + grp * 16 + (j & 15)) << 1) | (j >> 4); }
            ssd::ssd_unit((LAS char*)X.lds, unit, xbcc, dtb, args.in[7], args.in[9], (unit & 1) ? ybb : yfb, X.tid);
        }
        if (slot <= up_pos) { __syncthreads(); transposes_up_share(X, args.in[20], Wup); __syncthreads(); }
        {
            auto unit_ptrs = [&](int u, size_t& qoff, size_t& koff, int& qblk) {
                qblk = u % (SEQ / 256); int hh = (u / (SEQ / 256)) % AT_HQ, b = u / ((SEQ / 256) * AT_HQ);
                if (xcd_map) { const int c = blockIdx.x, r = u >> 8, kvh_ = c & 7, j = (c >> 3) + 32 * (r & 1); b = r >> 1; hh = kvh_ * (AT_HQ / AT_HKV) + (j >> 4); qblk = j & 15; }
                const int kvh = hh / (AT_HQ / AT_HKV);
                qoff = ((size_t)b * SEQ + (size_t)qblk * 256) * (AT_HQ * AT_D) + (size_t)hh * AT_D; koff = (size_t)b * SEQ * (AT_HKV * AT_D) + (size_t)kvh * AT_D; };
            const int NU = BATCH * AT_HQ * (SEQ / 256);
            attn::AttnPre P; size_t qoff, koff; int qblk;
            if ((int)blockIdx.x < NU) { unit_ptrs(blockIdx.x, qoff, koff, qblk); attn::attn_prime(P, qb + qoff, kb + koff, vb + koff, X.tid); }
            for (int u = blockIdx.x; u < NU; u += X.G) {
                const bool has_next = u + X.G < NU; size_t qn = qoff, kn = koff; int qbn = qblk;
                if (has_next) unit_ptrs(u + X.G, qn, kn, qbn);
                attn::attn_dense_body(P, kb + koff, vb + koff, qb + qoff, SEQ, (char*)lds, args.in[11], ropetab, qblk * 256, X.tid, qb + qn, kb + kn, vb + kn, has_next);
                qoff = qn; koff = kn; qblk = qbn;
            }
        }
        __syncthreads();
    }
    SEAM(5);
    if (IN(6)) { MKCTX(); phase_ssm_combine(X, yfb, ybb, zbuf, args.in[10]); }
    SEAM(6);
    if (IN(7)) { MKCTX();
        pg8::Gemm g{zbuf, Wssm, MTOK, D_MODEL, SSM_DI}; pg8::StaticOrder S; S.init(MTOK, D_MODEL, X.G, (int)blockIdx.x);
        pg8::EpiMix E{gates, pm, 0};
        pg8::gemm_phase<pg8::EpiMix, pg8::StaticOrder, true, true>(X.lds, g, S, E, X.tid);
    }
    if (IN(8)) { MKCTX();
        pg8::Gemm g{qb, Watt, MTOK, D_MODEL, D_MODEL}; pg8::StaticOrder S; S.init(MTOK, D_MODEL, X.G, (int)blockIdx.x);
        pg8::EpiMix E{gates, pm, 1};
        pg8::gemm_phase<pg8::EpiMix, pg8::StaticOrder, true, true>(X.lds, g, S, E, X.tid);
    }
    SEAM(8);
    if (IN(9)) { MKCTX();
        pg8::Gemm g{pm, Wout, MTOK, D_MODEL, D_MODEL}; pg8::StaticOrder S; S.init(MTOK, D_MODEL, X.G, (int)blockIdx.x);
        pg8::EpiRes E{x_in, r1, mod + 2 * D_MODEL, DN_ALPHA};
        pg8::gemm_phase<pg8::EpiRes, pg8::StaticOrder, true, true>(X.lds, g, S, E, X.tid);
    }
    SEAM(9);
    if (IN(10)) { MKCTX(); phase_ln1(X, r1, args.in[18], args.in[19], mod, st1, h2); }
    SEAM(10);
    if (IN(11)) { MKCTX();
        pg8::Gemm g{h2, Wup, MTOK, FFN2, D_MODEL}; pg8::StaticOrder S; S.init(MTOK, FFN2, X.G, (int)blockIdx.x);
        pg8::EpiConvGate E{act, edgeb, args.in[21], args.in[22]};
        pg8::gemm_phase<pg8::EpiConvGate, pg8::StaticOrder, true, true>(X.lds, g, S, E, X.tid);
    }
    if (IN(11)) { MKCTX();
        { const int nwg = (MTOK / 256) * (FFN2 / 256), first = nwg % X.G; tail_transposes_down(X, first, args.in[23], Wdn); }
    }
    SEAM(11);
    if (IN(12)) { MKCTX(); phase_conv_fixup(X, edgeb, args.in[21], args.in[22], act); }
    SEAM(12);
    if (IN(13)) { MKCTX();
        pg8::Gemm g{act, Wdn, MTOK, D_MODEL, FFN}; pg8::StaticOrder S; S.init(MTOK, D_MODEL, X.G, (int)blockIdx.x);
        pg8::EpiResLn E{r1, st1, args.in[18], args.in[19], args.out, mod + 5 * D_MODEL, DN_ALPHA};
        pg8::gemm_phase<pg8::EpiResLn, pg8::StaticOrder, true, true>(X.lds, g, S, E, X.tid);
    }
    SEAM(13);
    if (IN(14)) { MKCTX(); phase_ln_final(X, args.out, args.in[24], args.in[25]); }
#undef IN
#undef SEAM
#undef MKCTX
#undef TIDX
#undef x_in
#undef mod
#undef ropetab
#undef Wcat
#undef Wssm
#undef Watt
#undef Wout
#undef Wup
#undef Wdn
#undef hbuf
#undef zbuf
#undef edge1
#undef dtb
#undef qb
#undef kb
#undef vb
#undef gates
#undef xbcc
#undef yfb
#undef ybb
#undef pm
#undef r1
#undef st1
#undef h2
#undef edgeb
#undef act
}

extern "C" void kernel_launch(void* const* d_in, const int* in_sizes, int n_in, void* d_out, int out_size, void* d_ws, size_t ws_size, hipStream_t stream) {
    static int grid = 0;
    if (grid == 0) {
        if (n_in != 26 || in_sizes[0] != MTOK * D_MODEL || out_size != MTOK * D_MODEL || ws_size < WS_END) {
            fprintf(stderr, "kernel_launch: shape mismatch (n_in %d in0 %d out %d ws %zu need %zu); nothing launched\n", n_in, n_in > 0 ? in_sizes[0] : -1, out_size, ws_size, (size_t)WS_END); grid = -1; return; }
        int dev = 0, cus = 0, per_cu = 0;
        if (hipGetDevice(&dev) != hipSuccess || hipDeviceGetAttribute(&cus, hipDeviceAttributeMultiprocessorCount, dev) != hipSuccess) { grid = -1; return; }
        if (hipFuncSetAttribute((const void*)mk_fwd, hipFuncAttributeMaxDynamicSharedMemorySize, LDS_BYTES) != hipSuccess) { fprintf(stderr, "kernel_launch: hipFuncSetAttribute failed\n"); grid = -1; return; }
        if (hipOccupancyMaxActiveBlocksPerMultiprocessor(&per_cu, (const void*)mk_fwd, NWAVES * 64, LDS_BYTES) != hipSuccess || per_cu < 1) { fprintf(stderr, "kernel_launch: occupancy query says %d blocks per CU\n", per_cu); }
        (void)hipGetLastError();
        grid = cus;
    }
    if (grid < 0) return;
    if (hipMemsetAsync((char*)d_ws + WS_CTL, 0, CTL_ZERO_BYTES, stream) != hipSuccess) return;
    Args a{};
    for (int i = 0; i < 26; ++i) a.in[i] = (const float*)d_in[i];
    a.out = (float*)d_out; a.ws = (unsigned char*)d_ws; a.ph_lo = 0; a.ph_hi = N_PHASES;
    hipLaunchKernelGGL(mk_fwd, dim3(grid), dim3(NWAVES * 64), LDS_BYTES, stream, a);
    const hipError_t le = hipPeekAtLastError();
    if (le != hipSuccess) fprintf(stderr, "kernel_launch: launch failed: %s\n", hipGetErrorName(le));
}
```

```cpp
#include <hip/hip_runtime.h>
#include <cstdio>
#include <cstdint>

#define GAS __attribute__((address_space(1)))
#define LAS __attribute__((address_space(3)))
typedef unsigned short bf16;
typedef unsigned v4u __attribute__((ext_vector_type(4)));
typedef unsigned v2u __attribute__((ext_vector_type(2)));
typedef float v4f __attribute__((ext_vector_type(4)));

constexpr int D_MODEL = 4096, BATCH = 4, SEQ = 4096, MTOK = BATCH * SEQ;
constexpr int GRID_W = 64;
constexpr int SSM_DI = 8192, SSM_HD = 64, SSM_H = 128, SSM_G = 8, SSM_N = 128, SSM_CONVD = 10240;
constexpr int AT_D = 128, AT_HQ = 32, AT_HKV = 8;
constexpr int FFN = 11008, FFN2 = 22016;
constexpr int IN_COLS = 24832, CAT_COLS = IN_COLS + 2 * D_MODEL;
constexpr float LN_EPS = 1e-5f, RMS_EPS = 1e-6f;
constexpr float DN_ALPHA = 1.189207115002721f;
constexpr int MOD_LD = 6 * D_MODEL;

__device__ __forceinline__ float bf2f(unsigned b) { return __uint_as_float(b << 16); }
__device__ __forceinline__ float bflo(unsigned w) { return __uint_as_float(w << 16); }
__device__ __forceinline__ float bfhi(unsigned w) { return __uint_as_float(w & 0xffff0000u); }
__device__ __forceinline__ unsigned pkbf(float lo, float hi) { unsigned r; asm volatile("v_cvt_pk_bf16_f32 %0, %1, %2" : "=v"(r) : "v"(lo), "v"(hi)); return r; }
__device__ __forceinline__ float sigmoidf_(float v) { return __builtin_amdgcn_rcpf(1.0f + __expf(-v)); }
__device__ __forceinline__ float siluf_(float v) { return v * __builtin_amdgcn_rcpf(1.0f + __expf(-v)); }
__device__ __forceinline__ float softplusf_(float v) { return v > 20.f ? v : log1pf(__expf(v)); }
__device__ __forceinline__ float wave_sum(float v) {
#pragma unroll
    for (int o = 1; o < 64; o <<= 1) v += __shfl_xor(v, o);
    return v;
}
__device__ __forceinline__ int lane_id_now() { int l; asm volatile("v_mbcnt_lo_u32_b32 %0, -1, 0\n\tv_mbcnt_hi_u32_b32 %0, -1, %0" : "=v"(l)); return l; }
namespace pg8 {
#define PG8_LAS __attribute__((address_space(3)))
typedef unsigned short bf16_t;
typedef short bf16x8 __attribute__((ext_vector_type(8)));
typedef float f32x4 __attribute__((ext_vector_type(4)));
typedef unsigned u32x4 __attribute__((ext_vector_type(4)));
constexpr int BM = 256, BK = 64, HALF = 128, HTB = HALF * BK * 2  , STAGE_BYTES = 8 * HTB, NXCD = 8, WGM = 8;

__host__ __device__ __forceinline__ int lds_byte(int r, int c) { const int st = (r >> 4) * 2 + (c >> 5), rr = r & 15, cc = c & 31, ob = rr * 64 + cc * 2; return st * 1024 + (ob ^ (((ob >> 9) & 1) << 5)); }
__host__ __device__ __forceinline__ void stage_rc(int b, int& R, int& C) { const int st = b / 1024, sb = b % 1024, swz = sb ^ (((sb >> 9) & 1) << 5); R = (st >> 1) * 16 + swz / 64; C = (st & 1) * 32 + (swz % 64) / 2; }
__host__ __device__ __forceinline__ int perm32(int rho) { const int n = rho >> 4, i = rho & 15; return 8 * (i >> 2) + 4 * n + (i & 3); }

struct Unit { int pm, pn; };
struct Gemm { const bf16_t* A; const bf16_t* Bt; int M, N, K; };

struct StaticOrder {
    int nM, nN, nwg, G, c;
    __host__ __device__ void init(int M, int N, int G_, int c_) { nM = M / BM; nN = N / BM; nwg = nM * nN; G = G_; c = c_; }
    __host__ __device__ bool next(int i, Unit& u) const {
        const long L = (long)i * G + c; if (L >= nwg) return false;
        int wgid = (int)L; { const int q = nwg / NXCD, r = nwg % NXCD, xcd = wgid % NXCD, off = wgid / NXCD; wgid = (xcd < r ? xcd * (q + 1) : r * (q + 1) + (xcd - r) * q) + off; }
        const int nig = WGM * nN, gid = wgid / nig, fm = gid * WGM, gsz = (nM - fm) < WGM ? (nM - fm) : WGM;
        u.pm = fm + ((wgid % nig) % gsz); u.pn = (wgid % nig) / gsz; return true;
    }
    __device__ __forceinline__ void a_ready(const Unit&) const {}
    __device__ __forceinline__ void done(const Unit&) const {}
};

__device__ __forceinline__ unsigned cvt_pk_bf16(float lo, float hi) { unsigned r; asm volatile("v_cvt_pk_bf16_f32 %0, %1, %2" : "=v"(r) : "v"(lo), "v"(hi)); return r; }
typedef float f32x2 __attribute__((ext_vector_type(2)));
__device__ __forceinline__ void st8bf(bf16_t* p, const f32x4& v0, const f32x4& v1) {
    u32x4 w; w.x = cvt_pk_bf16(v0[0], v0[1]); w.y = cvt_pk_bf16(v0[2], v0[3]); w.z = cvt_pk_bf16(v1[0], v1[1]); w.w = cvt_pk_bf16(v1[2], v1[3]);
    *(u32x4*)p = w;
}
__device__ __forceinline__ void ld8bf(const bf16_t* p, f32x4& v0, f32x4& v1) {
    const u32x4 w = *(const u32x4*)p;
    v0 = (f32x4){__uint_as_float(w.x << 16), __uint_as_float(w.x & 0xffff0000u), __uint_as_float(w.y << 16), __uint_as_float(w.y & 0xffff0000u)};
    v1 = (f32x4){__uint_as_float(w.z << 16), __uint_as_float(w.z & 0xffff0000u), __uint_as_float(w.w << 16), __uint_as_float(w.w & 0xffff0000u)};
}
__device__ __forceinline__ float epi_sigmoid(float v) { return __builtin_amdgcn_rcpf(1.0f + __expf(-v)); }
__device__ __forceinline__ float epi_softplus(float v) { return v > 20.f ? v : log1pf(__expf(v)); }

__device__ __forceinline__ float dpp_prev(float v) { return __uint_as_float((unsigned)__builtin_amdgcn_update_dpp(0, (int)__float_as_uint(v), 0x111, 0xF, 0xF, true)); }
__device__ __forceinline__ float dpp_next(float v) { return __uint_as_float((unsigned)__builtin_amdgcn_update_dpp(0, (int)__float_as_uint(v), 0x101, 0xF, 0xF, true)); }
__device__ __forceinline__ f32x4 dpp_prev4(const f32x4& v) { return (f32x4){dpp_prev(v[0]), dpp_prev(v[1]), dpp_prev(v[2]), dpp_prev(v[3])}; }
__device__ __forceinline__ f32x4 dpp_next4(const f32x4& v) { return (f32x4){dpp_next(v[0]), dpp_next(v[1]), dpp_next(v[2]), dpp_next(v[3])}; }
struct EpiIn {
    static constexpr bool PERM = true, AFTER_DRAIN = false, APERM = true;
    bf16_t *z, *xbc, *q, *k, *v, *gates; float* dt; const float* dt_bias; const float* b_gate; const float* cw; const float* cb; float* edge;
    __device__ __forceinline__ void operator()(const f32x4 (&acc)[2][2][4][2], const Unit& u, int wr, int wc, int fr, int fq) const {
        const int pn = u.pn, row0 = u.pm * BM + wr * 128 + fr * 8, cw_ = wc * 32 + 8 * fq;
        if (pn == 72) {
#pragma unroll
            for (int bj = 0; bj < 2; ++bj) { const int col = cw_ + bj * HALF; const f32x4 b0 = *(const f32x4*)(dt_bias + col), b1 = *(const f32x4*)(dt_bias + col + 4);
#pragma unroll
                for (int ai = 0; ai < 2; ++ai)
#pragma unroll
                    for (int m = 0; m < 4; ++m) { f32x4 v0 = acc[ai][bj][m][0] + b0, v1 = acc[ai][bj][m][1] + b1;
#pragma unroll
                        for (int j = 0; j < 4; ++j) { v0[j] = epi_softplus(v0[j]); v1[j] = epi_softplus(v1[j]); }
                        float* p = dt + (size_t)(row0 + ai * 4 + m) * 256 + col; *(f32x4*)p = v0; *(f32x4*)(p + 4) = v1; } }
            return;
        }
        if (pn >= 32 && pn < 72) {
            const int seg = 2 * u.pm + wr;
#pragma unroll
            for (int bj = 0; bj < 2; ++bj)
#pragma unroll
                for (int n = 0; n < 2; ++n) {
                    const int ch = (pn - 32) * 256 + bj * HALF + cw_ + 4 * n;
                    const f32x4 w0 = *(const f32x4*)(cw + ch), w1 = *(const f32x4*)(cw + 10240 + ch), w2 = *(const f32x4*)(cw + 2 * 10240 + ch), bb = *(const f32x4*)(cb + ch);
#pragma unroll
                    for (int kk = 0; kk < 8; ++kk) {
                        const f32x4 um = (kk == 0) ? dpp_prev4(acc[1][bj][3][n]) : acc[(kk - 1) >> 2][bj][(kk - 1) & 3][n], up = (kk == 7) ? dpp_next4(acc[0][bj][0][n]) : acc[(kk + 1) >> 2][bj][(kk + 1) & 3][n];
                        const f32x4 c4 = um * w0 + acc[kk >> 2][bj][kk & 3][n] * w1 + up * w2 + bb;
                        typedef unsigned u32x2_ __attribute__((ext_vector_type(2)));
                        u32x2_ w; w.x = cvt_pk_bf16(c4[0] * epi_sigmoid(c4[0]), c4[1] * epi_sigmoid(c4[1])); w.y = cvt_pk_bf16(c4[2] * epi_sigmoid(c4[2]), c4[3] * epi_sigmoid(c4[3]));
                        *(u32x2_*)(xbc + (size_t)(row0 + kk) * 10240 + ch) = w;
                    }
                    if (fr == 0) { float* ep = edge + ((size_t)seg * 4 + 0) * 10240 + ch; *(f32x4*)ep = acc[0][bj][0][n]; *(f32x4*)(ep + 10240) = acc[0][bj][1][n]; }
                    if (fr == 15) { float* ep = edge + ((size_t)seg * 4 + 2) * 10240 + ch; *(f32x4*)ep = acc[1][bj][2][n]; *(f32x4*)(ep + 10240) = acc[1][bj][3][n]; }
                    asm volatile("" ::: "memory");
                }
            return;
        }
        bf16_t* base; int ldc, colt, mode = 0;
        if (pn < 32) { base = z; ldc = 8192; colt = pn * 256; }
        else if (pn < 89) { base = q; ldc = 4096; colt = (pn - 73) * 256; }
        else if (pn < 93) { base = k; ldc = 1024; colt = (pn - 89) * 256; }
        else if (pn < 97) { base = v; ldc = 1024; colt = (pn - 93) * 256; }
        else { base = gates; ldc = 8192; colt = (pn - 97) * 256; mode = 2; }
        f32x4 bv[2][2];
#pragma unroll
        for (int bj = 0; bj < 2; ++bj)
#pragma unroll
            for (int n = 0; n < 2; ++n) bv[bj][n] = (mode == 2) ? *(const f32x4*)(b_gate + colt + cw_ + bj * HALF + 4 * n) : (f32x4){0.f, 0.f, 0.f, 0.f};
#pragma unroll
        for (int ai = 0; ai < 2; ++ai)
#pragma unroll
            for (int m = 0; m < 4; ++m) { bf16_t* rowp = base + (size_t)(row0 + ai * 4 + m) * ldc + colt + cw_;
#pragma unroll
                for (int bj = 0; bj < 2; ++bj) { f32x4 v0 = acc[ai][bj][m][0] + bv[bj][0], v1 = acc[ai][bj][m][1] + bv[bj][1];
                    st8bf(rowp + bj * HALF, v0, v1); } }
    }
};
struct EpiMix {
    static constexpr bool PERM = true, AFTER_DRAIN = false, APERM = false;
    const bf16_t* gates; bf16_t* pm; int second;
    __device__ __forceinline__ void operator()(const f32x4 (&acc)[2][2][4][2], const Unit& u, int wr, int wc, int fr, int fq) const {
        const int row0 = u.pm * BM + wr * 64 + fr, col0 = u.pn * BM + wc * 32 + 8 * fq;
#pragma unroll
        for (int ai = 0; ai < 2; ++ai)
#pragma unroll
            for (int m = 0; m < 4; ++m) { const size_t row = (size_t)(row0 + ai * HALF + m * 16);
#pragma unroll
                for (int bj = 0; bj < 2; ++bj) { const int col = col0 + bj * HALF; f32x4 g0, g1; ld8bf(gates + row * 8192 + second * 4096 + col, g0, g1);
#pragma unroll
                    for (int j = 0; j < 4; ++j) { g0[j] = epi_sigmoid(g0[j]); g1[j] = epi_sigmoid(g1[j]); }

                    f32x4 v0 = acc[ai][bj][m][0] * g0, v1 = acc[ai][bj][m][1] * g1;
                    if (second) { f32x4 p0, p1; ld8bf(pm + row * 4096 + col, p0, p1); v0 += p0; v1 += p1; }
                    st8bf(pm + row * 4096 + col, v0, v1); } }
    }
};
struct EpiRes {
    static constexpr bool PERM = true, AFTER_DRAIN = false, APERM = false;
    const float* base; float* out; const float* gate; float alpha;
    __device__ __forceinline__ void operator()(const f32x4 (&acc)[2][2][4][2], const Unit& u, int wr, int wc, int fr, int fq) const {
        const int row0 = u.pm * BM + wr * 64 + fr, col0 = u.pn * BM + wc * 32 + 8 * fq;
        const float* g = gate + (size_t)(u.pm >> 4) * 24576;
#pragma unroll
        for (int bj = 0; bj < 2; ++bj) { const int col = col0 + bj * HALF; const f32x4 g0 = *(const f32x4*)(g + col), g1 = *(const f32x4*)(g + col + 4);
#pragma unroll
            for (int ai = 0; ai < 2; ++ai)
#pragma unroll
                for (int m = 0; m < 4; ++m) { const size_t off = (size_t)(row0 + ai * HALF + m * 16) * 4096 + col;
                    const f32x4 x0 = *(const f32x4*)(base + off), x1 = *(const f32x4*)(base + off + 4);
                    *(f32x4*)(out + off) = x0 * alpha + g0 * acc[ai][bj][m][0]; *(f32x4*)(out + off + 4) = x1 * alpha + g1 * acc[ai][bj][m][1]; } }
    }
};
struct EpiConvGate {
    static constexpr bool PERM = true, AFTER_DRAIN = false, APERM = true;
    bf16_t* act; float* edge; const float* cw; const float* cb;
    __device__ __forceinline__ void operator()(const f32x4 (&acc)[2][2][4][2], const Unit& u, int wr, int wc, int fr, int fq) const {
        const int tok0 = u.pm * BM + wr * 128 + fr * 8, seg = 2 * u.pm + wr;
#pragma unroll
        for (int n = 0; n < 2; ++n) {
            const int ch = u.pn * 128 + wc * 32 + 8 * fq + 4 * n;
            const f32x4 wa0 = *(const f32x4*)(cw + ch), wa1 = *(const f32x4*)(cw + 22016 + ch), wa2 = *(const f32x4*)(cw + 2 * 22016 + ch), ba = *(const f32x4*)(cb + ch);
            const f32x4 wb0 = *(const f32x4*)(cw + 11008 + ch), wb1 = *(const f32x4*)(cw + 22016 + 11008 + ch), wb2 = *(const f32x4*)(cw + 2 * 22016 + 11008 + ch), bb = *(const f32x4*)(cb + 11008 + ch);
#pragma unroll
            for (int k = 0; k < 8; ++k) {
                const f32x4 ua_m = (k == 0) ? dpp_prev4(acc[1][0][3][n]) : acc[(k - 1) >> 2][0][(k - 1) & 3][n], ua_p = (k == 7) ? dpp_next4(acc[0][0][0][n]) : acc[(k + 1) >> 2][0][(k + 1) & 3][n];
                const f32x4 ub_m = (k == 0) ? dpp_prev4(acc[1][1][3][n]) : acc[(k - 1) >> 2][1][(k - 1) & 3][n], ub_p = (k == 7) ? dpp_next4(acc[0][1][0][n]) : acc[(k + 1) >> 2][1][(k + 1) & 3][n];
                const f32x4 ca = ua_m * wa0 + acc[k >> 2][0][k & 3][n] * wa1 + ua_p * wa2 + ba;
                const f32x4 cb_ = ub_m * wb0 + acc[k >> 2][1][k & 3][n] * wb1 + ub_p * wb2 + bb;
                f32x4 o;
#pragma unroll
                for (int j = 0; j < 4; ++j) o[j] = ca[j] * epi_sigmoid(ca[j]) * cb_[j];
                typedef unsigned u32x2_ __attribute__((ext_vector_type(2)));
                u32x2_ w; w.x = cvt_pk_bf16(o[0], o[1]); w.y = cvt_pk_bf16(o[2], o[3]);
                *(u32x2_*)(act + (size_t)(tok0 + k) * 11008 + ch) = w;
            }
            const int tc = u.pn * 256 + wc * 32 + 8 * fq + 4 * n;
            if (fr == 0) { float* ep = edge + ((size_t)seg * 4 + 0) * 22016 + tc;
                *(f32x4*)ep = acc[0][0][0][n]; *(f32x4*)(ep + 128) = acc[0][1][0][n]; *(f32x4*)(ep + 22016) = acc[0][0][1][n]; *(f32x4*)(ep + 22016 + 128) = acc[0][1][1][n]; }
            if (fr == 15) { float* ep = edge + ((size_t)seg * 4 + 2) * 22016 + tc;
                *(f32x4*)ep = acc[1][0][2][n]; *(f32x4*)(ep + 128) = acc[1][1][2][n]; *(f32x4*)(ep + 22016) = acc[1][0][3][n]; *(f32x4*)(ep + 22016 + 128) = acc[1][1][3][n]; }
            asm volatile("" ::: "memory");
        }
    }
};
struct EpiResLn {
    static constexpr bool PERM = true, AFTER_DRAIN = false, APERM = false;
    const float* r1; const float* stats; const float* ln_g; const float* ln_b; float* out; const float* gate; float alpha;
    __device__ __forceinline__ void operator()(const f32x4 (&acc)[2][2][4][2], const Unit& u, int wr, int wc, int fr, int fq) const {
        typedef float f2_ __attribute__((ext_vector_type(2)));
        const int row0 = u.pm * BM + wr * 64 + fr, col0 = u.pn * BM + wc * 32 + 8 * fq;
        const float* g = gate + (size_t)(u.pm >> 4) * 24576;
#pragma unroll
        for (int bj = 0; bj < 2; ++bj) { const int col = col0 + bj * HALF; const f32x4 g0 = *(const f32x4*)(g + col), g1 = *(const f32x4*)(g + col + 4);
            const f32x4 a0 = *(const f32x4*)(ln_g + col) * alpha, a1 = *(const f32x4*)(ln_g + col + 4) * alpha, b0 = *(const f32x4*)(ln_b + col) * alpha, b1 = *(const f32x4*)(ln_b + col + 4) * alpha;
#pragma unroll
            for (int ai = 0; ai < 2; ++ai)
#pragma unroll
                for (int m = 0; m < 4; ++m) { const size_t row = (size_t)(row0 + ai * HALF + m * 16), off = row * 4096 + col; const f2_ st = *(const f2_*)(stats + 2 * row); const float mean = st.x, rstd = st.y;
                    const f32x4 x0 = (*(const f32x4*)(r1 + off) - mean) * rstd, x1 = (*(const f32x4*)(r1 + off + 4) - mean) * rstd;
                    *(f32x4*)(out + off) = x0 * a0 + b0 + g0 * acc[ai][bj][m][0]; *(f32x4*)(out + off + 4) = x1 * a1 + b1 + g1 * acc[ai][bj][m][1]; } }
    }
};
template <class Epi, class Sched, bool ALIGN_EPI = false, bool SP2 = false>
__device__ __forceinline__ void gemm_phase(PG8_LAS unsigned char* lds, const Gemm g, const Sched& S, const Epi& E, int tid_in) {
    int tid_l = tid_in; asm volatile("" : "+v"(tid_l));
    const int tid = tid_l, wid = __builtin_amdgcn_readfirstlane(tid >> 6), lane = tid & 63, wr = wid >> 2, wc = wid & 3, fr = lane & 15, fq = lane >> 4;
    const int K = g.K, nt = K / BK;
    unsigned voffA[2], voffB[2];
#pragma unroll
    for (int i = 0; i < 2; ++i) { int R, C; stage_rc(tid * 16 + i * 8192, R, C); const int Rb = Epi::PERM ? ((R & ~31) + perm32(R & 31)) : R;
        const int Ra = Epi::APERM ? (128 * (R >> 6) + 8 * (R & 15) + ((R >> 4) & 3)) : R;
        voffA[i] = (unsigned)(Ra * K + C) * 2u; voffB[i] = (unsigned)(Rb * K + C) * 2u; }
    const size_t kstep = (size_t)(BK * 2);
    const size_t hstep = (size_t)HALF * K * 2;
    const size_t tstep = 2 * hstep;
    const size_t hstepA = Epi::APERM ? (size_t)4 * K * 2 : hstep;
    const unsigned ldsw = (unsigned)wid * 1024u;
    const int aoff = lds_byte(wr * 64 + fr, fq * 8), boff = lds_byte(wc * 32 + fr, fq * 8);
#define PG8_SA(b, h) (((b) * 2 + (h)) * HTB)
#define PG8_SB(b, h) ((4 + (b) * 2 + (h)) * HTB)
#define PG8_STAGE(bufoff, gbase, voff) do { _Pragma("unroll") for (int _i = 0; _i < 2; ++_i) \
        __builtin_amdgcn_global_load_lds((const unsigned*)((const char*)(gbase) + (voff)[_i]), (PG8_LAS unsigned*)(lds + (bufoff) + ldsw + _i * 8192), 16, 0, 0); } while (0)
#define PG8_LDA(dst, b, h) do { _Pragma("unroll") for (int m = 0; m < 4; ++m) _Pragma("unroll") for (int k = 0; k < 2; ++k) dst[m][k] = *(const PG8_LAS bf16x8*)(lds + PG8_SA(b, h) + aoff + m * 2048 + k * 1024); } while (0)
#define PG8_LDB(dst, b, h) do { _Pragma("unroll") for (int n = 0; n < 2; ++n) _Pragma("unroll") for (int k = 0; k < 2; ++k) dst[n][k] = *(const PG8_LAS bf16x8*)(lds + PG8_SB(b, h) + boff + n * 2048 + k * 1024); } while (0)
#define PG8_MMA(ai, bj, At, Bt) do { __builtin_amdgcn_s_setprio(1); _Pragma("unroll") for (int n = 0; n < 2; ++n) _Pragma("unroll") for (int m = 0; m < 4; ++m) { _Pragma("unroll") for (int k = 0; k < 2; ++k) \
        acc[ai][bj][m][n] = __builtin_amdgcn_mfma_f32_16x16x32_bf16(Bt[n][k], At[m][k], acc[ai][bj][m][n], 0, 0, 0); __builtin_amdgcn_sched_barrier(0); } __builtin_amdgcn_s_setprio(0); } while (0)
#define PG8_WAIT_V(n) asm volatile("s_waitcnt vmcnt(" #n ")" ::: "memory")
#define PG8_WAIT_L(n) asm volatile("s_waitcnt lgkmcnt(" #n ")" ::: "memory")
#define PG8_BAR __builtin_amdgcn_s_barrier()
#define PG8_SCHED __builtin_amdgcn_sched_barrier(0)
    Unit cur, nxt; int ui = 0;
    if (!S.next(0, cur)) return;
    f32x4 acc[2][2][4][2];
#pragma unroll
    for (int a = 0; a < 2; ++a)
#pragma unroll
        for (int b = 0; b < 2; ++b)
#pragma unroll
            for (int m = 0; m < 4; ++m)
#pragma unroll
                for (int n = 0; n < 2; ++n) acc[a][b][m][n] = (f32x4){0.f, 0.f, 0.f, 0.f};
    bf16x8 At[4][2], B0[2][2], B1[2][2];
    const char* cA = (const char*)g.A + (size_t)cur.pm * tstep; const char* cB = (const char*)g.Bt + (size_t)cur.pn * tstep;
    S.a_ready(cur);
    if constexpr (SP2) {
        PG8_STAGE(PG8_SB(0, 0), cB, voffB); PG8_STAGE(PG8_SB(0, 1), cB + hstep, voffB); PG8_STAGE(PG8_SA(0, 0), cA, voffA); PG8_STAGE(PG8_SA(0, 1), cA + hstepA, voffA);
        if (wr == 1) PG8_BAR;
        PG8_WAIT_V(2); PG8_BAR;
        PG8_STAGE(PG8_SB(1, 0), cB + kstep, voffB); PG8_STAGE(PG8_SA(1, 0), cA + kstep, voffA); PG8_STAGE(PG8_SB(1, 1), cB + hstep + kstep, voffB);
        PG8_WAIT_V(6); PG8_BAR;
    } else {
        PG8_STAGE(PG8_SB(0, 0), cB, voffB); PG8_STAGE(PG8_SA(0, 0), cA, voffA); PG8_STAGE(PG8_SB(0, 1), cB + hstep, voffB); PG8_STAGE(PG8_SA(0, 1), cA + hstepA, voffA);
        if (wr == 1) PG8_BAR;
        PG8_WAIT_V(4); PG8_BAR;
        PG8_STAGE(PG8_SB(1, 0), cB + kstep, voffB); PG8_STAGE(PG8_SA(1, 0), cA + kstep, voffA); PG8_STAGE(PG8_SB(1, 1), cB + hstep + kstep, voffB);
        PG8_WAIT_V(6); PG8_BAR;
    }
    for (;;) {
        const bool has_next = S.next(ui + 1, nxt);
        const char* nA = has_next ? (const char*)g.A + (size_t)nxt.pm * tstep : cA; const char* nB = has_next ? (const char*)g.Bt + (size_t)nxt.pn * tstep : cB;
        for (int t = 0; t < nt; t += 2) {
            const bool last = (t == nt - 2);
            const char* a1 = cA + (size_t)(t + 1) * kstep;
            const char* a2 = last ? nA : cA + (size_t)(t + 2) * kstep; const char* b2 = last ? nB : cB + (size_t)(t + 2) * kstep;
            const char* a3 = a2 + kstep; const char* b3 = b2 + kstep;
            if (last && has_next) S.a_ready(nxt);
            if constexpr (SP2) {
            PG8_LDB(B0, 0, 0); PG8_LDB(B1, 0, 1); PG8_SCHED; PG8_LDA(At, 0, 0); PG8_STAGE(PG8_SA(1, 1), a1 + hstepA, voffA);
            PG8_WAIT_V(8); PG8_WAIT_L(0); PG8_BAR; PG8_MMA(0, 0, At, B0); PG8_MMA(0, 1, At, B1); PG8_BAR; PG8_SCHED;
            PG8_LDA(At, 0, 1); PG8_STAGE(PG8_SB(0, 0), b2, voffB); PG8_STAGE(PG8_SB(0, 1), b2 + hstep, voffB); PG8_STAGE(PG8_SA(0, 0), a2, voffA);
            PG8_WAIT_V(8); PG8_WAIT_L(0); PG8_BAR; PG8_MMA(1, 0, At, B0); PG8_MMA(1, 1, At, B1); PG8_BAR; PG8_SCHED;
            PG8_LDB(B0, 1, 0); PG8_LDB(B1, 1, 1); PG8_SCHED; PG8_LDA(At, 1, 0); PG8_STAGE(PG8_SA(0, 1), a2 + hstepA, voffA);
            PG8_WAIT_V(8); PG8_WAIT_L(0); PG8_BAR; PG8_MMA(0, 0, At, B0); PG8_MMA(0, 1, At, B1); PG8_BAR; PG8_SCHED;
            PG8_LDA(At, 1, 1); PG8_STAGE(PG8_SB(1, 0), b3, voffB); PG8_STAGE(PG8_SB(1, 1), b3 + hstep, voffB); PG8_STAGE(PG8_SA(1, 0), a3, voffA);
            PG8_WAIT_V(8); PG8_WAIT_L(0); PG8_BAR; PG8_MMA(1, 0, At, B0); PG8_MMA(1, 1, At, B1); PG8_BAR; PG8_SCHED;
            } else {
            PG8_LDB(B0, 0, 0); PG8_SCHED; PG8_LDA(At, 0, 0); PG8_STAGE(PG8_SA(1, 1), a1 + hstepA, voffA);
            PG8_WAIT_L(8); PG8_BAR; PG8_WAIT_L(0); PG8_MMA(0, 0, At, B0); PG8_BAR; PG8_SCHED;
            PG8_LDB(B1, 0, 1); PG8_STAGE(PG8_SB(0, 0), b2, voffB);
            PG8_BAR; PG8_WAIT_L(0); PG8_MMA(0, 1, At, B1); PG8_BAR;
            PG8_LDA(At, 0, 1); PG8_STAGE(PG8_SA(0, 0), a2, voffA);
            PG8_BAR; PG8_WAIT_L(0); PG8_MMA(1, 0, At, B0); PG8_BAR; PG8_SCHED;
            PG8_STAGE(PG8_SB(0, 1), b2 + hstep, voffB);
            PG8_WAIT_V(6); PG8_BAR; PG8_MMA(1, 1, At, B1); PG8_BAR;
            PG8_LDB(B0, 1, 0); PG8_SCHED; PG8_LDA(At, 1, 0); PG8_STAGE(PG8_SA(0, 1), a2 + hstepA, voffA);
            PG8_WAIT_L(8); PG8_BAR; PG8_WAIT_L(0); PG8_MMA(0, 0, At, B0); PG8_BAR; PG8_SCHED;
            PG8_LDB(B1, 1, 1); PG8_STAGE(PG8_SB(1, 0), b3, voffB);
            PG8_BAR; PG8_WAIT_L(0); PG8_MMA(0, 1, At, B1); PG8_BAR;
            PG8_LDA(At, 1, 1); PG8_STAGE(PG8_SA(1, 0), a3, voffA);
            PG8_BAR; PG8_WAIT_L(0); PG8_MMA(1, 0, At, B0); PG8_BAR; PG8_SCHED;
            PG8_STAGE(PG8_SB(1, 1), b3 + hstep, voffB);
            PG8_WAIT_V(6); PG8_BAR; PG8_MMA(1, 1, At, B1); PG8_BAR;
            }
        }
        if constexpr (ALIGN_EPI) { if (wr == 0) PG8_BAR; }
        if constexpr (!Epi::AFTER_DRAIN) { E(acc, cur, wr, wc, fr, fq); S.done(cur); }
        if (!has_next) break;
#pragma unroll
        for (int a = 0; a < 2; ++a)
#pragma unroll
            for (int b = 0; b < 2; ++b)
#pragma unroll
                for (int m = 0; m < 4; ++m)
#pragma unroll
                    for (int n = 0; n < 2; ++n) acc[a][b][m][n] = (f32x4){0.f, 0.f, 0.f, 0.f};
        cur = nxt; cA = nA; cB = nB; ++ui;
        if constexpr (ALIGN_EPI) { if (wr == 1) PG8_BAR; }
    }
    PG8_WAIT_V(0);
    if constexpr (!ALIGN_EPI) { if (wr == 0) PG8_BAR; }
    PG8_BAR;
    if constexpr (Epi::AFTER_DRAIN) { E.fused(acc, cur, wr, wc, fr, fq, lds, wid, lane); S.done(cur); }
#undef PG8_SA
#undef PG8_SB
#undef PG8_STAGE
#undef PG8_LDA
#undef PG8_LDB
#undef PG8_MMA
#undef PG8_WAIT_V
#undef PG8_WAIT_L
#undef PG8_BAR
#undef PG8_SCHED
}
}
namespace attn {
constexpr int D = 128, NW = 8, QBLK = 32, KVBLK = 64;
constexpr float SCALE = 0.088388347648318440f;
constexpr float THR = 8.f;
constexpr int SDEPTH = 2;
constexpr int LDQ = AT_HQ * D, LDK = AT_HKV * D, LDO = LDQ;
constexpr size_t SHM_V = KVBLK * D * 2, SHM_K = KVBLK * D * 2, SHM_ATTN = 2 * SHM_V + 2 * SHM_K + NW * 64 * 4;
using bf16x8 = __attribute__((ext_vector_type(8))) short;
using s16x4  = __attribute__((ext_vector_type(4))) short;
using f32x16 = __attribute__((ext_vector_type(16))) float;
using u32x4  = __attribute__((ext_vector_type(4))) unsigned;
#define KSWZ(row, colB) ((row) * 256 + ((colB) ^ (((row) & 7) << 4)))
#define SBAR() __builtin_amdgcn_sched_barrier(0)
__device__ __forceinline__ int crow(int r, int hi) { return (r & 3) + 8 * (r >> 2) + 4 * hi; }
__device__ __forceinline__ unsigned cvtpk(float lo, float hi) { unsigned r; asm volatile("v_cvt_pk_bf16_f32 %0, %1, %2" : "=v"(r) : "v"(lo), "v"(hi)); return r; }
__device__ __forceinline__ bf16x8 ld8(const bf16* p) { return *reinterpret_cast<const bf16x8*>(p); }

__device__ __forceinline__ void partialSM(f32x16& p0, f32x16& p1, float& m_reg, float& mn, float& alpha) {
  constexpr float C = SCALE * 1.4426950408889634f;
  float pmax = p0[0];
#pragma unroll
  for (int r = 1; r < 16; ++r) pmax = fmaxf(pmax, p0[r]);
#pragma unroll
  for (int r = 0; r < 16; ++r) pmax = fmaxf(pmax, p1[r]);
  { auto rr = __builtin_amdgcn_permlane32_swap(__float_as_uint(pmax), __float_as_uint(pmax), false, false);
    pmax = fmaxf(__uint_as_float(rr[0]), __uint_as_float(rr[1])); }
  if (__builtin_expect(__all(pmax - m_reg <= THR / SCALE), 1)) { mn = m_reg; alpha = 1.f; }
  else { mn = fmaxf(m_reg, pmax); alpha = __builtin_amdgcn_exp2f((m_reg - mn) * C); m_reg = mn; }
  float mnC = -mn * C;
#pragma unroll
  for (int r = 0; r < 16; ++r) p0[r] = fmaf(p0[r], C, mnC);
#pragma unroll
  for (int r = 0; r < 16; ++r) p1[r] = fmaf(p1[r], C, mnC);
#pragma unroll
  for (int r = 0; r < 16; ++r) p0[r] = __builtin_amdgcn_exp2f(p0[r]);
}
__device__ __forceinline__ void finishSM(f32x16& p0, f32x16& p1, float alpha, float& l_reg, bf16x8& pa0, bf16x8& pa1, bf16x8& pa2, bf16x8& pa3) {
#pragma unroll
  for (int r = 0; r < 16; ++r) p1[r] = __builtin_amdgcn_exp2f(p1[r]);
  float ps = 0;
#pragma unroll
  for (int r = 0; r < 16; ++r) ps += p0[r];
#pragma unroll
  for (int r = 0; r < 16; ++r) ps += p1[r];
  { auto rr = __builtin_amdgcn_permlane32_swap(__float_as_uint(ps), __float_as_uint(ps), false, false);
    ps = __uint_as_float(rr[0]) + __uint_as_float(rr[1]); }
  l_reg = l_reg * alpha + ps;
#define PK4(P, BASE, OUT) do { unsigned a0 = cvtpk(P[BASE + 0], P[BASE + 1]), a1 = cvtpk(P[BASE + 2], P[BASE + 3]);   \
    unsigned b0 = cvtpk(P[BASE + 4], P[BASE + 5]), b1 = cvtpk(P[BASE + 6], P[BASE + 7]);                              \
    auto r0 = __builtin_amdgcn_permlane32_swap(a0, b0, false, false); auto r1 = __builtin_amdgcn_permlane32_swap(a1, b1, false, false); \
    u32x4 w = {r0[0], r1[0], r0[1], r1[1]}; OUT = *reinterpret_cast<bf16x8*>(&w); } while (0)
  PK4(p0, 0, pa0); PK4(p0, 8, pa1); PK4(p1, 0, pa2); PK4(p1, 8, pa3);
#undef PK4
}
__device__ __forceinline__ void qkt(f32x16& p0, f32x16& p1, const bf16* Ks, const bf16x8* qr, int r32, int hi) {
  p0 = f32x16{}; p1 = f32x16{};
#pragma unroll
  for (int d0 = 0; d0 < 8; ++d0) { int cb = (d0 * 16 + hi * 8) * 2;
    bf16x8 b0 = *reinterpret_cast<const bf16x8*>((const char*)Ks + KSWZ(r32, cb));
    bf16x8 b1 = *reinterpret_cast<const bf16x8*>((const char*)Ks + KSWZ(32 + r32, cb));
    p0 = __builtin_amdgcn_mfma_f32_32x32x16_bf16(b0, qr[d0], p0, 0, 0, 0);
    p1 = __builtin_amdgcn_mfma_f32_32x32x16_bf16(b1, qr[d0], p1, 0, 0, 0); }
}
__device__ __forceinline__ int v_st(int k, int c) { const int kk = (k & ~0xC) | ((k & 4) << 1) | ((k & 8) >> 1); return ((kk >> 3) * 4 + (c >> 5)) * 512 + ((kk & 7) * 32 + (c & 31)) * 2; }
__device__ __forceinline__ int v_rd_base(int lane) { return ((lane & 3) << 3) | (((lane >> 2) & 3) << 6) | (((lane >> 4) & 1) << 5) | (((lane >> 5) & 1) << 8); }
constexpr int v_rd_off(int d0, int ks, int half) { return d0 * 512 + ks * 4096 + half * 2048; }
template <int OFF> __device__ __forceinline__ s16x4 tr_read(int vb) {
  s16x4 r; asm volatile("ds_read_b64_tr_b16 %0, %1 offset:%2" : "=&v"(r) : "v"(vb), "i"(OFF) : "memory"); return r;
}
#define PV_READ(D0, F) do { F[0] = tr_read<v_rd_off(D0, 0, 0)>(vb); F[1] = tr_read<v_rd_off(D0, 0, 1)>(vb); F[2] = tr_read<v_rd_off(D0, 1, 0)>(vb); F[3] = tr_read<v_rd_off(D0, 1, 1)>(vb); \
                            F[4] = tr_read<v_rd_off(D0, 2, 0)>(vb); F[5] = tr_read<v_rd_off(D0, 2, 1)>(vb); F[6] = tr_read<v_rd_off(D0, 3, 0)>(vb); F[7] = tr_read<v_rd_off(D0, 3, 1)>(vb); } while (0)
#define PV_PK(L, H) (bf16x8){L[0], L[1], L[2], L[3], H[0], H[1], H[2], H[3]}
#define PV_MMA(od, F) do { od = __builtin_amdgcn_mfma_f32_32x32x16_bf16(pa0, PV_PK(F[0], F[1]), od, 0, 0, 0); od = __builtin_amdgcn_mfma_f32_32x32x16_bf16(pa1, PV_PK(F[2], F[3]), od, 0, 0, 0); \
                            od = __builtin_amdgcn_mfma_f32_32x32x16_bf16(pa2, PV_PK(F[4], F[5]), od, 0, 0, 0); od = __builtin_amdgcn_mfma_f32_32x32x16_bf16(pa3, PV_PK(F[6], F[7]), od, 0, 0, 0); } while (0)
__device__ __forceinline__ void pv_d0(f32x16* o, int vb, bf16x8 pa0, bf16x8 pa1, bf16x8 pa2, bf16x8 pa3) {
  s16x4 fa[8], fb[8];
  PV_READ(0, fa);
  PV_READ(1, fb); asm volatile("s_waitcnt lgkmcnt(8)" ::: "memory"); SBAR(); PV_MMA(o[0], fa);
  PV_READ(2, fa); asm volatile("s_waitcnt lgkmcnt(8)" ::: "memory"); SBAR(); PV_MMA(o[1], fb);
  PV_READ(3, fb); asm volatile("s_waitcnt lgkmcnt(8)" ::: "memory"); SBAR(); PV_MMA(o[2], fa);
  asm volatile("s_waitcnt lgkmcnt(0)" ::: "memory"); SBAR(); PV_MMA(o[3], fb);
}
#undef PV_READ
#undef PV_PK
#undef PV_MMA

struct AttnPre { bf16x8 qr[8]; bf16x8 vs0[2], vs1[2], ks0[2], ks1[2]; };
__device__ __forceinline__ void attn_prime(AttnPre& P, const bf16* Qb, const bf16* __restrict__ Kh, const bf16* __restrict__ Vh, int tid_in) {
  const int tid = tid_in, wid = __builtin_amdgcn_readfirstlane(tid >> 6), lane = tid & 63, r32 = lane & 31, hi = lane >> 5;
  const int sr = tid >> 4, sc = (tid & 15) * 8;
#pragma unroll
  for (int i = 0; i < 2; ++i) { P.vs0[i] = ld8(&Vh[(long)(i * KVBLK + sr) * LDK + sc]); P.vs1[i] = ld8(&Vh[(long)(i * KVBLK + 32 + sr) * LDK + sc]);
    P.ks0[i] = ld8(&Kh[(long)(i * KVBLK + sr) * LDK + sc]); P.ks1[i] = ld8(&Kh[(long)(i * KVBLK + 32 + sr) * LDK + sc]); }
  const bf16* Qw = Qb + (long)(wid * QBLK + r32) * LDQ + hi * 8;
#pragma unroll
  for (int d0 = 0; d0 < 8; ++d0) P.qr[d0] = ld8(Qw + d0 * 16);
}
__device__ __forceinline__ void attn_dense_body(AttnPre& P, const bf16* __restrict__ Kh, const bf16* __restrict__ Vh, bf16* Ob, int seq, char* lds, const float* qnw, const float* rtab, int t0, int tid_in,
                                                const bf16* Qn, const bf16* __restrict__ Kn, const bf16* __restrict__ Vn, bool has_next) {
  const int tid = tid_in, wid = __builtin_amdgcn_readfirstlane(tid >> 6), lane = tid & 63, r32 = lane & 31, hi = lane >> 5;
  bf16* V_lds = (bf16*)lds; bf16* K_lds = (bf16*)(lds + 2 * SHM_V);
  float* ws = (float*)(lds + 2 * SHM_V + 2 * SHM_K) + wid * 64; float* li_l = ws; float* al_l = ws + 32;
  float m_reg = -1e30f, l_reg = 0; f32x16 o[4] = {}; bf16x8 (&qr)[8] = P.qr;
  {
    float ss = 0.f;
#pragma unroll
    for (int d0 = 0; d0 < 8; ++d0) { const u32x4 w = __builtin_bit_cast(u32x4, qr[d0]);
#pragma unroll
      for (int c = 0; c < 4; ++c) { const float lo = __uint_as_float(w[c] << 16), hi_ = __uint_as_float(w[c] & 0xffff0000u); ss += lo * lo + hi_ * hi_; } }
    ss += __shfl_xor(ss, 32);
    const float rn = 1.0f / sqrtf(ss * (1.f / 128.f) + RMS_EPS);
    const int tq = t0 + wid * QBLK + r32;
    v4f tv[2][2][4], wv[2][2][4];
#pragma unroll
    for (int hf = 0; hf < 2; ++hf) {
      const int pos = hf ? (tq & (GRID_W - 1)) : (tq / GRID_W);
#pragma unroll
      for (int dl = 0; dl < 2; ++dl) {
        const int d1 = 4 * hf + dl, d2 = d1 + 2;
        const float* tp = rtab + (size_t)(pos * 32 + 16 * dl + 8 * hi) * 2;
#pragma unroll
        for (int q4 = 0; q4 < 4; ++q4) tv[hf][dl][q4] = *(const v4f*)(tp + 4 * q4);
        wv[hf][dl][0] = *(const v4f*)(qnw + d1 * 16 + hi * 8); wv[hf][dl][1] = *(const v4f*)(qnw + d1 * 16 + hi * 8 + 4);
        wv[hf][dl][2] = *(const v4f*)(qnw + d2 * 16 + hi * 8); wv[hf][dl][3] = *(const v4f*)(qnw + d2 * 16 + hi * 8 + 4);
      } }
#pragma unroll
    for (int hf = 0; hf < 2; ++hf)
#pragma unroll
      for (int dl = 0; dl < 2; ++dl) {
        const int d1 = 4 * hf + dl, d2 = d1 + 2;
        const u32x4 w1 = __builtin_bit_cast(u32x4, qr[d1]), w2 = __builtin_bit_cast(u32x4, qr[d2]);
        u32x4 o1, o2;
#pragma unroll
        for (int c = 0; c < 4; ++c) {
          const v4f t = tv[hf][dl][c]; const v4f n1 = wv[hf][dl][c >> 1], n2 = wv[hf][dl][2 + (c >> 1)];
          const float a0 = __uint_as_float(w1[c] << 16) * rn * n1[2 * (c & 1)], a1 = __uint_as_float(w1[c] & 0xffff0000u) * rn * n1[2 * (c & 1) + 1];
          const float b0 = __uint_as_float(w2[c] << 16) * rn * n2[2 * (c & 1)], b1 = __uint_as_float(w2[c] & 0xffff0000u) * rn * n2[2 * (c & 1) + 1];
          o1[c] = cvtpk(a0 * t.x - b0 * t.y, a1 * t.z - b1 * t.w);
          o2[c] = cvtpk(b0 * t.x + a0 * t.y, b1 * t.z + a1 * t.w); }
        qr[d1] = __builtin_bit_cast(bf16x8, o1); qr[d2] = __builtin_bit_cast(bf16x8, o2);
      } }
  const int sr = tid >> 4, sc = (tid & 15) * 8, vst0 = v_st(sr, sc), vst1 = v_st(32 + sr, sc);
  const int vb0 = (int)(uintptr_t)V_lds + v_rd_base(lane);
#define SLOADP(i, Kp, Vp, k0) do { P.vs0[i] = ld8(&(Vp)[(long)((k0) + sr) * LDK + sc]); P.vs1[i] = ld8(&(Vp)[(long)((k0) + 32 + sr) * LDK + sc]); \
    P.ks0[i] = ld8(&(Kp)[(long)((k0) + sr) * LDK + sc]); P.ks1[i] = ld8(&(Kp)[(long)((k0) + 32 + sr) * LDK + sc]); } while (0)
#define SLOAD(i, k0) SLOADP(i, Kh, Vh, k0)
#define SWRITE(b, i) do { *(bf16x8*)((char*)V_lds + (b) * SHM_V + vst0) = P.vs0[i];          \
    *(bf16x8*)((char*)V_lds + (b) * SHM_V + vst1) = P.vs1[i]; int kc = sc * 2;               \
    *(bf16x8*)((char*)K_lds + (b) * SHM_K + KSWZ(sr, kc)) = P.ks0[i];                       \
    *(bf16x8*)((char*)K_lds + (b) * SHM_K + KSWZ(32 + sr, kc)) = P.ks1[i]; } while (0)
#define SWAIT() do { asm volatile("s_waitcnt vmcnt(4)" ::: "memory"); } while (0)
#define RESC(a) do { if (__any((a) < 1.f)) { if (hi == 0) al_l[r32] = (a); asm volatile("s_waitcnt lgkmcnt(0)" ::: "memory"); \
    _Pragma("unroll") for (int d = 0; d < 4; ++d) _Pragma("unroll") for (int r = 0; r < 16; ++r) o[d][r] *= al_l[crow(r, hi)]; } } while (0)
  f32x16 pA0, pA1, pB0, pB1; float mnA, mnB, alA, alB; bf16x8 pa0, pa1, pa2, pa3; const int NT = seq / KVBLK;
  constexpr int SE = 0, SO = SDEPTH - 1;
  __syncthreads();
  SWRITE(0, SE); __syncthreads();
  qkt(pA0, pA1, K_lds, qr, r32, hi); partialSM(pA0, pA1, m_reg, mnA, alA);
  if (2 < NT) SLOAD(SE, 2 * KVBLK);
  SWAIT(); SWRITE(1, SO); __syncthreads();
  for (int j = 1; j + 1 < NT; j += 2) {
    SBAR(); qkt(pB0, pB1, (bf16*)((char*)K_lds + SHM_K), qr, r32, hi);
    finishSM(pA0, pA1, alA, l_reg, pa0, pa1, pa2, pa3); SBAR();
    SLOAD(SO, (j + SDEPTH) * KVBLK); SBAR();
    pv_d0(o, vb0, pa0, pa1, pa2, pa3); partialSM(pB0, pB1, m_reg, mnB, alB);
    __syncthreads(); SWAIT(); SWRITE(0, SE);
    RESC(alB); __syncthreads();
    SBAR(); qkt(pA0, pA1, K_lds, qr, r32, hi);
    finishSM(pB0, pB1, alB, l_reg, pa0, pa1, pa2, pa3); SBAR();
    if (j + 3 < NT) SLOAD(SE, (j + 1 + SDEPTH) * KVBLK); SBAR();
    pv_d0(o, vb0 + (int)SHM_V, pa0, pa1, pa2, pa3); partialSM(pA0, pA1, m_reg, mnA, alA);
    __syncthreads(); SWAIT(); SWRITE(1, SO);
    RESC(alA); __syncthreads();
  }
  if (has_next) {
    const int t2 = (wid << 6) | lane_id_now(), sr2 = t2 >> 4, sc2 = (t2 & 15) * 8; const unsigned o2 = (unsigned)(sr2 * LDK + sc2) * 2u;
#pragma unroll
    for (int i = 0; i < 2; ++i) { const char* vp = (const char*)Vn + (size_t)(i * KVBLK * LDK * 2); const char* kp = (const char*)Kn + (size_t)(i * KVBLK * LDK * 2);
      P.vs0[i] = *(const bf16x8*)(vp + o2); P.vs1[i] = *(const bf16x8*)(vp + o2 + 32 * LDK * 2); P.ks0[i] = *(const bf16x8*)(kp + o2); P.ks1[i] = *(const bf16x8*)(kp + o2 + 32 * LDK * 2); } }
  SBAR(); qkt(pB0, pB1, (bf16*)((char*)K_lds + SHM_K), qr, r32, hi);
  finishSM(pA0, pA1, alA, l_reg, pa0, pa1, pa2, pa3); SBAR();
  if (has_next) { const int l2 = lane_id_now(); const unsigned qo2 = (unsigned)((wid * QBLK + (l2 & 31)) * LDQ + (l2 >> 5) * 8) * 2u;
#pragma unroll
    for (int d0 = 0; d0 < 8; ++d0) qr[d0] = *(const bf16x8*)((const char*)Qn + qo2 + d0 * 32); }
  SBAR();
  pv_d0(o, vb0, pa0, pa1, pa2, pa3); partialSM(pB0, pB1, m_reg, mnB, alB);
  __syncthreads(); RESC(alB);
  finishSM(pB0, pB1, alB, l_reg, pa0, pa1, pa2, pa3); SBAR();
  pv_d0(o, vb0 + (int)SHM_V, pa0, pa1, pa2, pa3);
  if (hi == 0) li_l[r32] = l_reg; asm volatile("s_waitcnt lgkmcnt(0)" ::: "memory");
  float rli[16];
#pragma unroll
  for (int r = 0; r < 16; ++r) rli[r] = __builtin_amdgcn_rcpf(li_l[crow(r, hi)]);
  bf16* Ow = Ob + (long)(wid * QBLK) * LDO;
#pragma unroll
  for (int r = 0; r < 16; ++r) { int orow = crow(r, hi);
#pragma unroll
    for (int d0 = 0; d0 < 4; ++d0) Ow[(long)orow * LDO + d0 * 32 + r32] = (bf16)(cvtpk(o[d0][r] * rli[r], 0.f) & 0xffffu); }
#undef SLOAD
#undef SLOADP
#undef SWRITE
#undef SWAIT
#undef RESC
}
#undef KSWZ
#undef SBAR
}
constexpr int NWAVES = 8;
constexpr size_t MiB = 1u << 20;
constexpr size_t WS_CTL = 0, CTL_ZERO_BYTES = 1 * MiB;
constexpr size_t WS_MOD = 512 * 1024;
constexpr size_t WS_WCAT = 1 * MiB;
constexpr size_t WS_H = 259 * MiB;
constexpr size_t WS_WSSM = 387 * MiB;
constexpr size_t WS_WATT = 451 * MiB;
constexpr size_t WS_WOUT = 483 * MiB;
constexpr size_t WS_WUP = 515 * MiB;
constexpr size_t WS_WDN = 687 * MiB;
constexpr size_t WS_Z = 773 * MiB;
constexpr size_t WS_XBCC = 1029 * MiB;
constexpr size_t WS_DT = 1349 * MiB;
constexpr size_t WS_Q = 1365 * MiB;
constexpr size_t WS_K = 1493 * MiB;
constexpr size_t WS_V = 1525 * MiB;
constexpr size_t WS_GATES = 1557 * MiB;
constexpr size_t WS_PART = WS_Z;
constexpr size_t WS_EDGE1 = 687 * MiB;
constexpr size_t WS_YB = 1 * MiB;
constexpr size_t WS_PM = WS_XBCC;
constexpr size_t WS_R1 = 1 * MiB;
constexpr size_t WS_ST1 = WS_Z;
constexpr size_t WS_H2 = WS_XBCC;
constexpr size_t WS_EDGE = 1157 * MiB;
constexpr size_t WS_ACT = 1202 * MiB;
constexpr size_t WS_END = 1557 * MiB + 256 * MiB;

constexpr int LDS_BYTES = 147456;
constexpr int LDS_ZERO_OFF = 143360, MISC_OFF = LDS_ZERO_OFF + 320;

typedef GAS unsigned gu32;
#define RLX_AGENT __ATOMIC_RELAXED, __HIP_MEMORY_SCOPE_AGENT
#define LDS_WAIT() asm volatile("s_waitcnt lgkmcnt(0)" ::: "memory")
#define VM_WAIT() asm volatile("s_waitcnt vmcnt(0)" ::: "memory")
namespace ssd {
using bf16x8 = __attribute__((ext_vector_type(8))) short;
using s16x4  = __attribute__((ext_vector_type(4))) short;
using f32x16 = __attribute__((ext_vector_type(16))) float;
typedef float f2 __attribute__((ext_vector_type(2)));
constexpr int B_OFF = 0, C_OFF = 32768, XX_OFF = 65536, H_OFF = 98304, TBL_OFF = 114688, TBL_BYTES = 2048, MX_OFF = TBL_OFF + 2 * TBL_BYTES, SSD_LDS = MX_OFF + 10 * 2048;
constexpr int T_CUM = 0, T_DT = 512, T_WT = 1024, T_ETOT = 1536;
__device__ __forceinline__ int off_b(int row, int ch) { return 256 * row + 16 * (ch ^ (((row & 3) << 2) | ((row >> 2) & 3))); }
template <int OFF> __device__ __forceinline__ s16x4 tr_read(int addr) {
    s16x4 r; asm volatile("ds_read_b64_tr_b16 %0, %1 offset:%2" : "=&v"(r) : "v"(addr), "i"(OFF) : "memory"); return r;
}
#define SSD_PK(L, H) (bf16x8){L[0], L[1], L[2], L[3], H[0], H[1], H[2], H[3]}
#define SSD_LGKM0() do { asm volatile("s_waitcnt lgkmcnt(0)" ::: "memory"); __builtin_amdgcn_sched_barrier(0); } while (0)
#define SSD_MFMA(a, b, c) __builtin_amdgcn_mfma_f32_32x32x16_bf16(a, b, c, 0, 0, 0)

template <int SB, int LB>
__device__ __forceinline__ void decay_tile(const f32x16& g, bf16x8& m0, bf16x8& m1, LAS const char* tbl, int l31, int h, float cl) {
    const LAS float* cs2 = (const LAS float*)(tbl + T_DT); const float cl2 = cl * 1.4426950408889634f;
    float m[16];
#pragma unroll
    for (int q = 0; q < 4; ++q) { const v4f c4 = *(const LAS v4f*)(cs2 + 32 * SB + 8 * q + 4 * h);
#pragma unroll
        for (int e = 0; e < 4; ++e) { const float v = g[4 * q + e] * __builtin_amdgcn_exp2f(cl2 - c4[e]);
            m[4 * q + e] = (SB != LB || (8 * q + 4 * h + e) <= l31) ? v : 0.f; } }
    { v4u w; w.x = pkbf(m[0], m[1]); w.y = pkbf(m[2], m[3]); w.z = pkbf(m[4], m[5]); w.w = pkbf(m[6], m[7]); m0 = __builtin_bit_cast(bf16x8, w); }
    { v4u w; w.x = pkbf(m[8], m[9]); w.y = pkbf(m[10], m[11]); w.z = pkbf(m[12], m[13]); w.w = pkbf(m[14], m[15]); m1 = __builtin_bit_cast(bf16x8, w); }
}
#define SSD_RRO(s) (rr0 ^ (32 * (s)))
#define SSD_BROW(SB, s) (*(const LAS bf16x8*)(L + B_OFF + 8192 * (SB) + SSD_RRO(s)))

#define SSD_XF(SB, xf) do { xf[0] = tr_read<256 * (32 * (SB) + 0)>(xtr0); xf[1] = tr_read<256 * (32 * (SB) + 8)>(xtr1); xf[2] = tr_read<256 * (32 * (SB) + 16)>(xtr0); xf[3] = tr_read<256 * (32 * (SB) + 24)>(xtr1); } while (0)
#define SSD_MXA(LB_, SB_, KS_) (MX_OFF + ((((LB_) * ((LB_) + 1) / 2 + (SB_)) * 2 + (KS_)) << 10))
template <int LB, int PB>
__device__ __forceinline__ void chunk_y1(f32x16& yi, LAS char* L, LAS const char* tbl, int rr0, int pb, int lane, int l31, int h) {
    constexpr bool HAS_A = (PB <= LB), HAS_B = (PB + 2 <= LB);
    bf16x8 Cfr[8];
#pragma unroll
    for (int s = 0; s < 8; ++s) { LAS const char* as_ = L + SSD_RRO(s); Cfr[s] = *(const LAS bf16x8*)(as_ + (C_OFF + 8192 * LB)); }
    const float cl = *(const LAS float*)(tbl + T_CUM + 4 * (32 * LB + l31));
    f32x16 ga = {}, gb = {}; yi = (f32x16){};
#pragma unroll
    for (int s = 0; s < 8; ++s) {
        LAS const char* as_ = L + SSD_RRO(s);
        const bf16x8 hfr = *(const LAS bf16x8*)(as_ + (H_OFF + 8192 * PB)); yi = SSD_MFMA(hfr, Cfr[s], yi);
        if constexpr (HAS_A) { const bf16x8 ba = *(const LAS bf16x8*)(as_ + (B_OFF + 8192 * PB)); ga = SSD_MFMA(ba, Cfr[s], ga); }
        if constexpr (HAS_B) { const bf16x8 bb = *(const LAS bf16x8*)(as_ + (B_OFF + 8192 * (PB + 2))); gb = SSD_MFMA(bb, Cfr[s], gb); }
    }
    { const float el = __expf(cl);
#pragma unroll
      for (int r = 0; r < 16; ++r) yi[r] *= el; }
    if constexpr (HAS_A) { bf16x8 m0, m1; decay_tile<PB, LB>(ga, m0, m1, tbl, l31, h, cl);
        *(LAS bf16x8*)(L + SSD_MXA(LB, PB, 0) + 16 * lane) = m0; *(LAS bf16x8*)(L + SSD_MXA(LB, PB, 1) + 16 * lane) = m1; }
    if constexpr (HAS_B) { bf16x8 m0, m1; decay_tile<PB + 2, LB>(gb, m0, m1, tbl, l31, h, cl);
        *(LAS bf16x8*)(L + SSD_MXA(LB, PB + 2, 0) + 16 * lane) = m0; *(LAS bf16x8*)(L + SSD_MXA(LB, PB + 2, 1) + 16 * lane) = m1; }
}
template <int LB>
__device__ __forceinline__ void chunk_y2(f32x16& acc_y, LAS const char* L, int xtr0, int xtr1, int lane) {
    s16x4 xf[LB + 1][4]; bf16x8 mf[LB + 1][2];
    SSD_XF(0, xf[0]);
    if constexpr (LB >= 1) SSD_XF(1, xf[1]);
    if constexpr (LB >= 2) SSD_XF(2, xf[2]);
    if constexpr (LB >= 3) SSD_XF(3, xf[3]);
#pragma unroll
    for (int sb = 0; sb <= LB; ++sb) { mf[sb][0] = *(const LAS bf16x8*)(L + SSD_MXA(LB, sb, 0) + 16 * lane); mf[sb][1] = *(const LAS bf16x8*)(L + SSD_MXA(LB, sb, 1) + 16 * lane); }
    SSD_LGKM0();
#pragma unroll
    for (int sb = 0; sb <= LB; ++sb) { acc_y = SSD_MFMA(SSD_PK(xf[sb][0], xf[sb][1]), mf[sb][0], acc_y); acc_y = SSD_MFMA(SSD_PK(xf[sb][2], xf[sb][3]), mf[sb][1], acc_y); }
}
#undef SSD_XF

__device__ __forceinline__ void ssd_unit(LAS char* L, int unit, const bf16* xbc, const float* dtb, const float* a_log, const float* dskip, bf16* yout, int tid_in) {
    const int dir = unit & 1, head = (unit >> 1) & 127, b = unit >> 8, grp = head >> 4;
    asm volatile("" : "+s"(xbc), "+s"(dtb), "+s"(yout));
    int tid_l = tid_in; asm volatile("" : "+v"(tid_l));
    const int tid = tid_l, lane = tid & 63, w = __builtin_amdgcn_readfirstlane(tid >> 6), h = lane >> 5, l31 = lane & 31;
    const int pb = (w < 4) ? 0 : 1, lb = (w < 4) ? w : 7 - w, nb = w & 3, pb2 = w >> 2;
    constexpr int SCANW = 7;
    const float A = -__expf(a_log[dir * SSM_H + head]); const float dsk_eff = (dir == 0) ? dskip[head] : 0.f;
    const int rr0 = 256 * l31 + 16 * (h ^ (((l31 & 3) << 2) | ((l31 >> 2) & 3)));
    const int tq = (lane & 15) >> 2, tp = lane & 3, tblk = (lane >> 4) & 1;
    const int Lb = (int)(uintptr_t)L;
    const int xtr0 = Lb + XX_OFF + 256 * (4 * h + tq) + 16 * ((4 * pb + 2 * tblk + (tp >> 1)) ^ ((tq << 2) | ((0 + h) & 3))) + 8 * (tp & 1);
    const int xtr1 = Lb + XX_OFF + 256 * (4 * h + tq) + 16 * ((4 * pb + 2 * tblk + (tp >> 1)) ^ ((tq << 2) | ((2 + h) & 3))) + 8 * (tp & 1);
    const int btr0 = Lb + B_OFF + 256 * (8 * h + tq) + 16 * ((4 * nb + 2 * tblk + (tp >> 1)) ^ ((tq << 2) | (2 * h + 0))) + 8 * (tp & 1);
    const int btr1 = Lb + B_OFF + 256 * (8 * h + tq) + 16 * ((4 * nb + 2 * tblk + (tp >> 1)) ^ ((tq << 2) | (2 * h + 1))) + 8 * (tp & 1);
    const int wtr0 = Lb + XX_OFF + 256 * (8 * h + tq) + 16 * ((4 * (2 + pb2) + 2 * tblk + (tp >> 1)) ^ ((tq << 2) | (2 * h + 0))) + 8 * (tp & 1);
    const int wtr1 = Lb + XX_OFF + 256 * (8 * h + tq) + 16 * ((4 * (2 + pb2) + 2 * tblk + (tp >> 1)) ^ ((tq << 2) | (2 * h + 1))) + 8 * (tp & 1);

    { unsigned z0; asm volatile("v_mov_b32 %0, 0" : "=v"(z0)); const v4u zz = (v4u){z0, z0, z0, z0};
      for (int i = tid; i < 16384 / 16; i += 512) *(LAS v4u*)(L + H_OFF + i * 16) = zz; }
    f32x16 acc_h = {};
    v4u xr[2], br[4], cr[4]; float dtr0 = 0.f, dtr1 = 0.f, dtn0 = 0.f, dtn1 = 0.f;
    const size_t brow = (size_t)b * SEQ; const int sgn = dir ? -1 : 1;
#define SSD_TOK(ci, tau) (dir ? ((SEQ / 128 - 1 - (ci)) * 128 + 127 - (tau)) : ((ci) * 128 + (tau)))
#define SSD_TB(ci) ((int)brow + (dir ? ((SEQ / 128 - 1 - (ci)) * 128 + 127) : ((ci) * 128)))
#define SSD_PREFETCH(ci) do { const int tb_ = SSD_TB(ci); \
        { const unsigned ox = (unsigned)((tb_ + sgn * (tidl >> 3)) * (SSM_CONVD * 2) + (head * 64 + (tidl & 7) * 8) * 2); const unsigned sx = (unsigned)(sgn * 64 * SSM_CONVD * 2); \
          _Pragma("unroll") for (int i = 0; i < 2; ++i) xr[i] = *(const GAS v4u*)((const char*)xbc + (ox + (unsigned)i * sx)); } \
        { const unsigned ob = (unsigned)((tb_ + sgn * (tidl >> 4)) * (SSM_CONVD * 2) + (SSM_DI + grp * 128 + (tidl & 15) * 8) * 2); const unsigned sb = (unsigned)(sgn * 32 * SSM_CONVD * 2); \
          _Pragma("unroll") for (int i = 0; i < 4; ++i) { const char* rp = (const char*)xbc + (ob + (unsigned)i * sb); br[i] = *(const GAS v4u*)rp; cr[i] = *(const GAS v4u*)(rp + 2048); } } } while (0)
#define SSD_DTLOAD(ci, d0, d1) do { if (w == SCANW) { const unsigned od = (unsigned)((SSD_TB(ci) + sgn * 2 * lane) * 256 + dir * SSM_H + head) * 4u; \
        d0 = *(const GAS float*)((const char*)dtb + od); d1 = *(const GAS float*)((const char*)dtb + (od + (unsigned)(sgn * 1024))); } } while (0)
#define SSD_SCAN(TB) do { if (w == SCANW) { LAS char* tb_ = L + TBL_OFF + (TB) * TBL_BYTES; \
        const float a0 = dtr0 * A, a1 = dtr1 * A; float inc = a0 + a1; \
        _Pragma("unroll") for (int o = 1; o < 64; o <<= 1) { const float v = __shfl_up(inc, o); if (lane >= o) inc += v; } \
        const float c1 = inc, c0 = inc - a1; const float total = __shfl(inc, 63); \
        *(LAS f2*)(tb_ + T_CUM + 8 * lane) = (f2){c0, c1}; *(LAS f2*)(tb_ + T_DT + 8 * lane) = (f2){(c0 - __logf(dtr0)) * 1.4426950408889634f, (c1 - __logf(dtr1)) * 1.4426950408889634f}; \
        *(LAS f2*)(tb_ + T_WT + 8 * lane) = (f2){__expf(total - c0) * dtr0, __expf(total - c1) * dtr1}; if (lane == 0) *(LAS float*)(tb_ + T_ETOT) = __expf(total); } } while (0)
#define SSD_STAGE(TB) do { const LAS char* tb_ = L + TBL_OFF + (TB) * TBL_BYTES; \
        { const int obc = off_b(tidl >> 4, tidl & 15);                    \
          _Pragma("unroll") for (int i = 0; i < 4; ++i) { *(LAS v4u*)(L + B_OFF + obc + 8192 * i) = br[i]; *(LAS v4u*)(L + C_OFF + obc + 8192 * i) = cr[i]; } } \
        { const int oxx = off_b(tidl >> 3, tidl & 7);                     \
          _Pragma("unroll") for (int i = 0; i < 2; ++i) { const float wt = *(const LAS float*)(tb_ + T_WT + 4 * (tidl >> 3) + 256 * i); \
            *(LAS v4u*)(L + XX_OFF + oxx + 16384 * i) = xr[i]; \
            v4u o; o.x = pkbf(bflo(xr[i].x) * wt, bfhi(xr[i].x) * wt); o.y = pkbf(bflo(xr[i].y) * wt, bfhi(xr[i].y) * wt); o.z = pkbf(bflo(xr[i].z) * wt, bfhi(xr[i].z) * wt); o.w = pkbf(bflo(xr[i].w) * wt, bfhi(xr[i].w) * wt); \
            *(LAS v4u*)(L + XX_OFF + (oxx ^ 128) + 16384 * i) = o; } } } while (0)

    int tidl = tid; asm volatile("" : "+v"(tidl));
    SSD_DTLOAD(0, dtr0, dtr1);
    SSD_PREFETCH(0);
    SSD_SCAN(0);
    SSD_DTLOAD(1, dtr0, dtr1);
    __syncthreads();
    SSD_STAGE(0);
    SSD_PREFETCH(1);
    __syncthreads();
    for (int ci = 0; ci < SEQ / 128; ++ci) {
        const bool more = (ci + 1 < SEQ / 128);
        tidl = tid; asm volatile("" : "+v"(tidl));
        LAS const char* tbl = L + TBL_OFF + (ci & 1) * TBL_BYTES;
        if (ci + 2 < SEQ / 128) SSD_DTLOAD(ci + 2, dtn0, dtn1);
        if (more) SSD_SCAN((ci + 1) & 1);
        const float e_tot = *(const LAS float*)(tbl + T_ETOT);
        f32x16 acc_y;
        if (pb == 0) { if (lb == 0) chunk_y1<0, 0>(acc_y, L, tbl, rr0, pb, lane, l31, h); else if (lb == 1) chunk_y1<1, 0>(acc_y, L, tbl, rr0, pb, lane, l31, h);
                       else if (lb == 2) chunk_y1<2, 0>(acc_y, L, tbl, rr0, pb, lane, l31, h); else chunk_y1<3, 0>(acc_y, L, tbl, rr0, pb, lane, l31, h); }
        else         { if (lb == 0) chunk_y1<0, 1>(acc_y, L, tbl, rr0, pb, lane, l31, h); else if (lb == 1) chunk_y1<1, 1>(acc_y, L, tbl, rr0, pb, lane, l31, h);
                       else if (lb == 2) chunk_y1<2, 1>(acc_y, L, tbl, rr0, pb, lane, l31, h); else chunk_y1<3, 1>(acc_y, L, tbl, rr0, pb, lane, l31, h); }
        __syncthreads();
        if (lb == 0) chunk_y2<0>(acc_y, L, xtr0, xtr1, lane); else if (lb == 1) chunk_y2<1>(acc_y, L, xtr0, xtr1, lane);
        else if (lb == 2) chunk_y2<2>(acc_y, L, xtr0, xtr1, lane); else chunk_y2<3>(acc_y, L, xtr0, xtr1, lane);
        s16x4 sa[8][2], sb_[8][2];
#define SSD_ST_RD(KS) do { sa[KS][0] = tr_read<256 * (16 * (KS) + 0)>(btr0); sa[KS][1] = tr_read<256 * (16 * (KS) + 4)>(btr1); \
                           sb_[KS][0] = tr_read<256 * (16 * (KS) + 0)>(wtr0); sb_[KS][1] = tr_read<256 * (16 * (KS) + 4)>(wtr1); } while (0)
        SSD_ST_RD(0); SSD_ST_RD(1); SSD_ST_RD(2); SSD_ST_RD(3); SSD_ST_RD(4); SSD_ST_RD(5); SSD_ST_RD(6); SSD_ST_RD(7);
#undef SSD_ST_RD
        { char* yp = (char*)yout + (unsigned)((SSD_TB(ci) + sgn * (32 * lb + l31)) * SSM_DI + head * 64 + 32 * pb + 4 * h) * 2u;
          if (dir == 0) { const int x0 = off_b(32 * lb + l31, 4 * pb) + 8 * h;
#pragma unroll
            for (int q = 0; q < 4; ++q) { const v2u xq = *(const LAS v2u*)(L + XX_OFF + (x0 ^ (16 * q)));
              v2u o; o.x = pkbf(acc_y[4 * q] + dsk_eff * bflo(xq.x), acc_y[4 * q + 1] + dsk_eff * bfhi(xq.x)); o.y = pkbf(acc_y[4 * q + 2] + dsk_eff * bflo(xq.y), acc_y[4 * q + 3] + dsk_eff * bfhi(xq.y));
              *(GAS v2u*)(yp + 16 * q) = o; }
          } else {
#pragma unroll
            for (int q = 0; q < 4; ++q) { v2u o; o.x = pkbf(acc_y[4 * q], acc_y[4 * q + 1]); o.y = pkbf(acc_y[4 * q + 2], acc_y[4 * q + 3]); *(GAS v2u*)(yp + 16 * q) = o; } } }
        dtr0 = dtn0; dtr1 = dtn1;
        SSD_LGKM0();
        __syncthreads();
        { f32x16 ha = {}, hb = {};
          __builtin_amdgcn_s_setprio(1);
          ha = SSD_MFMA(SSD_PK(sa[0][0], sa[0][1]), SSD_PK(sb_[0][0], sb_[0][1]), ha); hb = SSD_MFMA(SSD_PK(sa[1][0], sa[1][1]), SSD_PK(sb_[1][0], sb_[1][1]), hb);
          ha = SSD_MFMA(SSD_PK(sa[2][0], sa[2][1]), SSD_PK(sb_[2][0], sb_[2][1]), ha); hb = SSD_MFMA(SSD_PK(sa[3][0], sa[3][1]), SSD_PK(sb_[3][0], sb_[3][1]), hb);
          ha = SSD_MFMA(SSD_PK(sa[4][0], sa[4][1]), SSD_PK(sb_[4][0], sb_[4][1]), ha); hb = SSD_MFMA(SSD_PK(sa[5][0], sa[5][1]), SSD_PK(sb_[5][0], sb_[5][1]), hb);
          ha = SSD_MFMA(SSD_PK(sa[6][0], sa[6][1]), SSD_PK(sb_[6][0], sb_[6][1]), ha); hb = SSD_MFMA(SSD_PK(sa[7][0], sa[7][1]), SSD_PK(sb_[7][0], sb_[7][1]), hb);
          __builtin_amdgcn_s_setprio(0);
#pragma unroll
          for (int r = 0; r < 16; ++r) acc_h[r] = acc_h[r] * e_tot + (ha[r] + hb[r]); }
        tidl = tid; asm volatile("" : "+v"(tidl));
        if (more) {
            const int a0 = off_b(32 * pb2 + l31, 4 * nb) + 8 * h;
#pragma unroll
            for (int q = 0; q < 4; ++q) { v2u o; o.x = pkbf(acc_h[4 * q], acc_h[4 * q + 1]); o.y = pkbf(acc_h[4 * q + 2], acc_h[4 * q + 3]);
                *(LAS v2u*)(L + H_OFF + (a0 ^ (16 * q))) = o; }
            SSD_STAGE((ci + 1) & 1);
            if (ci + 2 < SEQ / 128) SSD_PREFETCH(ci + 2);
        }
        __syncthreads();
    }
#undef SSD_TOK
#undef SSD_PREFETCH
#undef SSD_DTLOAD
#undef SSD_SCAN
#undef SSD_STAGE
}
#undef SSD_PK
#undef SSD_LGKM0
#undef SSD_MFMA
#undef SSD_BROW
#undef SSD_RRO
#undef SSD_MXA
}
#define XB_TMO      128
#define XB_XCNT(j)  (256  + 64 * (j))
#define XB_XSUB(j)  (1280 + 64 * (j))
#define XB_XGEN(j)  (2304 + 64 * (j))
#define XB_TOP      3328
#define XB_TOPGEN   3392
#define XCD_BAR_WORDS 3456
#define XB_SPIN_CAP (1u << 18)

__device__ __forceinline__ unsigned xb_ld(unsigned* p)              { return __hip_atomic_load(p, __ATOMIC_RELAXED, __HIP_MEMORY_SCOPE_AGENT); }
__device__ __forceinline__ unsigned xb_add(unsigned* p, unsigned v) { return __hip_atomic_fetch_add(p, v, __ATOMIC_RELAXED, __HIP_MEMORY_SCOPE_AGENT); }
__device__ __forceinline__ unsigned xb_xcc_id() { return (unsigned)__builtin_amdgcn_s_getreg((3 << 11) | 20) & 0xFu; }
#define XB_SPIN(cond, bar) do { unsigned _sp = 0; while (cond) { __builtin_amdgcn_s_sleep(1); \
    if ((++_sp & 255u) == 0u) { if (xb_ld(&(bar)[XB_TMO])) break; if (_sp > XB_SPIN_CAP) { atomicAdd(&(bar)[XB_TMO], 1u); break; } } } } while (0)

struct XcdBarrier {
    unsigned* bar; unsigned x;
    volatile LAS unsigned* st;
};

__device__ __forceinline__ XcdBarrier xcd_barrier_post(unsigned* bar, volatile LAS unsigned* st, int tid) {
    XcdBarrier b; b.bar = bar; b.x = xb_xcc_id(); b.st = st;
    if (tid == 0) (void)xb_add(&bar[XB_XCNT(b.x)], 1u);
    return b;
}
__device__ __forceinline__ void xcd_barrier_complete(unsigned* bar, unsigned x, unsigned& nloc, unsigned& nx) {
    const unsigned G = gridDim.x * gridDim.y * gridDim.z;
    unsigned sum, cnt, mine, sp = 0u;
    for (;;) {
        sum = 0u; cnt = 0u; mine = 0u;
#pragma unroll
        for (unsigned j = 0; j < 16; ++j) { const unsigned c = xb_ld(&bar[XB_XCNT(j)]); sum += c; cnt += (c > 0u) ? 1u : 0u; mine = (j == x) ? c : mine; }
        if (sum == G) break;
        __builtin_amdgcn_s_sleep(1);
        if ((++sp & 255u) == 0u) { if (xb_ld(&bar[XB_TMO])) break; if (sp > XB_SPIN_CAP) { atomicAdd(&bar[XB_TMO], 1u); break; } }
    }
    nloc = mine > 0u ? mine : 1u; nx = cnt > 0u ? cnt : 1u;
}

__device__ __forceinline__ void xcd_barrier(const XcdBarrier& b, int tid) {
    asm volatile("s_waitcnt vmcnt(0)" ::: "memory");
    __syncthreads();
    if (tid == 0) {
        unsigned* bar = b.bar;
        __builtin_amdgcn_s_waitcnt(0);
        unsigned nloc = b.st[0], nx = b.st[1];
        if (nloc == 0u) { xcd_barrier_complete(bar, b.x, nloc, nx); b.st[0] = nloc; b.st[1] = nx; }
        const unsigned old = xb_add(&bar[XB_XSUB(b.x)], 1u);
        const unsigned gen = old / nloc;
        if (old + 1u == (gen + 1u) * nloc) {
            __builtin_amdgcn_fence(__ATOMIC_RELEASE, "agent");
            asm volatile("s_waitcnt vmcnt(0)" ::: "memory");
            const unsigned og = xb_add(&bar[XB_TOP], 1u);
            const unsigned tg = og / nx;
            if (og + 1u == (tg + 1u) * nx) xb_add(&bar[XB_TOPGEN], 1u);
            else XB_SPIN(xb_ld(&bar[XB_TOPGEN]) == tg, bar);
            __builtin_amdgcn_fence(__ATOMIC_ACQUIRE, "agent");
            xb_add(&bar[XB_XGEN(b.x)], 1u);
            asm volatile("s_waitcnt vmcnt(0)" ::: "memory");
        } else {
            XB_SPIN(xb_ld(&bar[XB_XGEN(b.x)]) == gen, bar);
            __builtin_amdgcn_fence(__ATOMIC_ACQUIRE, "agent");
            asm volatile("s_waitcnt vmcnt(0)" ::: "memory");
        }
    }
    __syncthreads();
}
struct Ctx { LAS unsigned char* lds; int tid, lane, wave, gw, NGW, G; };
constexpr int NWAVES_C = 8;

__device__ __forceinline__ void transpose_item(const float* W, int K, int N, bf16* WT, int row_off, LAS float* scr, int item, int lane) {
    const int nblk = N / 32, kb = item / nblk, nb = item % nblk, k0 = 64 * kb, n0 = 32 * nb;
#pragma unroll 8
    for (int i = 0; i < 32; ++i) { const int kk = 2 * i + (lane >> 5); scr[kk * 33 + (lane & 31)] = W[(size_t)(k0 + kk) * N + n0 + (lane & 31)]; }
    LDS_WAIT(); asm volatile("" ::: "memory");
    const int c = lane & 7;
#pragma unroll
    for (int j = 0; j < 4; ++j) { const int n = (lane >> 3) + 8 * j; const LAS float* s = scr + (8 * c) * 33 + n;
        v4u o; o.x = pkbf(s[0 * 33], s[1 * 33]); o.y = pkbf(s[2 * 33], s[3 * 33]); o.z = pkbf(s[4 * 33], s[5 * 33]); o.w = pkbf(s[6 * 33], s[7 * 33]);
        *(GAS v4u*)(WT + (size_t)(row_off + n0 + n) * K + k0 + 8 * c) = o; }
    LDS_WAIT(); asm volatile("" ::: "memory");
}

struct P0Args { const float *c, *w_ada, *b_ada; float* mod; float* ropetab; const float *w_in, *w_gate, *w_ssm, *w_att, *w_out, *w_up, *w_dn; bf16 *Wcat, *Wssm, *Watt, *Wout, *Wup, *Wdn; };
__device__ __forceinline__ void phase_prologue(const Ctx& X, const P0Args& A) {
    for (int it = X.gw; it < 96 * 64; it += X.NGW) {
        const int nb = it % 96, kc = it / 96, n0 = nb * 256 + X.lane * 4, k0 = kc * 64;
        float sc[4];
#pragma unroll
        for (int b = 0; b < 4; ++b) sc[b] = siluf_(A.c[b * D_MODEL + k0 + X.lane]);
        v4f acc[4];
#pragma unroll
        for (int b = 0; b < 4; ++b) acc[b] = (v4f){0.f, 0.f, 0.f, 0.f};
        const float* wp = A.w_ada + (size_t)k0 * MOD_LD + n0;
#pragma unroll 1
        for (int kq = 0; kq < 4; ++kq) {
            v4f w[16];
#pragma unroll
            for (int kk = 0; kk < 16; ++kk) w[kk] = *(const GAS v4f*)(wp + (size_t)(kq * 16 + kk) * MOD_LD);
#pragma unroll
            for (int kk = 0; kk < 16; ++kk)
#pragma unroll
                for (int b = 0; b < 4; ++b) { const float s = __uint_as_float(__builtin_amdgcn_readlane(__float_as_uint(sc[b]), kq * 16 + kk)); acc[b] += w[kk] * s; }
        }
        if (kc == 0) { const v4f bb = *(const GAS v4f*)(A.b_ada + n0);
#pragma unroll
            for (int b = 0; b < 4; ++b) acc[b] += bb; }
#pragma unroll
        for (int b = 0; b < 4; ++b) { float* mp = A.mod + (size_t)b * MOD_LD + n0;
            unsafeAtomicAdd(mp, acc[b].x); unsafeAtomicAdd(mp + 1, acc[b].y); unsafeAtomicAdd(mp + 2, acc[b].z); unsafeAtomicAdd(mp + 3, acc[b].w); }
    }
    { const int gt = X.gw * 64 + X.lane;
      if (gt < 64 * 32) { const int pos = gt >> 5, i = gt & 31; const float ang = (float)pos * exp2f(-(float)i * (13.287712379549449f / 32.0f)); float sn, cs; sincosf(ang, &sn, &cs);
          A.ropetab[2 * gt] = cs; A.ropetab[2 * gt + 1] = sn; } }
    LAS float* scr = (LAS float*)(X.lds + X.wave * 16384);
    constexpr int I_IN = (D_MODEL / 64) * (IN_COLS / 32), I_GATE = (D_MODEL / 64) * (2 * D_MODEL / 32);
    constexpr int NITEMS = I_IN + I_GATE;
    for (int it = X.gw; it < NITEMS; it += X.NGW) {
        int r = it;
        if (r < I_IN) { transpose_item(A.w_in, D_MODEL, IN_COLS, A.Wcat, 0, scr, r, X.lane); continue; } r -= I_IN;
        transpose_item(A.w_gate, D_MODEL, 2 * D_MODEL, A.Wcat, IN_COLS, scr, r, X.lane);
    }
}
__device__ __forceinline__ void transposes_up_share(const Ctx& X, const float* w_up, bf16* Wup) {
    LAS float* scr = (LAS float*)(X.lds + X.wave * 16384);
    constexpr int I_UP = (D_MODEL / 64) * (FFN2 / 32), nblk = FFN2 / 32;
    const int lr = X.lane >> 3, lc = 4 * (X.lane & 7);
    for (int it0 = X.gw; it0 < I_UP; it0 += 2 * X.NGW) {
        const int it1 = it0 + X.NGW; const bool two = it1 < I_UP;
        v4f v[2][8];
#pragma unroll
        for (int s = 0; s < 2; ++s) { const int it = (s && two) ? it1 : it0; const int kb = it / nblk, nb = it % nblk;
            const GAS float* src = (const GAS float*)w_up + (size_t)(64 * kb + lr) * FFN2 + 32 * nb + lc;
#pragma unroll
            for (int i = 0; i < 8; ++i) v[s][i] = *(const GAS v4f*)(src + (size_t)(8 * i) * FFN2); }
#pragma unroll
        for (int s = 0; s < 2; ++s) {
            if (s && !two) break;
            const int it = s ? it1 : it0; const int kb = it / nblk, nb = it % nblk, k0 = 64 * kb, n0 = 32 * nb;
            const int f = (n0 < FFN) ? (256 * (n0 >> 7) + (n0 & 127)) : (256 * ((n0 - FFN) >> 7) + 128 + ((n0 - FFN) & 127));
#pragma unroll
            for (int i = 0; i < 8; ++i) { LAS float* d = scr + (lr + 8 * i) * 33 + lc; d[0] = v[s][i].x; d[1] = v[s][i].y; d[2] = v[s][i].z; d[3] = v[s][i].w; }
            LDS_WAIT(); asm volatile("" ::: "memory");
            const int c = X.lane & 7;
#pragma unroll
            for (int j = 0; j < 4; ++j) { const int n = (X.lane >> 3) + 8 * j; const LAS float* sp = scr + (8 * c) * 33 + n;
                v4u o; o.x = pkbf(sp[0 * 33], sp[1 * 33]); o.y = pkbf(sp[2 * 33], sp[3 * 33]); o.z = pkbf(sp[4 * 33], sp[5 * 33]); o.w = pkbf(sp[6 * 33], sp[7 * 33]);
                *(GAS v4u*)(Wup + (size_t)(f + n) * D_MODEL + k0 + 8 * c) = o; }
            LDS_WAIT(); asm volatile("" ::: "memory");
        }
    }
}
__device__ __forceinline__ void tail_transposes_mix(const Ctx& X, int first, const float* w_ssm, const float* w_att, const float* w_out, bf16* Wssm, bf16* Watt, bf16* Wout) {
    if ((int)blockIdx.x < first) return;
    LAS float* scr = (LAS float*)(X.lds + X.wave * 16384);
    constexpr int I_SSM = (SSM_DI / 64) * (D_MODEL / 32), I_ATT = (D_MODEL / 64) * (D_MODEL / 32), NIT = I_SSM + 2 * I_ATT;
    const int gwv = ((int)blockIdx.x - first) * NWAVES_C + X.wave, ngw = (X.G - first) * NWAVES_C;
    for (int it = gwv; it < NIT; it += ngw) {
        int r = it;
        if (r < I_SSM) { transpose_item(w_ssm, SSM_DI, D_MODEL, Wssm, 0, scr, r, X.lane); continue; } r -= I_SSM;
        if (r < I_ATT) { transpose_item(w_att, D_MODEL, D_MODEL, Watt, 0, scr, r, X.lane); continue; } r -= I_ATT;
        transpose_item(w_out, D_MODEL, D_MODEL, Wout, 0, scr, r, X.lane);
    }
}
__device__ __forceinline__ void tail_transposes_down(const Ctx& X, int first, const float* w_dn, bf16* Wdn) {
    if ((int)blockIdx.x < first) return;
    LAS float* scr = (LAS float*)(X.lds + X.wave * 16384);
    constexpr int NIT = (FFN / 64) * (D_MODEL / 32);
    const int gwv = ((int)blockIdx.x - first) * NWAVES_C + X.wave, ngw = (X.G - first) * NWAVES_C;
    for (int it = gwv; it < NIT; it += ngw) transpose_item(w_dn, FFN, D_MODEL, Wdn, 0, scr, it, X.lane);
}
__device__ __forceinline__ void phase_mod_reduce(const Ctx& X, const float* part, const float* b_ada, float* mod) {
    const int gt = X.gw * 64 + X.lane;
    for (int i = gt; i < 4 * MOD_LD / 4; i += X.NGW * 64) {
        const int b = i / (MOD_LD / 4), n = (i % (MOD_LD / 4)) * 4;
        v4f s = *(const GAS v4f*)(b_ada + n);
#pragma unroll 8
        for (int kc = 0; kc < 64; ++kc) s += *(const GAS v4f*)(part + ((size_t)(kc * 4 + b)) * MOD_LD + n);
        *(GAS v4f*)(mod + (size_t)b * MOD_LD + n) = s;
    }
}
__device__ __forceinline__ void ln_stats(const v4f (&v)[16], float& mean, float& rstd) {
    float s = 0.f;
#pragma unroll
    for (int j = 0; j < 16; ++j) s += (v[j].x + v[j].y) + (v[j].z + v[j].w);
    mean = wave_sum(s) * (1.f / D_MODEL); float s2 = 0.f;
#pragma unroll
    for (int j = 0; j < 16; ++j) { const v4f d = v[j] - mean; s2 += (d.x * d.x + d.y * d.y) + (d.z * d.z + d.w * d.w); }
    rstd = 1.0f / sqrtf(wave_sum(s2) * (1.f / D_MODEL) + LN_EPS);
}
__device__ __forceinline__ void phase_h(const Ctx& X, const float* x, const float* mod, bf16* h) {
    for (int m = X.gw; m < MTOK; m += X.NGW) {
        const GAS v4f* xr = (const GAS v4f*)(x + (size_t)m * D_MODEL) + X.lane;
        v4f v[16];
#pragma unroll
        for (int j = 0; j < 16; ++j) v[j] = xr[64 * j];
        float mean, rstd; ln_stats(v, mean, rstd);
        const float* mrow = mod + (size_t)(m / SEQ) * MOD_LD;
        const GAS v4f* sh = (const GAS v4f*)(mrow) + X.lane; const GAS v4f* sc = (const GAS v4f*)(mrow + D_MODEL) + X.lane;
        GAS v2u* o = (GAS v2u*)(h + (size_t)m * D_MODEL) + X.lane;
#pragma unroll
        for (int j = 0; j < 16; ++j) { const v4f y = (v[j] - mean) * rstd * (sc[64 * j] + 1.0f) + sh[64 * j]; v2u w; w.x = pkbf(y.x, y.y); w.y = pkbf(y.z, y.w); o[64 * j] = w; }
    }
}
__device__ __forceinline__ void unpack8(const v4u w, float (&f)[8]) { f[0] = bflo(w.x); f[1] = bfhi(w.x); f[2] = bflo(w.y); f[3] = bfhi(w.y); f[4] = bflo(w.z); f[5] = bfhi(w.z); f[6] = bflo(w.w); f[7] = bfhi(w.w); }
__device__ __forceinline__ void phase_xbc_fixup(const Ctx& X, const float* edge, const float* cw, const float* cb, bf16* out) {
    constexpr int NCG = SSM_CONVD / 8, NSEG = MTOK / 128;
    const int gt = X.gw * 64 + X.lane, NT = X.NGW * 64;
    for (int it = gt; it < (NSEG - 1) * NCG; it += NT) {
        const int bd = 1 + it / NCG, c = 8 * (it % NCG);
        if ((bd & 31) == 0) continue;
        const float* e_lm1 = edge + ((size_t)(bd - 1) * 4 + 2) * SSM_CONVD + c; const float* e_l = e_lm1 + SSM_CONVD;
        const float* e_f = edge + ((size_t)bd * 4 + 0) * SSM_CONVD + c; const float* e_f1 = e_f + SSM_CONVD;
        float oa[8], ob[8];
#pragma unroll
        for (int j = 0; j < 8; ++j) { const float w0 = cw[c + j], w1 = cw[SSM_CONVD + c + j], w2 = cw[2 * SSM_CONVD + c + j], bb = cb[c + j];
            oa[j] = siluf_(e_lm1[j] * w0 + e_l[j] * w1 + e_f[j] * w2 + bb);
            ob[j] = siluf_(e_l[j] * w0 + e_f[j] * w1 + e_f1[j] * w2 + bb); }
        v4u w0_, w1_; w0_.x = pkbf(oa[0], oa[1]); w0_.y = pkbf(oa[2], oa[3]); w0_.z = pkbf(oa[4], oa[5]); w0_.w = pkbf(oa[6], oa[7]);
        w1_.x = pkbf(ob[0], ob[1]); w1_.y = pkbf(ob[2], ob[3]); w1_.z = pkbf(ob[4], ob[5]); w1_.w = pkbf(ob[6], ob[7]);
        *(GAS v4u*)(out + (size_t)(128 * bd - 1) * SSM_CONVD + c) = w0_; *(GAS v4u*)(out + (size_t)(128 * bd) * SSM_CONVD + c) = w1_;
    }
}
__device__ __forceinline__ void qk_norm_rope_rows(const Ctx& X, bf16* buf, int nheads, const float* nw, const float* tab) {
    const int total = MTOK * nheads / 4;
    const int sub = X.lane >> 4, j16 = X.lane & 15;
    float wv[8];
#pragma unroll
    for (int e = 0; e < 8; ++e) wv[e] = nw[j16 * 8 + e];
    const int half = j16 >> 3, jj = j16 & 7;
    const bool is_x2 = (jj >= 4);
    const int i0 = (jj & 3) * 8;
    for (int it = X.gw; it < total; it += X.NGW) {
        const int pair = it * 4 + sub, tok = pair / nheads, hd = pair % nheads;
        GAS v4u* p = (GAS v4u*)(buf + ((size_t)tok * nheads + hd) * 128 + j16 * 8);
        float f[8]; unpack8(*p, f);
        float ss = 0.f;
#pragma unroll
        for (int e = 0; e < 8; ++e) ss += f[e] * f[e];
        ss += __shfl_xor(ss, 1); ss += __shfl_xor(ss, 2); ss += __shfl_xor(ss, 4); ss += __shfl_xor(ss, 8);
        const float r = 1.0f / sqrtf(ss * (1.f / 128.f) + RMS_EPS);
#pragma unroll
        for (int e = 0; e < 8; ++e) f[e] = f[e] * r * wv[e];
        const int t = tok % SEQ; const int pos = half ? (t % GRID_W) : (t / GRID_W);
        const GAS v4f* tp = (const GAS v4f*)(tab + (size_t)(pos * 32 + i0) * 2);
        float csn[16];
#pragma unroll
        for (int q4 = 0; q4 < 4; ++q4) { const v4f tv = tp[q4]; csn[q4 * 4 + 0] = tv.x; csn[q4 * 4 + 1] = tv.y; csn[q4 * 4 + 2] = tv.z; csn[q4 * 4 + 3] = tv.w; }
        float o[8];
#pragma unroll
        for (int e = 0; e < 8; ++e) { const float other = __shfl_xor(f[e], 4); const float cs = csn[2 * e], sn = csn[2 * e + 1];
            o[e] = is_x2 ? (f[e] * cs + other * sn) : (f[e] * cs - other * sn); }
        v4u w; w.x = pkbf(o[0], o[1]); w.y = pkbf(o[2], o[3]); w.z = pkbf(o[4], o[5]); w.w = pkbf(o[6], o[7]);
        *p = w;
    }
}
__device__ __forceinline__ void ssd_naive_unit(const Ctx& X, int unit, const bf16* xbc, const float* dtb, const float* a_log, bf16* yout) {
    const int dir = unit & 1, head = (unit >> 1) & 127, b = unit >> 8, grp = head >> 4;
    const int tid = X.tid, p = tid >> 3, ng = tid & 7;
    LAS float* xs = (LAS float*)X.lds;
    LAS float* Bs = xs + 64 * 64;
    LAS float* Cs = Bs + 64 * 128;
    LAS float* dts = Cs + 64 * 128;
    LAS float* as_ = dts + 64;
    LAS float* ys = as_ + 64;
    const float A = -__expf(a_log[dir * SSM_H + head]);
    float h[16];
#pragma unroll
    for (int i = 0; i < 16; ++i) h[i] = 0.f;
    for (int ci = 0; ci < SEQ / 64; ++ci) {
        const int c = dir ? (SEQ / 64 - 1 - ci) : ci; const size_t row0 = (size_t)b * SEQ + (size_t)c * 64;
        { const int tok = tid >> 3, s8 = (tid & 7);
          const bf16* rp = xbc + (row0 + tok) * SSM_CONVD;
          float f[8]; unpack8(*(const GAS v4u*)(rp + head * 64 + s8 * 8), f);
#pragma unroll
          for (int j = 0; j < 8; ++j) xs[tok * 64 + s8 * 8 + j] = f[j];
          unpack8(*(const GAS v4u*)(rp + SSM_DI + grp * 128 + s8 * 16), f);
#pragma unroll
          for (int j = 0; j < 8; ++j) Bs[tok * 128 + s8 * 16 + j] = f[j];
          unpack8(*(const GAS v4u*)(rp + SSM_DI + grp * 128 + s8 * 16 + 8), f);
#pragma unroll
          for (int j = 0; j < 8; ++j) Bs[tok * 128 + s8 * 16 + 8 + j] = f[j];
          unpack8(*(const GAS v4u*)(rp + SSM_DI + 1024 + grp * 128 + s8 * 16), f);
#pragma unroll
          for (int j = 0; j < 8; ++j) Cs[tok * 128 + s8 * 16 + j] = f[j];
          unpack8(*(const GAS v4u*)(rp + SSM_DI + 1024 + grp * 128 + s8 * 16 + 8), f);
#pragma unroll
          for (int j = 0; j < 8; ++j) Cs[tok * 128 + s8 * 16 + 8 + j] = f[j];
          if (tid < 64) { const float dv = dtb[(row0 + tid) * 256 + dir * SSM_H + head]; dts[tid] = dv; as_[tid] = __expf(dv * A); } }
        __syncthreads();
#pragma unroll 2
        for (int ti = 0; ti < 64; ++ti) {
            const int t = dir ? 63 - ti : ti;
            const float av = as_[t], xv = xs[t * 64 + p] * dts[t];
            float part = 0.f;
#pragma unroll
            for (int i4 = 0; i4 < 4; ++i4) { const v4f bv = *(const LAS v4f*)(Bs + t * 128 + ng * 16 + i4 * 4), cv = *(const LAS v4f*)(Cs + t * 128 + ng * 16 + i4 * 4);
#pragma unroll
                for (int j = 0; j < 4; ++j) { h[i4 * 4 + j] = av * h[i4 * 4 + j] + xv * bv[j]; part += cv[j] * h[i4 * 4 + j]; } }
            part += __shfl_xor(part, 1); part += __shfl_xor(part, 2); part += __shfl_xor(part, 4);
            if (ng == 0) ys[t * 64 + p] = part;
        }
        __syncthreads();
        { const int tok = tid >> 3, s8 = tid & 7; const LAS float* yp = ys + tok * 64 + s8 * 8;
          v4u o; o.x = pkbf(yp[0], yp[1]); o.y = pkbf(yp[2], yp[3]); o.z = pkbf(yp[4], yp[5]); o.w = pkbf(yp[6], yp[7]);
          *(GAS v4u*)(yout + (row0 + tok) * SSM_DI + head * 64 + s8 * 8) = o; }
    }
    __syncthreads();
}
__device__ __forceinline__ void phase_ssm_combine(const Ctx& X, const bf16* yf, const bf16* yb, bf16* z, const float* normw) {
    for (int it = X.gw; it < MTOK * SSM_G; it += X.NGW) {
        const int tok = it >> 3, g = it & 7, e0 = g * 1024 + X.lane * 16;
        float y[16];
#pragma unroll
        for (int hh = 0; hh < 2; ++hh) { float a[8], bq[8], zz[8];
            unpack8(*(const GAS v4u*)(yf + (size_t)tok * SSM_DI + e0 + hh * 8), a); unpack8(*(const GAS v4u*)(yb + (size_t)tok * SSM_DI + e0 + hh * 8), bq);
            unpack8(*(const GAS v4u*)(z + (size_t)tok * SSM_DI + e0 + hh * 8), zz);
#pragma unroll
            for (int j = 0; j < 8; ++j) y[hh * 8 + j] = (a[j] + bq[j]) * siluf_(zz[j]); }
        float ss = 0.f;
#pragma unroll
        for (int j = 0; j < 16; ++j) ss += y[j] * y[j];
        const float r = 1.0f / sqrtf(wave_sum(ss) * (1.f / 1024.f) + RMS_EPS);
#pragma unroll
        for (int hh = 0; hh < 2; ++hh) { float o[8];
#pragma unroll
            for (int j = 0; j < 8; ++j) o[j] = y[hh * 8 + j] * r * normw[e0 + hh * 8 + j];
            v4u w; w.x = pkbf(o[0], o[1]); w.y = pkbf(o[2], o[3]); w.z = pkbf(o[4], o[5]); w.w = pkbf(o[6], o[7]);
            *(GAS v4u*)(z + (size_t)tok * SSM_DI + e0 + hh * 8) = w; }
    }
}
__device__ __forceinline__ void phase_ln1(const Ctx& X, const float* r1, const float* g, const float* bt, const float* mod, float* stats, bf16* h2) {
    for (int m = X.gw; m < MTOK; m += X.NGW) {
        const GAS v4f* rr = (const GAS v4f*)(r1 + (size_t)m * D_MODEL) + X.lane;
        v4f v[16];
#pragma unroll
        for (int j = 0; j < 16; ++j) v[j] = rr[64 * j];
        float mean, rstd; ln_stats(v, mean, rstd);
        const float* gl = g; const float* bl = bt; asm volatile("" : "+s"(gl), "+s"(bl));
        const GAS v4f* gp = (const GAS v4f*)gl + X.lane; const GAS v4f* bp = (const GAS v4f*)bl + X.lane;
        if (X.lane == 0) { typedef float f2_ __attribute__((ext_vector_type(2))); *(GAS f2_*)(stats + 2 * (size_t)m) = (f2_){mean, rstd}; }
#pragma unroll
        for (int j = 0; j < 16; ++j) { v[j] = (v[j] - mean) * rstd * gp[64 * j] + bp[64 * j]; if ((j & 3) == 3) asm volatile("" ::: "memory"); }
        ln_stats(v, mean, rstd);
        const float* mrow = mod + (size_t)(m / SEQ) * MOD_LD;
        const GAS v4f* sh = (const GAS v4f*)(mrow + 3 * D_MODEL) + X.lane; const GAS v4f* sc = (const GAS v4f*)(mrow + 4 * D_MODEL) + X.lane;
        GAS v2u* o = (GAS v2u*)(h2 + (size_t)m * D_MODEL) + X.lane;
#pragma unroll
        for (int j = 0; j < 16; ++j) { const v4f y = (v[j] - mean) * rstd * (sc[64 * j] + 1.0f) + sh[64 * j]; v2u w; w.x = pkbf(y.x, y.y); w.y = pkbf(y.z, y.w); o[64 * j] = w; }
    }
}
__device__ __forceinline__ void phase_conv_fixup(const Ctx& X, const float* edge, const float* cw, const float* cb, bf16* act) {
    constexpr int NCG = FFN / 8, NSEG = MTOK / 128;
    const int gt = X.gw * 64 + X.lane, NT = X.NGW * 64;
    for (int it = gt; it < (NSEG - 1) * NCG; it += NT) {
        const int bd = 1 + it / NCG, cg = it % NCG;
        if ((bd & 31) == 0) continue;
        const int c = 8 * cg, tca = 256 * (c >> 7) + (c & 127);
        const float* e_lm1 = edge + ((size_t)(bd - 1) * 4 + 2) * 22016 + tca;
        const float* e_l = e_lm1 + 22016;
        const float* e_f = edge + ((size_t)bd * 4 + 0) * 22016 + tca;
        const float* e_f1 = e_f + 22016;
        float oa[8], ob[8];
#pragma unroll
        for (int j = 0; j < 8; ++j) {
            const float wa0 = cw[c + j], wa1 = cw[FFN2 + c + j], wa2 = cw[2 * FFN2 + c + j], ba = cb[c + j];
            const float wb0 = cw[FFN + c + j], wb1 = cw[FFN2 + FFN + c + j], wb2 = cw[2 * FFN2 + FFN + c + j], bb = cb[FFN + c + j];
            const float a_lm1 = e_lm1[j], a_l = e_l[j], a_f = e_f[j], a_f1 = e_f1[j], b_lm1 = e_lm1[128 + j], b_l = e_l[128 + j], b_f = e_f[128 + j], b_f1 = e_f1[128 + j];
            const float ca0 = a_lm1 * wa0 + a_l * wa1 + a_f * wa2 + ba, cb0 = b_lm1 * wb0 + b_l * wb1 + b_f * wb2 + bb;
            const float ca1 = a_l * wa0 + a_f * wa1 + a_f1 * wa2 + ba, cb1 = b_l * wb0 + b_f * wb1 + b_f1 * wb2 + bb;
            oa[j] = siluf_(ca0) * cb0; ob[j] = siluf_(ca1) * cb1; }
        v4u w0, w1; w0.x = pkbf(oa[0], oa[1]); w0.y = pkbf(oa[2], oa[3]); w0.z = pkbf(oa[4], oa[5]); w0.w = pkbf(oa[6], oa[7]);
        w1.x = pkbf(ob[0], ob[1]); w1.y = pkbf(ob[2], ob[3]); w1.z = pkbf(ob[4], ob[5]); w1.w = pkbf(ob[6], ob[7]);
        *(GAS v4u*)(act + (size_t)(128 * bd - 1) * FFN + c) = w0; *(GAS v4u*)(act + (size_t)(128 * bd) * FFN + c) = w1;
    }
}
__device__ __forceinline__ void phase_ln_final(const Ctx& X, float* io, const float* g, const float* bt) {
    for (int m = X.gw; m < MTOK; m += X.NGW) {
        GAS v4f* rr = (GAS v4f*)(io + (size_t)m * D_MODEL) + X.lane;
        v4f v[16];
#pragma unroll
        for (int j = 0; j < 16; ++j) v[j] = rr[64 * j];
        float mean, rstd; ln_stats(v, mean, rstd);
        const GAS v4f* gp = (const GAS v4f*)g + X.lane; const GAS v4f* bp = (const GAS v4f*)bt + X.lane;
#pragma unroll
        for (int j = 0; j < 16; ++j) rr[64 * j] = (v[j] - mean) * rstd * gp[64 * j] + bp[64 * j];
    }
}
constexpr int N_PHASES = 15;
struct Args { const float* in[26]; float* out; unsigned char* ws; int ph_lo, ph_hi; };
__global__ void __launch_bounds__(NWAVES * 64, 2) mk_fwd(Args args) {
    extern __shared__ __attribute__((aligned(16))) unsigned char lds[];
    volatile LAS unsigned* MISC = (volatile LAS unsigned*)((LAS unsigned char*)lds + MISC_OFF);
    unsigned char* const ws = args.ws;
    for (int u = threadIdx.x; u < (LDS_BYTES - LDS_ZERO_OFF) / 4; u += NWAVES * 64) ((LAS unsigned*)((LAS unsigned char*)lds + LDS_ZERO_OFF))[u] = 0u;
    __syncthreads();
    const int s_wave = __builtin_amdgcn_readfirstlane((int)threadIdx.x >> 6);
#define TIDX() ((s_wave << 6) | lane_id_now())
    XcdBarrier bar = xcd_barrier_post((unsigned*)(ws + WS_CTL), MISC + 8, TIDX());
    const int lo = args.ph_lo, hi = args.ph_hi;
#define IN(k) (lo <= (k) && (k) < hi)
#define SEAM(k) do { if (IN(k) && IN((k) + 1)) xcd_barrier(bar, TIDX()); } while (0)
#define MKCTX() Ctx X; { int t_ = TIDX(); asm volatile("" : "+v"(t_)); X.lds = (LAS unsigned char*)lds; X.tid = t_; X.lane = t_ & 63; X.wave = __builtin_amdgcn_readfirstlane(t_ >> 6); \
        X.G = gridDim.x; X.gw = blockIdx.x * NWAVES + X.wave; X.NGW = X.G * NWAVES; }
#define x_in args.in[0]
#define mod ((float*)(ws + WS_MOD))
#define ropetab ((float*)(ws + WS_MOD + 393216))
#define Wcat ((bf16*)(ws + WS_WCAT))
#define Wssm ((bf16*)(ws + WS_WSSM))
#define Watt ((bf16*)(ws + WS_WATT))
#define Wout ((bf16*)(ws + WS_WOUT))
#define Wup ((bf16*)(ws + WS_WUP))
#define Wdn ((bf16*)(ws + WS_WDN))
#define hbuf ((bf16*)(ws + WS_H))
#define zbuf ((bf16*)(ws + WS_Z))
#define edge1 ((float*)(ws + WS_EDGE1))
#define dtb ((float*)(ws + WS_DT))
#define qb ((bf16*)(ws + WS_Q))
#define kb ((bf16*)(ws + WS_K))
#define vb ((bf16*)(ws + WS_V))
#define gates ((bf16*)(ws + WS_GATES))
#define xbcc ((bf16*)(ws + WS_XBCC))
#define yfb ((bf16*)args.out)
#define ybb ((bf16*)(ws + WS_YB))
#define pm ((bf16*)(ws + WS_PM))
#define r1 ((float*)(ws + WS_R1))
#define st1 ((float*)(ws + WS_ST1))
#define h2 ((bf16*)(ws + WS_H2))
#define edgeb ((float*)(ws + WS_EDGE))
#define act ((bf16*)(ws + WS_ACT))

    if (IN(0)) { MKCTX();
        P0Args A{args.in[1], args.in[2], args.in[3], mod, ropetab, args.in[4], args.in[15], args.in[13], args.in[14], args.in[17], args.in[20], args.in[23], Wcat, Wssm, Watt, Wout, Wup, Wdn};
        phase_prologue(X, A);
    }
    SEAM(0);
    if (IN(2)) { MKCTX(); phase_h(X, x_in, mod, hbuf); }
    SEAM(2);
    if (IN(3)) { MKCTX();
        pg8::Gemm g{hbuf, Wcat, MTOK, CAT_COLS, D_MODEL}; pg8::StaticOrder S; S.init(MTOK, CAT_COLS, X.G, (int)blockIdx.x);
        pg8::EpiIn E{zbuf, xbcc, qb, kb, vb, gates, dtb, args.in[8], args.in[16], args.in[5], args.in[6], edge1};
        pg8::gemm_phase<pg8::EpiIn, pg8::StaticOrder, true, true>(X.lds, g, S, E, X.tid);
    }
    if (IN(3)) { MKCTX();
        { const int nwg = (MTOK / 256) * (CAT_COLS / 256), first = nwg % X.G; if (first) tail_transposes_mix(X, first, args.in[13], args.in[14], args.in[17], Wssm, Watt, Wout); else tail_transposes_mix(X, 0, args.in[13], args.in[14], args.in[17], Wssm, Watt, Wout); }
    }
    SEAM(3);
    if (IN(4)) { MKCTX();
        phase_xbc_fixup(X, edge1, args.in[5], args.in[6], xbcc);
        qk_norm_rope_rows(X, kb, AT_HKV, args.in[12], ropetab);
    }
    SEAM(4);
    if (IN(5)) { MKCTX();
        const bool xcd_map = (X.G == 256);
        const int up_pos = ((int)blockIdx.x & 7) % 5; int slot = 0;
        for (int u = blockIdx.x; u < BATCH * SSM_H * 2; u += X.G, ++slot) {
            if (slot == up_pos) { __syncthreads(); transposes_up_share(X, args.in[20], Wup); __syncthreads(); }
            int unit = u;
            if (xcd_map) { const int c = blockIdx.x, r = u >> 8, grp = c & 7, j = c >> 3; unit = ((r * SSM_H + grp * 16 + (j & 15)) << 1) | (j >> 4); }
            ssd::ssd_unit((LAS char*)X.lds, unit, xbcc, dtb, args.in[7], args.in[9], (unit & 1) ? ybb : yfb, X.tid);
        }
        if (slot <= up_pos) { __syncthreads(); transposes_up_share(X, args.in[20], Wup); __syncthreads(); }
        {
            auto unit_ptrs = [&](int u, size_t& qoff, size_t& koff, int& qblk) {
                qblk = u % (SEQ / 256); int hh = (u / (SEQ / 256)) % AT_HQ, b = u / ((SEQ / 256) * AT_HQ);
                if (xcd_map) { const int c = blockIdx.x, r = u >> 8, kvh_ = c & 7, j = (c >> 3) + 32 * (r & 1); b = r >> 1; hh = kvh_ * (AT_HQ / AT_HKV) + (j >> 4); qblk = j & 15; }
                const int kvh = hh / (AT_HQ / AT_HKV);
                qoff = ((size_t)b * SEQ + (size_t)qblk * 256) * (AT_HQ * AT_D) + (size_t)hh * AT_D; koff = (size_t)b * SEQ * (AT_HKV * AT_D) + (size_t)kvh * AT_D; };
            const int NU = BATCH * AT_HQ * (SEQ / 256);
            attn::AttnPre P; size_t qoff, koff; int qblk;
            if ((int)blockIdx.x < NU) { unit_ptrs(blockIdx.x, qoff, koff, qblk); attn::attn_prime(P, qb + qoff, kb + koff, vb + koff, X.tid); }
            for (int u = blockIdx.x; u < NU; u += X.G) {
                const bool has_next = u + X.G < NU; size_t qn = qoff, kn = koff; int qbn = qblk;
                if (has_next) unit_ptrs(u + X.G, qn, kn, qbn);
                attn::attn_dense_body(P, kb + koff, vb + koff, qb + qoff, SEQ, (char*)lds, args.in[11], ropetab, qblk * 256, X.tid, qb + qn, kb + kn, vb + kn, has_next);
                qoff = qn; koff = kn; qblk = qbn;
            }
        }
        __syncthreads();
    }
    SEAM(5);
    if (IN(6)) { MKCTX(); phase_ssm_combine(X, yfb, ybb, zbuf, args.in[10]); }
    SEAM(6);
    if (IN(7)) { MKCTX();
        pg8::Gemm g{zbuf, Wssm, MTOK, D_MODEL, SSM_DI}; pg8::StaticOrder S; S.init(MTOK, D_MODEL, X.G, (int)blockIdx.x);
        pg8::EpiMix E{gates, pm, 0};
        pg8::gemm_phase<pg8::EpiMix, pg8::StaticOrder, true, true>(X.lds, g, S, E, X.tid);
    }
    if (IN(8)) { MKCTX();
        pg8::Gemm g{qb, Watt, MTOK, D_MODEL, D_MODEL}; pg8::StaticOrder S; S.init(MTOK, D_MODEL, X.G, (int)blockIdx.x);
        pg8::EpiMix E{gates, pm, 1};
        pg8::gemm_phase<pg8::EpiMix, pg8::StaticOrder, true, true>(X.lds, g, S, E, X.tid);
    }
    SEAM(8);
    if (IN(9)) { MKCTX();
        pg8::Gemm g{pm, Wout, MTOK, D_MODEL, D_MODEL}; pg8::StaticOrder S; S.init(MTOK, D_MODEL, X.G, (int)blockIdx.x);
        pg8::EpiRes E{x_in, r1, mod + 2 * D_MODEL, DN_ALPHA};
        pg8::gemm_phase<pg8::EpiRes, pg8::StaticOrder, true, true>(X.lds, g, S, E, X.tid);
    }
    SEAM(9);
    if (IN(10)) { MKCTX(); phase_ln1(X, r1, args.in[18], args.in[19], mod, st1, h2); }
    SEAM(10);
    if (IN(11)) { MKCTX();
        pg8::Gemm g{h2, Wup, MTOK, FFN2, D_MODEL}; pg8::StaticOrder S; S.init(MTOK, FFN2, X.G, (int)blockIdx.x);
        pg8::EpiConvGate E{act, edgeb, args.in[21], args.in[22]};
        pg8::gemm_phase<pg8::EpiConvGate, pg8::StaticOrder, true, true>(X.lds, g, S, E, X.tid);
    }
    if (IN(11)) { MKCTX();
        { const int nwg = (MTOK / 256) * (FFN2 / 256), first = nwg % X.G; tail_transposes_down(X, first, args.in[23], Wdn); }
    }
    SEAM(11);
    if (IN(12)) { MKCTX(); phase_conv_fixup(X, edgeb, args.in[21], args.in[22], act); }
    SEAM(12);
    if (IN(13)) { MKCTX();
        pg8::Gemm g{act, Wdn, MTOK, D_MODEL, FFN}; pg8::StaticOrder S; S.init(MTOK, D_MODEL, X.G, (int)blockIdx.x);
        pg8::EpiResLn E{r1, st1, args.in[18], args.in[19], args.out, mod + 5 * D_MODEL, DN_ALPHA};
        pg8::gemm_phase<pg8::EpiResLn, pg8::StaticOrder, true, true>(X.lds, g, S, E, X.tid);
    }
    SEAM(13);
    if (IN(14)) { MKCTX(); phase_ln_final(X, args.out, args.in[24], args.in[25]); }
#undef IN
#undef SEAM
#undef MKCTX
#undef TIDX
#undef x_in
#undef mod
#undef ropetab
#undef Wcat
#undef Wssm
#undef Watt
#undef Wout
#undef Wup
#undef Wdn
#undef hbuf
#undef zbuf
#undef edge1
#undef dtb
#undef qb
#undef kb
#undef vb
#undef gates
#undef xbcc
#undef yfb
#undef ybb
#undef pm
#undef r1
#undef st1
#undef h2
#undef edgeb
#undef act
}

extern "C" void kernel_launch(void* const* d_in, const int* in_sizes, int n_in, void* d_out, int out_size, void* d_ws, size_t ws_size, hipStream_t stream) {
    static int grid = 0;
    if (grid == 0) {
        if (n_in != 26 || in_sizes[0] != MTOK * D_MODEL || out_size != MTOK * D_MODEL || ws_size < WS_END) {
            fprintf(stderr, "kernel_launch: shape mismatch (n_in %d in0 %d out %d ws %zu need %zu); nothing launched\n", n_in, n_in > 0 ? in_sizes[0] : -1, out_size, ws_size, (size_t)WS_END); grid = -1; return; }
        int dev = 0, cus = 0, per_cu = 0;
        if (hipGetDevice(&dev) != hipSuccess || hipDeviceGetAttribute(&cus, hipDeviceAttributeMultiprocessorCount, dev) != hipSuccess) { grid = -1; return; }
        if (hipFuncSetAttribute((const void*)mk_fwd, hipFuncAttributeMaxDynamicSharedMemorySize, LDS_BYTES) != hipSuccess) { fprintf(stderr, "kernel_launch: hipFuncSetAttribute failed\n"); grid = -1; return; }
        if (hipOccupancyMaxActiveBlocksPerMultiprocessor(&per_cu, (const void*)mk_fwd, NWAVES * 64, LDS_BYTES) != hipSuccess || per_cu < 1) { fprintf(stderr, "kernel_launch: occupancy query says %d blocks per CU\n", per_cu); }
        (void)hipGetLastError();
        grid = cus;
    }
    if (grid < 0) return;
    if (hipMemsetAsync((char*)d_ws + WS_CTL, 0, CTL_ZERO_BYTES, stream) != hipSuccess) return;
    Args a{};
    for (int i = 0; i < 26; ++i) a.in[i] = (const float*)d_in[i];
    a.out = (float*)d_out; a.ws = (unsigned char*)d_ws; a.ph_lo = 0; a.ph_hi = N_PHASES;
    hipLaunchKernelGGL(mk_fwd, dim3(grid), dim3(NWAVES * 64), LDS_BYTES, stream, a);
    const hipError_t le = hipPeekAtLastError();
    if (le != hipSuccess) fprintf(stderr, "kernel_launch: launch failed: %s\n", hipGetErrorName(le));
}
```

```cpp
#include <hip/hip_runtime.h>
#include <cstdio>
#include <cstdint>

#define GAS __attribute__((address_space(1)))
#define LAS __attribute__((address_space(3)))
typedef unsigned short bf16;
typedef unsigned v4u __attribute__((ext_vector_type(4)));
typedef unsigned v2u __attribute__((ext_vector_type(2)));
typedef float v4f __attribute__((ext_vector_type(4)));

constexpr int D_MODEL = 4096, BATCH = 4, SEQ = 4096, MTOK = BATCH * SEQ;
constexpr int GRID_W = 64;
constexpr int SSM_DI = 8192, SSM_HD = 64, SSM_H = 128, SSM_G = 8, SSM_N = 128, SSM_CONVD = 10240;
constexpr int AT_D = 128, AT_HQ = 32, AT_HKV = 8;
constexpr int FFN = 11008, FFN2 = 22016;
constexpr int IN_COLS = 24832, CAT_COLS = IN_COLS + 2 * D_MODEL;
constexpr float LN_EPS = 1e-5f, RMS_EPS = 1e-6f;
constexpr float DN_ALPHA = 1.189207115002721f;
constexpr int MOD_LD = 6 * D_MODEL;

__device__ __forceinline__ float bf2f(unsigned b) { return __uint_as_float(b << 16); }
__device__ __forceinline__ float bflo(unsigned w) { return __uint_as_float(w << 16); }
__device__ __forceinline__ float bfhi(unsigned w) { return __uint_as_float(w & 0xffff0000u); }
__device__ __forceinline__ unsigned pkbf(float lo, float hi) { unsigned r; asm volatile("v_cvt_pk_bf16_f32 %0, %1, %2" : "=v"(r) : "v"(lo), "v"(hi)); return r; }
__device__ __forceinline__ float sigmoidf_(float v) { return __builtin_amdgcn_rcpf(1.0f + __expf(-v)); }
__device__ __forceinline__ float siluf_(float v) { return v * __builtin_amdgcn_rcpf(1.0f + __expf(-v)); }
__device__ __forceinline__ float softplusf_(float v) { return v > 20.f ? v : log1pf(__expf(v)); }
__device__ __forceinline__ float wave_sum(float v) {
#pragma unroll
    for (int o = 1; o < 64; o <<= 1) v += __shfl_xor(v, o);
    return v;
}
__device__ __forceinline__ int lane_id_now() { int l; asm volatile("v_mbcnt_lo_u32_b32 %0, -1, 0\n\tv_mbcnt_hi_u32_b32 %0, -1, %0" : "=v"(l)); return l; }
namespace pg8 {
#define PG8_LAS __attribute__((address_space(3)))
typedef unsigned short bf16_t;
typedef short bf16x8 __attribute__((ext_vector_type(8)));
typedef float f32x4 __attribute__((ext_vector_type(4)));
typedef unsigned u32x4 __attribute__((ext_vector_type(4)));
constexpr int BM = 256, BK = 64, HALF = 128, HTB = HALF * BK * 2  , STAGE_BYTES = 8 * HTB, NXCD = 8, WGM = 8;

__host__ __device__ __forceinline__ int lds_byte(int r, int c) { const int st = (r >> 4) * 2 + (c >> 5), rr = r & 15, cc = c & 31, ob = rr * 64 + cc * 2; return st * 1024 + (ob ^ (((ob >> 9) & 1) << 5)); }
__host__ __device__ __forceinline__ void stage_rc(int b, int& R, int& C) { const int st = b / 1024, sb = b % 1024, swz = sb ^ (((sb >> 9) & 1) << 5); R = (st >> 1) * 16 + swz / 64; C = (st & 1) * 32 + (swz % 64) / 2; }
__host__ __device__ __forceinline__ int perm32(int rho) { const int n = rho >> 4, i = rho & 15; return 8 * (i >> 2) + 4 * n + (i & 3); }

struct Unit { int pm, pn; };
struct Gemm { const bf16_t* A; const bf16_t* Bt; int M, N, K; };

struct StaticOrder {
    int nM, nN, nwg, G, c;
    __host__ __device__ void init(int M, int N, int G_, int c_) { nM = M / BM; nN = N / BM; nwg = nM * nN; G = G_; c = c_; }
    __host__ __device__ bool next(int i, Unit& u) const {
        const long L = (long)i * G + c; if (L >= nwg) return false;
        int wgid = (int)L; { const int q = nwg / NXCD, r = nwg % NXCD, xcd = wgid % NXCD, off = wgid / NXCD; wgid = (xcd < r ? xcd * (q + 1) : r * (q + 1) + (xcd - r) * q) + off; }
        const int nig = WGM * nN, gid = wgid / nig, fm = gid * WGM, gsz = (nM - fm) < WGM ? (nM - fm) : WGM;
        u.pm = fm + ((wgid % nig) % gsz); u.pn = (wgid % nig) / gsz; return true;
    }
    __device__ __forceinline__ void a_ready(const Unit&) const {}
    __device__ __forceinline__ void done(const Unit&) const {}
};

__device__ __forceinline__ unsigned cvt_pk_bf16(float lo, float hi) { unsigned r; asm volatile("v_cvt_pk_bf16_f32 %0, %1, %2" : "=v"(r) : "v"(lo), "v"(hi)); return r; }
typedef float f32x2 __attribute__((ext_vector_type(2)));
__device__ __forceinline__ void st8bf(bf16_t* p, const f32x4& v0, const f32x4& v1) {
    u32x4 w; w.x = cvt_pk_bf16(v0[0], v0[1]); w.y = cvt_pk_bf16(v0[2], v0[3]); w.z = cvt_pk_bf16(v1[0], v1[1]); w.w = cvt_pk_bf16(v1[2], v1[3]);
    *(u32x4*)p = w;
}
__device__ __forceinline__ void ld8bf(const bf16_t* p, f32x4& v0, f32x4& v1) {
    const u32x4 w = *(const u32x4*)p;
    v0 = (f32x4){__uint_as_float(w.x << 16), __uint_as_float(w.x & 0xffff0000u), __uint_as_float(w.y << 16), __uint_as_float(w.y & 0xffff0000u)};
    v1 = (f32x4){__uint_as_float(w.z << 16), __uint_as_float(w.z & 0xffff0000u), __uint_as_float(w.w << 16), __uint_as_float(w.w & 0xffff0000u)};
}
__device__ __forceinline__ float epi_sigmoid(float v) { return __builtin_amdgcn_rcpf(1.0f + __expf(-v)); }
__device__ __forceinline__ float epi_softplus(float v) { return v > 20.f ? v : log1pf(__expf(v)); }

__device__ __forceinline__ float dpp_prev(float v) { return __uint_as_float((unsigned)__builtin_amdgcn_update_dpp(0, (int)__float_as_uint(v), 0x111, 0xF, 0xF, true)); }
__device__ __forceinline__ float dpp_next(float v) { return __uint_as_float((unsigned)__builtin_amdgcn_update_dpp(0, (int)__float_as_uint(v), 0x101, 0xF, 0xF, true)); }
__device__ __forceinline__ f32x4 dpp_prev4(const f32x4& v) { return (f32x4){dpp_prev(v[0]), dpp_prev(v[1]), dpp_prev(v[2]), dpp_prev(v[3])}; }
__device__ __forceinline__ f32x4 dpp_next4(const f32x4& v) { return (f32x4){dpp_next(v[0]), dpp_next(v[1]), dpp_next(v[2]), dpp_next(v[3])}; }
struct EpiIn {
    static constexpr bool PERM = true, AFTER_DRAIN = false, APERM = true;
    bf16_t *z, *xbc, *q, *k, *v, *gates; float* dt; const float* dt_bias; const float* b_gate; const float* cw; const float* cb; float* edge;
    __device__ __forceinline__ void operator()(const f32x4 (&acc)[2][2][4][2], const Unit& u, int wr, int wc, int fr, int fq) const {
        const int pn = u.pn, row0 = u.pm * BM + wr * 128 + fr * 8, cw_ = wc * 32 + 8 * fq;
        if (pn == 72) {
#pragma unroll
            for (int bj = 0; bj < 2; ++bj) { const int col = cw_ + bj * HALF; const f32x4 b0 = *(const f32x4*)(dt_bias + col), b1 = *(const f32x4*)(dt_bias + col + 4);
#pragma unroll
                for (int ai = 0; ai < 2; ++ai)
#pragma unroll
                    for (int m = 0; m < 4; ++m) { f32x4 v0 = acc[ai][bj][m][0] + b0, v1 = acc[ai][bj][m][1] + b1;
#pragma unroll
                        for (int j = 0; j < 4; ++j) { v0[j] = epi_softplus(v0[j]); v1[j] = epi_softplus(v1[j]); }
                        float* p = dt + (size_t)(row0 + ai * 4 + m) * 256 + col; *(f32x4*)p = v0; *(f32x4*)(p + 4) = v1; } }
            return;
        }
        if (pn >= 32 && pn < 72) {
            const int seg = 2 * u.pm + wr;
#pragma unroll
            for (int bj = 0; bj < 2; ++bj)
#pragma unroll
                for (int n = 0; n < 2; ++n) {
                    const int ch = (pn - 32) * 256 + bj * HALF + cw_ + 4 * n;
                    const f32x4 w0 = *(const f32x4*)(cw + ch), w1 = *(const f32x4*)(cw + 10240 + ch), w2 = *(const f32x4*)(cw + 2 * 10240 + ch), bb = *(const f32x4*)(cb + ch);
#pragma unroll
                    for (int kk = 0; kk < 8; ++kk) {
                        const f32x4 um = (kk == 0) ? dpp_prev4(acc[1][bj][3][n]) : acc[(kk - 1) >> 2][bj][(kk - 1) & 3][n], up = (kk == 7) ? dpp_next4(acc[0][bj][0][n]) : acc[(kk + 1) >> 2][bj][(kk + 1) & 3][n];
                        const f32x4 c4 = um * w0 + acc[kk >> 2][bj][kk & 3][n] * w1 + up * w2 + bb;
                        typedef unsigned u32x2_ __attribute__((ext_vector_type(2)));
                        u32x2_ w; w.x = cvt_pk_bf16(c4[0] * epi_sigmoid(c4[0]), c4[1] * epi_sigmoid(c4[1])); w.y = cvt_pk_bf16(c4[2] * epi_sigmoid(c4[2]), c4[3] * epi_sigmoid(c4[3]));
                        *(u32x2_*)(xbc + (size_t)(row0 + kk) * 10240 + ch) = w;
                    }
                    if (fr == 0) { float* ep = edge + ((size_t)seg * 4 + 0) * 10240 + ch; *(f32x4*)ep = acc[0][bj][0][n]; *(f32x4*)(ep + 10240) = acc[0][bj][1][n]; }
                    if (fr == 15) { float* ep = edge + ((size_t)seg * 4 + 2) * 10240 + ch; *(f32x4*)ep = acc[1][bj][2][n]; *(f32x4*)(ep + 10240) = acc[1][bj][3][n]; }
                    asm volatile("" ::: "memory");
                }
            return;
        }
        bf16_t* base; int ldc, colt, mode = 0;
        if (pn < 32) { base = z; ldc = 8192; colt = pn * 256; }
        else if (pn < 89) { base = q; ldc = 4096; colt = (pn - 73) * 256; }
        else if (pn < 93) { base = k; ldc = 1024; colt = (pn - 89) * 256; }
        else if (pn < 97) { base = v; ldc = 1024; colt = (pn - 93) * 256; }
        else { base = gates; ldc = 8192; colt = (pn - 97) * 256; mode = 2; }
        f32x4 bv[2][2];
#pragma unroll
        for (int bj = 0; bj < 2; ++bj)
#pragma unroll
            for (int n = 0; n < 2; ++n) bv[bj][n] = (mode == 2) ? *(const f32x4*)(b_gate + colt + cw_ + bj * HALF + 4 * n) : (f32x4){0.f, 0.f, 0.f, 0.f};
#pragma unroll
        for (int ai = 0; ai < 2; ++ai)
#pragma unroll
            for (int m = 0; m < 4; ++m) { bf16_t* rowp = base + (size_t)(row0 + ai * 4 + m) * ldc + colt + cw_;
#pragma unroll
                for (int bj = 0; bj < 2; ++bj) { f32x4 v0 = acc[ai][bj][m][0] + bv[bj][0], v1 = acc[ai][bj][m][1] + bv[bj][1];
                    st8bf(rowp + bj * HALF, v0, v1); } }
    }
};
struct EpiMix {
    static constexpr bool PERM = true, AFTER_DRAIN = false, APERM = false;
    const bf16_t* gates; bf16_t* pm; int second;
    __device__ __forceinline__ void operator()(const f32x4 (&acc)[2][2][4][2], const Unit& u, int wr, int wc, int fr, int fq) const {
        const int row0 = u.pm * BM + wr * 64 + fr, col0 = u.pn * BM + wc * 32 + 8 * fq;
#pragma unroll
        for (int ai = 0; ai < 2; ++ai)
#pragma unroll
            for (int m = 0; m < 4; ++m) { const size_t row = (size_t)(row0 + ai * HALF + m * 16);
#pragma unroll
                for (int bj = 0; bj < 2; ++bj) { const int col = col0 + bj * HALF; f32x4 g0, g1; ld8bf(gates + row * 8192 + second * 4096 + col, g0, g1);
#pragma unroll
                    for (int j = 0; j < 4; ++j) { g0[j] = epi_sigmoid(g0[j]); g1[j] = epi_sigmoid(g1[j]); }

                    f32x4 v0 = acc[ai][bj][m][0] * g0, v1 = acc[ai][bj][m][1] * g1;
                    if (second) { f32x4 p0, p1; ld8bf(pm + row * 4096 + col, p0, p1); v0 += p0; v1 += p1; }
                    st8bf(pm + row * 4096 + col, v0, v1); } }
    }
};
struct EpiRes {
    static constexpr bool PERM = true, AFTER_DRAIN = false, APERM = false;
    const float* base; float* out; const float* gate; float alpha;
    __device__ __forceinline__ void operator()(const f32x4 (&acc)[2][2][4][2], const Unit& u, int wr, int wc, int fr, int fq) const {
        const int row0 = u.pm * BM + wr * 64 + fr, col0 = u.pn * BM + wc * 32 + 8 * fq;
        const float* g = gate + (size_t)(u.pm >> 4) * 24576;
#pragma unroll
        for (int bj = 0; bj < 2; ++bj) { const int col = col0 + bj * HALF; const f32x4 g0 = *(const f32x4*)(g + col), g1 = *(const f32x4*)(g + col + 4);
#pragma unroll
            for (int ai = 0; ai < 2; ++ai)
#pragma unroll
                for (int m = 0; m < 4; ++m) { const size_t off = (size_t)(row0 + ai * HALF + m * 16) * 4096 + col;
                    const f32x4 x0 = *(const f32x4*)(base + off), x1 = *(const f32x4*)(base + off + 4);
                    *(f32x4*)(out + off) = x0 * alpha + g0 * acc[ai][bj][m][0]; *(f32x4*)(out + off + 4) = x1 * alpha + g1 * acc[ai][bj][m][1]; } }
    }
};
struct EpiConvGate {
    static constexpr bool PERM = true, AFTER_DRAIN = false, APERM = true;
    bf16_t* act; float* edge; const float* cw; const float* cb;
    __device__ __forceinline__ void operator()(const f32x4 (&acc)[2][2][4][2], const Unit& u, int wr, int wc, int fr, int fq) const {
        const int tok0 = u.pm * BM + wr * 128 + fr * 8, seg = 2 * u.pm + wr;
#pragma unroll
        for (int n = 0; n < 2; ++n) {
            const int ch = u.pn * 128 + wc * 32 + 8 * fq + 4 * n;
            const f32x4 wa0 = *(const f32x4*)(cw + ch), wa1 = *(const f32x4*)(cw + 22016 + ch), wa2 = *(const f32x4*)(cw + 2 * 22016 + ch), ba = *(const f32x4*)(cb + ch);
            const f32x4 wb0 = *(const f32x4*)(cw + 11008 + ch), wb1 = *(const f32x4*)(cw + 22016 + 11008 + ch), wb2 = *(const f32x4*)(cw + 2 * 22016 + 11008 + ch), bb = *(const f32x4*)(cb + 11008 + ch);
#pragma unroll
            for (int k = 0; k < 8; ++k) {
                const f32x4 ua_m = (k == 0) ? dpp_prev4(acc[1][0][3][n]) : acc[(k - 1) >> 2][0][(k - 1) & 3][n], ua_p = (k == 7) ? dpp_next4(acc[0][0][0][n]) : acc[(k + 1) >> 2][0][(k + 1) & 3][n];
                const f32x4 ub_m = (k == 0) ? dpp_prev4(acc[1][1][3][n]) : acc[(k - 1) >> 2][1][(k - 1) & 3][n], ub_p = (k == 7) ? dpp_next4(acc[0][1][0][n]) : acc[(k + 1) >> 2][1][(k + 1) & 3][n];
                const f32x4 ca = ua_m * wa0 + acc[k >> 2][0][k & 3][n] * wa1 + ua_p * wa2 + ba;
                const f32x4 cb_ = ub_m * wb0 + acc[k >> 2][1][k & 3][n] * wb1 + ub_p * wb2 + bb;
                f32x4 o;
#pragma unroll
                for (int j = 0; j < 4; ++j) o[j] = ca[j] * epi_sigmoid(ca[j]) * cb_[j];
                typedef unsigned u32x2_ __attribute__((ext_vector_type(2)));
                u32x2_ w; w.x = cvt_pk_bf16(o[0], o[1]); w.y = cvt_pk_bf16(o[2], o[3]);
                *(u32x2_*)(act + (size_t)(tok0 + k) * 11008 + ch) = w;
            }
            const int tc = u.pn * 256 + wc * 32 + 8 * fq + 4 * n;
            if (fr == 0) { float* ep = edge + ((size_t)seg * 4 + 0) * 22016 + tc;
                *(f32x4*)ep = acc[0][0][0][n]; *(f32x4*)(ep + 128) = acc[0][1][0][n]; *(f32x4*)(ep + 22016) = acc[0][0][1][n]; *(f32x4*)(ep + 22016 + 128) = acc[0][1][1][n]; }
            if (fr == 15) { float* ep = edge + ((size_t)seg * 4 + 2) * 22016 + tc;
                *(f32x4*)ep = acc[1][0][2][n]; *(f32x4*)(ep + 128) = acc[1][1][2][n]; *(f32x4*)(ep + 22016) = acc[1][0][3][n]; *(f32x4*)(ep + 22016 + 128) = acc[1][1][3][n]; }
            asm volatile("" ::: "memory");
        }
    }
};
struct EpiResLn {
    static constexpr bool PERM = true, AFTER_DRAIN = false, APERM = false;
    const float* r1; const float* stats; const float* ln_g; const float* ln_b; float* out; const float* gate; float alpha;
    __device__ __forceinline__ void operator()(const f32x4 (&acc)[2][2][4][2], const Unit& u, int wr, int wc, int fr, int fq) const {
        typedef float f2_ __attribute__((ext_vector_type(2)));
        const int row0 = u.pm * BM + wr * 64 + fr, col0 = u.pn * BM + wc * 32 + 8 * fq;
        const float* g = gate + (size_t)(u.pm >> 4) * 24576;
#pragma unroll
        for (int bj = 0; bj < 2; ++bj) { const int col = col0 + bj * HALF; const f32x4 g0 = *(const f32x4*)(g + col), g1 = *(const f32x4*)(g + col + 4);
            const f32x4 a0 = *(const f32x4*)(ln_g + col) * alpha, a1 = *(const f32x4*)(ln_g + col + 4) * alpha, b0 = *(const f32x4*)(ln_b + col) * alpha, b1 = *(const f32x4*)(ln_b + col + 4) * alpha;
#pragma unroll
            for (int ai = 0; ai < 2; ++ai)
#pragma unroll
                for (int m = 0; m < 4; ++m) { const size_t row = (size_t)(row0 + ai * HALF + m * 16), off = row * 4096 + col; const f2_ st = *(const f2_*)(stats + 2 * row); const float mean = st.x, rstd = st.y;
                    const f32x4 x0 = (*(const f32x4*)(r1 + off) - mean) * rstd, x1 = (*(const f32x4*)(r1 + off + 4) - mean) * rstd;
                    *(f32x4*)(out + off) = x0 * a0 + b0 + g0 * acc[ai][bj][m][0]; *(f32x4*)(out + off + 4) = x1 * a1 + b1 + g1 * acc[ai][bj][m][1]; } }
    }
};
template <class Epi, class Sched, bool ALIGN_EPI = false, bool SP2 = false>
__device__ __forceinline__ void gemm_phase(PG8_LAS unsigned char* lds, const Gemm g, const Sched& S, const Epi& E, int tid_in) {
    int tid_l = tid_in; asm volatile("" : "+v"(tid_l));
    const int tid = tid_l, wid = __builtin_amdgcn_readfirstlane(tid >> 6), lane = tid & 63, wr = wid >> 2, wc = wid & 3, fr = lane & 15, fq = lane >> 4;
    const int K = g.K, nt = K / BK;
    unsigned voffA[2], voffB[2];
#pragma unroll
    for (int i = 0; i < 2; ++i) { int R, C; stage_rc(tid * 16 + i * 8192, R, C); const int Rb = Epi::PERM ? ((R & ~31) + perm32(R & 31)) : R;
        const int Ra = Epi::APERM ? (128 * (R >> 6) + 8 * (R & 15) + ((R >> 4) & 3)) : R;
        voffA[i] = (unsigned)(Ra * K + C) * 2u; voffB[i] = (unsigned)(Rb * K + C) * 2u; }
    const size_t kstep = (size_t)(BK * 2);
    const size_t hstep = (size_t)HALF * K * 2;
    const size_t tstep = 2 * hstep;
    const size_t hstepA = Epi::APERM ? (size_t)4 * K * 2 : hstep;
    const unsigned ldsw = (unsigned)wid * 1024u;
    const int aoff = lds_byte(wr * 64 + fr, fq * 8), boff = lds_byte(wc * 32 + fr, fq * 8);
#define PG8_SA(b, h) (((b) * 2 + (h)) * HTB)
#define PG8_SB(b, h) ((4 + (b) * 2 + (h)) * HTB)
#define PG8_STAGE(bufoff, gbase, voff) do { _Pragma("unroll") for (int _i = 0; _i < 2; ++_i) \
        __builtin_amdgcn_global_load_lds((const unsigned*)((const char*)(gbase) + (voff)[_i]), (PG8_LAS unsigned*)(lds + (bufoff) + ldsw + _i * 8192), 16, 0, 0); } while (0)
#define PG8_LDA(dst, b, h) do { _Pragma("unroll") for (int m = 0; m < 4; ++m) _Pragma("unroll") for (int k = 0; k < 2; ++k) dst[m][k] = *(const PG8_LAS bf16x8*)(lds + PG8_SA(b, h) + aoff + m * 2048 + k * 1024); } while (0)
#define PG8_LDB(dst, b, h) do { _Pragma("unroll") for (int n = 0; n < 2; ++n) _Pragma("unroll") for (int k = 0; k < 2; ++k) dst[n][k] = *(const PG8_LAS bf16x8*)(lds + PG8_SB(b, h) + boff + n * 2048 + k * 1024); } while (0)
#define PG8_MMA(ai, bj, At, Bt) do { __builtin_amdgcn_s_setprio(1); _Pragma("unroll") for (int n = 0; n < 2; ++n) _Pragma("unroll") for (int m = 0; m < 4; ++m) { _Pragma("unroll") for (int kk = 0; kk < 2; ++kk) { const int k = kk ^ (m & 1);   \
        acc[ai][bj][m][n] = __builtin_amdgcn_mfma_f32_16x16x32_bf16(Bt[n][k], At[m][k], acc[ai][bj][m][n], 0, 0, 0); } __builtin_amdgcn_sched_barrier(0); } __builtin_amdgcn_s_setprio(0); } while (0)
#define PG8_WAIT_V(n) asm volatile("s_waitcnt vmcnt(" #n ")" ::: "memory")
#define PG8_WAIT_L(n) asm volatile("s_waitcnt lgkmcnt(" #n ")" ::: "memory")
#define PG8_BAR __builtin_amdgcn_s_barrier()
#define PG8_SCHED __builtin_amdgcn_sched_barrier(0)
    Unit cur, nxt; int ui = 0;
    if (!S.next(0, cur)) return;
    f32x4 acc[2][2][4][2];
#pragma unroll
    for (int a = 0; a < 2; ++a)
#pragma unroll
        for (int b = 0; b < 2; ++b)
#pragma unroll
            for (int m = 0; m < 4; ++m)
#pragma unroll
                for (int n = 0; n < 2; ++n) acc[a][b][m][n] = (f32x4){0.f, 0.f, 0.f, 0.f};
    bf16x8 At[4][2], B0[2][2], B1[2][2];
    const char* cA = (const char*)g.A + (size_t)cur.pm * tstep; const char* cB = (const char*)g.Bt + (size_t)cur.pn * tstep;
    S.a_ready(cur);
    if constexpr (SP2) {
        PG8_STAGE(PG8_SB(0, 0), cB, voffB); PG8_STAGE(PG8_SB(0, 1), cB + hstep, voffB); PG8_STAGE(PG8_SA(0, 0), cA, voffA); PG8_STAGE(PG8_SA(0, 1), cA + hstepA, voffA);
        if (wr == 1) PG8_BAR;
        PG8_WAIT_V(2); PG8_BAR;
        PG8_STAGE(PG8_SB(1, 0), cB + kstep, voffB); PG8_STAGE(PG8_SA(1, 0), cA + kstep, voffA); PG8_STAGE(PG8_SB(1, 1), cB + hstep + kstep, voffB);
        PG8_WAIT_V(6); PG8_BAR;
    } else {
        PG8_STAGE(PG8_SB(0, 0), cB, voffB); PG8_STAGE(PG8_SA(0, 0), cA, voffA); PG8_STAGE(PG8_SB(0, 1), cB + hstep, voffB); PG8_STAGE(PG8_SA(0, 1), cA + hstepA, voffA);
        if (wr == 1) PG8_BAR;
        PG8_WAIT_V(4); PG8_BAR;
        PG8_STAGE(PG8_SB(1, 0), cB + kstep, voffB); PG8_STAGE(PG8_SA(1, 0), cA + kstep, voffA); PG8_STAGE(PG8_SB(1, 1), cB + hstep + kstep, voffB);
        PG8_WAIT_V(6); PG8_BAR;
    }
    for (;;) {
        const bool has_next = S.next(ui + 1, nxt);
        const char* nA = has_next ? (const char*)g.A + (size_t)nxt.pm * tstep : cA; const char* nB = has_next ? (const char*)g.Bt + (size_t)nxt.pn * tstep : cB;
        for (int t = 0; t < nt; t += 2) {
            const bool last = (t == nt - 2);
            const char* a1 = cA + (size_t)(t + 1) * kstep;
            const char* a2 = last ? nA : cA + (size_t)(t + 2) * kstep; const char* b2 = last ? nB : cB + (size_t)(t + 2) * kstep;
            const char* a3 = a2 + kstep; const char* b3 = b2 + kstep;
            if (last && has_next) S.a_ready(nxt);
            if constexpr (SP2) {
            PG8_LDB(B0, 0, 0); PG8_LDB(B1, 0, 1); PG8_SCHED; PG8_LDA(At, 0, 0); PG8_STAGE(PG8_SA(1, 1), a1 + hstepA, voffA);
            PG8_WAIT_V(8); PG8_WAIT_L(0); PG8_BAR; PG8_MMA(0, 0, At, B0); PG8_MMA(0, 1, At, B1); PG8_BAR; PG8_SCHED;
            PG8_LDA(At, 0, 1); PG8_STAGE(PG8_SB(0, 0), b2, voffB); PG8_STAGE(PG8_SB(0, 1), b2 + hstep, voffB); PG8_STAGE(PG8_SA(0, 0), a2, voffA);
            PG8_WAIT_V(8); PG8_WAIT_L(0); PG8_BAR; PG8_MMA(1, 0, At, B0); PG8_MMA(1, 1, At, B1); PG8_BAR; PG8_SCHED;
            PG8_LDB(B0, 1, 0); PG8_LDB(B1, 1, 1); PG8_SCHED; PG8_LDA(At, 1, 0); PG8_STAGE(PG8_SA(0, 1), a2 + hstepA, voffA);
            PG8_WAIT_V(8); PG8_WAIT_L(0); PG8_BAR; PG8_MMA(0, 0, At, B0); PG8_MMA(0, 1, At, B1); PG8_BAR; PG8_SCHED;
            PG8_LDA(At, 1, 1); PG8_STAGE(PG8_SB(1, 0), b3, voffB); PG8_STAGE(PG8_SB(1, 1), b3 + hstep, voffB); PG8_STAGE(PG8_SA(1, 0), a3, voffA);
            PG8_WAIT_V(8); PG8_WAIT_L(0); PG8_BAR; PG8_MMA(1, 0, At, B0); PG8_MMA(1, 1, At, B1); PG8_BAR; PG8_SCHED;
            } else {
            PG8_LDB(B0, 0, 0); PG8_SCHED; PG8_LDA(At, 0, 0); PG8_STAGE(PG8_SA(1, 1), a1 + hstepA, voffA);
            PG8_WAIT_L(8); PG8_BAR; PG8_WAIT_L(0); PG8_MMA(0, 0, At, B0); PG8_BAR; PG8_SCHED;
            PG8_LDB(B1, 0, 1); PG8_STAGE(PG8_SB(0, 0), b2, voffB);
            PG8_BAR; PG8_WAIT_L(0); PG8_MMA(0, 1, At, B1); PG8_BAR;
            PG8_LDA(At, 0, 1); PG8_STAGE(PG8_SA(0, 0), a2, voffA);
            PG8_BAR; PG8_WAIT_L(0); PG8_MMA(1, 0, At, B0); PG8_BAR; PG8_SCHED;
            PG8_STAGE(PG8_SB(0, 1), b2 + hstep, voffB);
            PG8_WAIT_V(6); PG8_BAR; PG8_MMA(1, 1, At, B1); PG8_BAR;
            PG8_LDB(B0, 1, 0); PG8_SCHED; PG8_LDA(At, 1, 0); PG8_STAGE(PG8_SA(0, 1), a2 + hstepA, voffA);
            PG8_WAIT_L(8); PG8_BAR; PG8_WAIT_L(0); PG8_MMA(0, 0, At, B0); PG8_BAR; PG8_SCHED;
            PG8_LDB(B1, 1, 1); PG8_STAGE(PG8_SB(1, 0), b3, voffB);
            PG8_BAR; PG8_WAIT_L(0); PG8_MMA(0, 1, At, B1); PG8_BAR;
            PG8_LDA(At, 1, 1); PG8_STAGE(PG8_SA(1, 0), a3, voffA);
            PG8_BAR; PG8_WAIT_L(0); PG8_MMA(1, 0, At, B0); PG8_BAR; PG8_SCHED;
            PG8_STAGE(PG8_SB(1, 1), b3 + hstep, voffB);
            PG8_WAIT_V(6); PG8_BAR; PG8_MMA(1, 1, At, B1); PG8_BAR;
            }
        }
        if constexpr (ALIGN_EPI) { if (wr == 0) PG8_BAR; }
        if constexpr (!Epi::AFTER_DRAIN) { E(acc, cur, wr, wc, fr, fq); S.done(cur); }
        if (!has_next) break;
#pragma unroll
        for (int a = 0; a < 2; ++a)
#pragma unroll
            for (int b = 0; b < 2; ++b)
#pragma unroll
                for (int m = 0; m < 4; ++m)
#pragma unroll
                    for (int n = 0; n < 2; ++n) acc[a][b][m][n] = (f32x4){0.f, 0.f, 0.f, 0.f};
        cur = nxt; cA = nA; cB = nB; ++ui;
        if constexpr (ALIGN_EPI) { if (wr == 1) PG8_BAR; }
    }
    PG8_WAIT_V(0);
    if constexpr (!ALIGN_EPI) { if (wr == 0) PG8_BAR; }
    PG8_BAR;
    if constexpr (Epi::AFTER_DRAIN) { E.fused(acc, cur, wr, wc, fr, fq, lds, wid, lane); S.done(cur); }
#undef PG8_SA
#undef PG8_SB
#undef PG8_STAGE
#undef PG8_LDA
#undef PG8_LDB
#undef PG8_MMA
#undef PG8_WAIT_V
#undef PG8_WAIT_L
#undef PG8_BAR
#undef PG8_SCHED
}
}
namespace attn {
constexpr int D = 128, NW = 8, QBLK = 32, KVBLK = 64;
constexpr float SCALE = 0.088388347648318440f;
constexpr float THR = 8.f;
constexpr int SDEPTH = 2;
constexpr int LDQ = AT_HQ * D, LDK = AT_HKV * D, LDO = LDQ;
constexpr size_t SHM_V = KVBLK * D * 2, SHM_K = KVBLK * D * 2, SHM_ATTN = 2 * SHM_V + 2 * SHM_K + NW * 64 * 4;
using bf16x8 = __attribute__((ext_vector_type(8))) short;
using s16x4  = __attribute__((ext_vector_type(4))) short;
using f32x16 = __attribute__((ext_vector_type(16))) float;
using u32x4  = __attribute__((ext_vector_type(4))) unsigned;
#define KSWZ(row, colB) ((row) * 256 + ((colB) ^ (((row) & 7) << 4)))
#define SBAR() __builtin_amdgcn_sched_barrier(0)
__device__ __forceinline__ int crow(int r, int hi) { return (r & 3) + 8 * (r >> 2) + 4 * hi; }
__device__ __forceinline__ unsigned cvtpk(float lo, float hi) { unsigned r; asm volatile("v_cvt_pk_bf16_f32 %0, %1, %2" : "=v"(r) : "v"(lo), "v"(hi)); return r; }
__device__ __forceinline__ bf16x8 ld8(const bf16* p) { return *reinterpret_cast<const bf16x8*>(p); }

__device__ __forceinline__ void partialSM(f32x16& p0, f32x16& p1, float& m_reg, float& mn, float& alpha) {
  constexpr float C = SCALE * 1.4426950408889634f;
  float pmax = p0[0];
#pragma unroll
  for (int r = 1; r < 16; ++r) pmax = fmaxf(pmax, p0[r]);
#pragma unroll
  for (int r = 0; r < 16; ++r) pmax = fmaxf(pmax, p1[r]);
  { auto rr = __builtin_amdgcn_permlane32_swap(__float_as_uint(pmax), __float_as_uint(pmax), false, false);
    pmax = fmaxf(__uint_as_float(rr[0]), __uint_as_float(rr[1])); }
  if (__builtin_expect(__all(pmax - m_reg <= THR / SCALE), 1)) { mn = m_reg; alpha = 1.f; }
  else { mn = fmaxf(m_reg, pmax); alpha = __builtin_amdgcn_exp2f((m_reg - mn) * C); m_reg = mn; }
  float mnC = -mn * C;
#pragma unroll
  for (int r = 0; r < 16; ++r) p0[r] = fmaf(p0[r], C, mnC);
#pragma unroll
  for (int r = 0; r < 16; ++r) p1[r] = fmaf(p1[r], C, mnC);
#pragma unroll
  for (int r = 0; r < 16; ++r) p0[r] = __builtin_amdgcn_exp2f(p0[r]);
}
__device__ __forceinline__ void finishSM(f32x16& p0, f32x16& p1, float alpha, float& l_reg, bf16x8& pa0, bf16x8& pa1, bf16x8& pa2, bf16x8& pa3) {
#pragma unroll
  for (int r = 0; r < 16; ++r) p1[r] = __builtin_amdgcn_exp2f(p1[r]);
  float ps = 0;
#pragma unroll
  for (int r = 0; r < 16; ++r) ps += p0[r];
#pragma unroll
  for (int r = 0; r < 16; ++r) ps += p1[r];
  { auto rr = __builtin_amdgcn_permlane32_swap(__float_as_uint(ps), __float_as_uint(ps), false, false);
    ps = __uint_as_float(rr[0]) + __uint_as_float(rr[1]); }
  l_reg = l_reg * alpha + ps;
#define PK4(P, BASE, OUT) do { unsigned a0 = cvtpk(P[BASE + 0], P[BASE + 1]), a1 = cvtpk(P[BASE + 2], P[BASE + 3]);   \
    unsigned b0 = cvtpk(P[BASE + 4], P[BASE + 5]), b1 = cvtpk(P[BASE + 6], P[BASE + 7]);                              \
    auto r0 = __builtin_amdgcn_permlane32_swap(a0, b0, false, false); auto r1 = __builtin_amdgcn_permlane32_swap(a1, b1, false, false); \
    u32x4 w = {r0[0], r1[0], r0[1], r1[1]}; OUT = *reinterpret_cast<bf16x8*>(&w); } while (0)
  PK4(p0, 0, pa0); PK4(p0, 8, pa1); PK4(p1, 0, pa2); PK4(p1, 8, pa3);
#undef PK4
}
__device__ __forceinline__ void qkt(f32x16& p0, f32x16& p1, const bf16* Ks, const bf16x8* qr, int r32, int hi) {
  p0 = f32x16{}; p1 = f32x16{};
#pragma unroll
  for (int d0 = 0; d0 < 8; ++d0) { int cb = (d0 * 16 + hi * 8) * 2;
    bf16x8 b0 = *reinterpret_cast<const bf16x8*>((const char*)Ks + KSWZ(r32, cb));
    bf16x8 b1 = *reinterpret_cast<const bf16x8*>((const char*)Ks + KSWZ(32 + r32, cb));
    p0 = __builtin_amdgcn_mfma_f32_32x32x16_bf16(b0, qr[d0], p0, 0, 0, 0);
    p1 = __builtin_amdgcn_mfma_f32_32x32x16_bf16(b1, qr[d0], p1, 0, 0, 0); }
}
__device__ __forceinline__ int v_st(int k, int c) { const int kk = (k & ~0xC) | ((k & 4) << 1) | ((k & 8) >> 1); return ((kk >> 3) * 4 + (c >> 5)) * 512 + ((kk & 7) * 32 + (c & 31)) * 2; }
__device__ __forceinline__ int v_rd_base(int lane) { return ((lane & 3) << 3) | (((lane >> 2) & 3) << 6) | (((lane >> 4) & 1) << 5) | (((lane >> 5) & 1) << 8); }
constexpr int v_rd_off(int d0, int ks, int half) { return d0 * 512 + ks * 4096 + half * 2048; }
template <int OFF> __device__ __forceinline__ s16x4 tr_read(int vb) {
  s16x4 r; asm volatile("ds_read_b64_tr_b16 %0, %1 offset:%2" : "=&v"(r) : "v"(vb), "i"(OFF) : "memory"); return r;
}
#define PV_READ(D0, F) do { F[0] = tr_read<v_rd_off(D0, 0, 0)>(vb); F[1] = tr_read<v_rd_off(D0, 0, 1)>(vb); F[2] = tr_read<v_rd_off(D0, 1, 0)>(vb); F[3] = tr_read<v_rd_off(D0, 1, 1)>(vb); \
                            F[4] = tr_read<v_rd_off(D0, 2, 0)>(vb); F[5] = tr_read<v_rd_off(D0, 2, 1)>(vb); F[6] = tr_read<v_rd_off(D0, 3, 0)>(vb); F[7] = tr_read<v_rd_off(D0, 3, 1)>(vb); } while (0)
#define PV_PK(L, H) (bf16x8){L[0], L[1], L[2], L[3], H[0], H[1], H[2], H[3]}
#define PV_MMA(od, F) do { od = __builtin_amdgcn_mfma_f32_32x32x16_bf16(pa0, PV_PK(F[0], F[1]), od, 0, 0, 0); od = __builtin_amdgcn_mfma_f32_32x32x16_bf16(pa1, PV_PK(F[2], F[3]), od, 0, 0, 0); \
                            od = __builtin_amdgcn_mfma_f32_32x32x16_bf16(pa2, PV_PK(F[4], F[5]), od, 0, 0, 0); od = __builtin_amdgcn_mfma_f32_32x32x16_bf16(pa3, PV_PK(F[6], F[7]), od, 0, 0, 0); } while (0)
__device__ __forceinline__ void pv_d0(f32x16* o, int vb, bf16x8 pa0, bf16x8 pa1, bf16x8 pa2, bf16x8 pa3) {
  s16x4 fa[8], fb[8];
  PV_READ(0, fa);
  PV_READ(1, fb); asm volatile("s_waitcnt lgkmcnt(8)" ::: "memory"); SBAR(); PV_MMA(o[0], fa);
  PV_READ(2, fa); asm volatile("s_waitcnt lgkmcnt(8)" ::: "memory"); SBAR(); PV_MMA(o[1], fb);
  PV_READ(3, fb); asm volatile("s_waitcnt lgkmcnt(8)" ::: "memory"); SBAR(); PV_MMA(o[2], fa);
  asm volatile("s_waitcnt lgkmcnt(0)" ::: "memory"); SBAR(); PV_MMA(o[3], fb);
}
#undef PV_READ
#undef PV_PK
#undef PV_MMA

struct AttnPre { bf16x8 qr[8]; bf16x8 vs0[2], vs1[2], ks0[2], ks1[2]; };
__device__ __forceinline__ void attn_prime(AttnPre& P, const bf16* Qb, const bf16* __restrict__ Kh, const bf16* __restrict__ Vh, int tid_in) {
  const int tid = tid_in, wid = __builtin_amdgcn_readfirstlane(tid >> 6), lane = tid & 63, r32 = lane & 31, hi = lane >> 5;
  const int sr = tid >> 4, sc = (tid & 15) * 8;
#pragma unroll
  for (int i = 0; i < 2; ++i) { P.vs0[i] = ld8(&Vh[(long)(i * KVBLK + sr) * LDK + sc]); P.vs1[i] = ld8(&Vh[(long)(i * KVBLK + 32 + sr) * LDK + sc]);
    P.ks0[i] = ld8(&Kh[(long)(i * KVBLK + sr) * LDK + sc]); P.ks1[i] = ld8(&Kh[(long)(i * KVBLK + 32 + sr) * LDK + sc]); }
  const bf16* Qw = Qb + (long)(wid * QBLK + r32) * LDQ + hi * 8;
#pragma unroll
  for (int d0 = 0; d0 < 8; ++d0) P.qr[d0] = ld8(Qw + d0 * 16);
}
__device__ __forceinline__ void attn_dense_body(AttnPre& P, const bf16* __restrict__ Kh, const bf16* __restrict__ Vh, bf16* Ob, int seq, char* lds, const float* qnw, const float* rtab, int t0, int tid_in,
                                                const bf16* Qn, const bf16* __restrict__ Kn, const bf16* __restrict__ Vn, bool has_next) {
  const int tid = tid_in, wid = __builtin_amdgcn_readfirstlane(tid >> 6), lane = tid & 63, r32 = lane & 31, hi = lane >> 5;
  bf16* V_lds = (bf16*)lds; bf16* K_lds = (bf16*)(lds + 2 * SHM_V);
  float* ws = (float*)(lds + 2 * SHM_V + 2 * SHM_K) + wid * 64; float* li_l = ws; float* al_l = ws + 32;
  float m_reg = -1e30f, l_reg = 0; f32x16 o[4] = {}; bf16x8 (&qr)[8] = P.qr;
  {
    float ss = 0.f;
#pragma unroll
    for (int d0 = 0; d0 < 8; ++d0) { const u32x4 w = __builtin_bit_cast(u32x4, qr[d0]);
#pragma unroll
      for (int c = 0; c < 4; ++c) { const float lo = __uint_as_float(w[c] << 16), hi_ = __uint_as_float(w[c] & 0xffff0000u); ss += lo * lo + hi_ * hi_; } }
    ss += __shfl_xor(ss, 32);
    const float rn = 1.0f / sqrtf(ss * (1.f / 128.f) + RMS_EPS);
    const int tq = t0 + wid * QBLK + r32;
    v4f tv[2][2][4], wv[2][2][4];
#pragma unroll
    for (int hf = 0; hf < 2; ++hf) {
      const int pos = hf ? (tq & (GRID_W - 1)) : (tq / GRID_W);
#pragma unroll
      for (int dl = 0; dl < 2; ++dl) {
        const int d1 = 4 * hf + dl, d2 = d1 + 2;
        const float* tp = rtab + (size_t)(pos * 32 + 16 * dl + 8 * hi) * 2;
#pragma unroll
        for (int q4 = 0; q4 < 4; ++q4) tv[hf][dl][q4] = *(const v4f*)(tp + 4 * q4);
        wv[hf][dl][0] = *(const v4f*)(qnw + d1 * 16 + hi * 8); wv[hf][dl][1] = *(const v4f*)(qnw + d1 * 16 + hi * 8 + 4);
        wv[hf][dl][2] = *(const v4f*)(qnw + d2 * 16 + hi * 8); wv[hf][dl][3] = *(const v4f*)(qnw + d2 * 16 + hi * 8 + 4);
      } }
#pragma unroll
    for (int hf = 0; hf < 2; ++hf)
#pragma unroll
      for (int dl = 0; dl < 2; ++dl) {
        const int d1 = 4 * hf + dl, d2 = d1 + 2;
        const u32x4 w1 = __builtin_bit_cast(u32x4, qr[d1]), w2 = __builtin_bit_cast(u32x4, qr[d2]);
        u32x4 o1, o2;
#pragma unroll
        for (int c = 0; c < 4; ++c) {
          const v4f t = tv[hf][dl][c]; const v4f n1 = wv[hf][dl][c >> 1], n2 = wv[hf][dl][2 + (c >> 1)];
          const float a0 = __uint_as_float(w1[c] << 16) * rn * n1[2 * (c & 1)], a1 = __uint_as_float(w1[c] & 0xffff0000u) * rn * n1[2 * (c & 1) + 1];
          const float b0 = __uint_as_float(w2[c] << 16) * rn * n2[2 * (c & 1)], b1 = __uint_as_float(w2[c] & 0xffff0000u) * rn * n2[2 * (c & 1) + 1];
          o1[c] = cvtpk(a0 * t.x - b0 * t.y, a1 * t.z - b1 * t.w);
          o2[c] = cvtpk(b0 * t.x + a0 * t.y, b1 * t.z + a1 * t.w); }
        qr[d1] = __builtin_bit_cast(bf16x8, o1); qr[d2] = __builtin_bit_cast(bf16x8, o2);
      } }
  const int sr = tid >> 4, sc = (tid & 15) * 8, vst0 = v_st(sr, sc), vst1 = v_st(32 + sr, sc);
  const int vb0 = (int)(uintptr_t)V_lds + v_rd_base(lane);
#define SLOADP(i, Kp, Vp, k0) do { P.vs0[i] = ld8(&(Vp)[(long)((k0) + sr) * LDK + sc]); P.vs1[i] = ld8(&(Vp)[(long)((k0) + 32 + sr) * LDK + sc]); \
    P.ks0[i] = ld8(&(Kp)[(long)((k0) + sr) * LDK + sc]); P.ks1[i] = ld8(&(Kp)[(long)((k0) + 32 + sr) * LDK + sc]); } while (0)
#define SLOAD(i, k0) SLOADP(i, Kh, Vh, k0)
#define SWRITE(b, i) do { *(bf16x8*)((char*)V_lds + (b) * SHM_V + vst0) = P.vs0[i];          \
    *(bf16x8*)((char*)V_lds + (b) * SHM_V + vst1) = P.vs1[i]; int kc = sc * 2;               \
    *(bf16x8*)((char*)K_lds + (b) * SHM_K + KSWZ(sr, kc)) = P.ks0[i];                       \
    *(bf16x8*)((char*)K_lds + (b) * SHM_K + KSWZ(32 + sr, kc)) = P.ks1[i]; } while (0)
#define SWAIT() do { asm volatile("s_waitcnt vmcnt(4)" ::: "memory"); } while (0)
#define RESC(a) do { if (__any((a) < 1.f)) { if (hi == 0) al_l[r32] = (a); asm volatile("s_waitcnt lgkmcnt(0)" ::: "memory"); \
    _Pragma("unroll") for (int d = 0; d < 4; ++d) _Pragma("unroll") for (int r = 0; r < 16; ++r) o[d][r] *= al_l[crow(r, hi)]; } } while (0)
  f32x16 pA0, pA1, pB0, pB1; float mnA, mnB, alA, alB; bf16x8 pa0, pa1, pa2, pa3; const int NT = seq / KVBLK;
  constexpr int SE = 0, SO = SDEPTH - 1;
  __syncthreads();
  SWRITE(0, SE); __syncthreads();
  qkt(pA0, pA1, K_lds, qr, r32, hi); partialSM(pA0, pA1, m_reg, mnA, alA);
  if (2 < NT) SLOAD(SE, 2 * KVBLK);
  SWAIT(); SWRITE(1, SO); __syncthreads();
  for (int j = 1; j + 1 < NT; j += 2) {
    SBAR(); qkt(pB0, pB1, (bf16*)((char*)K_lds + SHM_K), qr, r32, hi);
    finishSM(pA0, pA1, alA, l_reg, pa0, pa1, pa2, pa3); SBAR();
    SLOAD(SO, (j + SDEPTH) * KVBLK); SBAR();
    pv_d0(o, vb0, pa0, pa1, pa2, pa3); partialSM(pB0, pB1, m_reg, mnB, alB);
    __syncthreads(); SWAIT(); SWRITE(0, SE);
    RESC(alB); __syncthreads();
    SBAR(); qkt(pA0, pA1, K_lds, qr, r32, hi);
    finishSM(pB0, pB1, alB, l_reg, pa0, pa1, pa2, pa3); SBAR();
    if (j + 3 < NT) SLOAD(SE, (j + 1 + SDEPTH) * KVBLK); SBAR();
    pv_d0(o, vb0 + (int)SHM_V, pa0, pa1, pa2, pa3); partialSM(pA0, pA1, m_reg, mnA, alA);
    __syncthreads(); SWAIT(); SWRITE(1, SO);
    RESC(alA); __syncthreads();
  }
  if (has_next) {
    const int t2 = (wid << 6) | lane_id_now(), sr2 = t2 >> 4, sc2 = (t2 & 15) * 8; const unsigned o2 = (unsigned)(sr2 * LDK + sc2) * 2u;
#pragma unroll
    for (int i = 0; i < 2; ++i) { const char* vp = (const char*)Vn + (size_t)(i * KVBLK * LDK * 2); const char* kp = (const char*)Kn + (size_t)(i * KVBLK * LDK * 2);
      P.vs0[i] = *(const bf16x8*)(vp + o2); P.vs1[i] = *(const bf16x8*)(vp + o2 + 32 * LDK * 2); P.ks0[i] = *(const bf16x8*)(kp + o2); P.ks1[i] = *(const bf16x8*)(kp + o2 + 32 * LDK * 2); } }
  SBAR(); qkt(pB0, pB1, (bf16*)((char*)K_lds + SHM_K), qr, r32, hi);
  finishSM(pA0, pA1, alA, l_reg, pa0, pa1, pa2, pa3); SBAR();
  if (has_next) { const int l2 = lane_id_now(); const unsigned qo2 = (unsigned)((wid * QBLK + (l2 & 31)) * LDQ + (l2 >> 5) * 8) * 2u;
#pragma unroll
    for (int d0 = 0; d0 < 8; ++d0) qr[d0] = *(const bf16x8*)((const char*)Qn + qo2 + d0 * 32); }
  SBAR();
  pv_d0(o, vb0, pa0, pa1, pa2, pa3); partialSM(pB0, pB1, m_reg, mnB, alB);
  __syncthreads(); RESC(alB);
  finishSM(pB0, pB1, alB, l_reg, pa0, pa1, pa2, pa3); SBAR();
  pv_d0(o, vb0 + (int)SHM_V, pa0, pa1, pa2, pa3);
  if (hi == 0) li_l[r32] = l_reg; asm volatile("s_waitcnt lgkmcnt(0)" ::: "memory");
  float rli[16];
#pragma unroll
  for (int r = 0; r < 16; ++r) rli[r] = __builtin_amdgcn_rcpf(li_l[crow(r, hi)]);
  bf16* Ow = Ob + (long)(wid * QBLK) * LDO;
#pragma unroll
  for (int r = 0; r < 16; ++r) { int orow = crow(r, hi);
#pragma unroll
    for (int d0 = 0; d0 < 4; ++d0) Ow[(long)orow * LDO + d0 * 32 + r32] = (bf16)(cvtpk(o[d0][r] * rli[r], 0.f) & 0xffffu); }
#undef SLOAD
#undef SLOADP
#undef SWRITE
#undef SWAIT
#undef RESC
}
#undef KSWZ
#undef SBAR
}
constexpr int NWAVES = 8;
constexpr size_t MiB = 1u << 20;
constexpr size_t WS_CTL = 0, CTL_ZERO_BYTES = 1 * MiB;
constexpr size_t WS_MOD = 512 * 1024;
constexpr size_t WS_WCAT = 1 * MiB;
constexpr size_t WS_H = 259 * MiB;
constexpr size_t WS_WSSM = 387 * MiB;
constexpr size_t WS_WATT = 451 * MiB;
constexpr size_t WS_WOUT = 483 * MiB;
constexpr size_t WS_WUP = 515 * MiB;
constexpr size_t WS_WDN = 687 * MiB;
constexpr size_t WS_Z = 773 * MiB;
constexpr size_t WS_XBCC = 1029 * MiB;
constexpr size_t WS_DT = 1349 * MiB;
constexpr size_t WS_Q = 1365 * MiB;
constexpr size_t WS_K = 1493 * MiB;
constexpr size_t WS_V = 1525 * MiB;
constexpr size_t WS_GATES = 1557 * MiB;
constexpr size_t WS_PART = WS_Z;
constexpr size_t WS_EDGE1 = 687 * MiB;
constexpr size_t WS_YB = 1 * MiB;
constexpr size_t WS_PM = WS_XBCC;
constexpr size_t WS_R1 = 1 * MiB;
constexpr size_t WS_ST1 = WS_Z;
constexpr size_t WS_H2 = WS_XBCC;
constexpr size_t WS_EDGE = 1157 * MiB;
constexpr size_t WS_ACT = 1202 * MiB;
constexpr size_t WS_END = 1557 * MiB + 256 * MiB;

constexpr int LDS_BYTES = 147456;
constexpr int LDS_ZERO_OFF = 143360, MISC_OFF = LDS_ZERO_OFF + 320;

typedef GAS unsigned gu32;
#define RLX_AGENT __ATOMIC_RELAXED, __HIP_MEMORY_SCOPE_AGENT
#define LDS_WAIT() asm volatile("s_waitcnt lgkmcnt(0)" ::: "memory")
#define VM_WAIT() asm volatile("s_waitcnt vmcnt(0)" ::: "memory")
namespace ssd {
using bf16x8 = __attribute__((ext_vector_type(8))) short;
using s16x4  = __attribute__((ext_vector_type(4))) short;
using f32x16 = __attribute__((ext_vector_type(16))) float;
typedef float f2 __attribute__((ext_vector_type(2)));
constexpr int B_OFF = 0, C_OFF = 32768, XX_OFF = 65536, H_OFF = 98304, TBL_OFF = 114688, TBL_BYTES = 2048, MX_OFF = TBL_OFF + 2 * TBL_BYTES, SSD_LDS = MX_OFF + 10 * 2048;
constexpr int T_CUM = 0, T_DT = 512, T_WT = 1024, T_ETOT = 1536;
__device__ __forceinline__ int off_b(int row, int ch) { return 256 * row + 16 * (ch ^ (((row & 3) << 2) | ((row >> 2) & 3))); }
template <int OFF> __device__ __forceinline__ s16x4 tr_read(int addr) {
    s16x4 r; asm volatile("ds_read_b64_tr_b16 %0, %1 offset:%2" : "=&v"(r) : "v"(addr), "i"(OFF) : "memory"); return r;
}
#define SSD_PK(L, H) (bf16x8){L[0], L[1], L[2], L[3], H[0], H[1], H[2], H[3]}
#define SSD_LGKM0() do { asm volatile("s_waitcnt lgkmcnt(0)" ::: "memory"); __builtin_amdgcn_sched_barrier(0); } while (0)
#define SSD_MFMA(a, b, c) __builtin_amdgcn_mfma_f32_32x32x16_bf16(a, b, c, 0, 0, 0)

template <int SB, int LB>
__device__ __forceinline__ void decay_tile(const f32x16& g, bf16x8& m0, bf16x8& m1, LAS const char* tbl, int l31, int h, float cl) {
    const LAS float* cs2 = (const LAS float*)(tbl + T_DT); const float cl2 = cl * 1.4426950408889634f;
    float m[16];
#pragma unroll
    for (int q = 0; q < 4; ++q) { const v4f c4 = *(const LAS v4f*)(cs2 + 32 * SB + 8 * q + 4 * h);
#pragma unroll
        for (int e = 0; e < 4; ++e) { const float v = g[4 * q + e] * __builtin_amdgcn_exp2f(cl2 - c4[e]);
            m[4 * q + e] = (SB != LB || (8 * q + 4 * h + e) <= l31) ? v : 0.f; } }
    { v4u w; w.x = pkbf(m[0], m[1]); w.y = pkbf(m[2], m[3]); w.z = pkbf(m[4], m[5]); w.w = pkbf(m[6], m[7]); m0 = __builtin_bit_cast(bf16x8, w); }
    { v4u w; w.x = pkbf(m[8], m[9]); w.y = pkbf(m[10], m[11]); w.z = pkbf(m[12], m[13]); w.w = pkbf(m[14], m[15]); m1 = __builtin_bit_cast(bf16x8, w); }
}
#define SSD_RRO(s) (rr0 ^ (32 * (s)))
#define SSD_BROW(SB, s) (*(const LAS bf16x8*)(L + B_OFF + 8192 * (SB) + SSD_RRO(s)))

#define SSD_XF(SB, xf) do { xf[0] = tr_read<256 * (32 * (SB) + 0)>(xtr0); xf[1] = tr_read<256 * (32 * (SB) + 8)>(xtr1); xf[2] = tr_read<256 * (32 * (SB) + 16)>(xtr0); xf[3] = tr_read<256 * (32 * (SB) + 24)>(xtr1); } while (0)
#define SSD_MXA(LB_, SB_, KS_) (MX_OFF + ((((LB_) * ((LB_) + 1) / 2 + (SB_)) * 2 + (KS_)) << 10))
template <int LB, int PB>
__device__ __forceinline__ void chunk_y1(f32x16& yi, LAS char* L, LAS const char* tbl, int rr0, int pb, int lane, int l31, int h) {
    constexpr bool HAS_A = (PB <= LB), HAS_B = (PB + 2 <= LB);
    bf16x8 Cfr[8];
#pragma unroll
    for (int s = 0; s < 8; ++s) { LAS const char* as_ = L + SSD_RRO(s); Cfr[s] = *(const LAS bf16x8*)(as_ + (C_OFF + 8192 * LB)); }
    const float cl = *(const LAS float*)(tbl + T_CUM + 4 * (32 * LB + l31));
    f32x16 ga = {}, gb = {}; yi = (f32x16){};
#pragma unroll
    for (int s = 0; s < 8; ++s) {
        LAS const char* as_ = L + SSD_RRO(s);
        const bf16x8 hfr = *(const LAS bf16x8*)(as_ + (H_OFF + 8192 * PB)); yi = SSD_MFMA(hfr, Cfr[s], yi);
        if constexpr (HAS_A) { const bf16x8 ba = *(const LAS bf16x8*)(as_ + (B_OFF + 8192 * PB)); ga = SSD_MFMA(ba, Cfr[s], ga); }
        if constexpr (HAS_B) { const bf16x8 bb = *(const LAS bf16x8*)(as_ + (B_OFF + 8192 * (PB + 2))); gb = SSD_MFMA(bb, Cfr[s], gb); }
    }
    { const float el = __expf(cl);
#pragma unroll
      for (int r = 0; r < 16; ++r) yi[r] *= el; }
    if constexpr (HAS_A) { bf16x8 m0, m1; decay_tile<PB, LB>(ga, m0, m1, tbl, l31, h, cl);
        *(LAS bf16x8*)(L + SSD_MXA(LB, PB, 0) + 16 * lane) = m0; *(LAS bf16x8*)(L + SSD_MXA(LB, PB, 1) + 16 * lane) = m1; }
    if constexpr (HAS_B) { bf16x8 m0, m1; decay_tile<PB + 2, LB>(gb, m0, m1, tbl, l31, h, cl);
        *(LAS bf16x8*)(L + SSD_MXA(LB, PB + 2, 0) + 16 * lane) = m0; *(LAS bf16x8*)(L + SSD_MXA(LB, PB + 2, 1) + 16 * lane) = m1; }
}
template <int LB>
__device__ __forceinline__ void chunk_y2(f32x16& acc_y, LAS const char* L, int xtr0, int xtr1, int lane) {
    s16x4 xf[LB + 1][4]; bf16x8 mf[LB + 1][2];
    SSD_XF(0, xf[0]);
    if constexpr (LB >= 1) SSD_XF(1, xf[1]);
    if constexpr (LB >= 2) SSD_XF(2, xf[2]);
    if constexpr (LB >= 3) SSD_XF(3, xf[3]);
#pragma unroll
    for (int sb = 0; sb <= LB; ++sb) { mf[sb][0] = *(const LAS bf16x8*)(L + SSD_MXA(LB, sb, 0) + 16 * lane); mf[sb][1] = *(const LAS bf16x8*)(L + SSD_MXA(LB, sb, 1) + 16 * lane); }
    SSD_LGKM0();
#pragma unroll
    for (int sb = 0; sb <= LB; ++sb) { acc_y = SSD_MFMA(SSD_PK(xf[sb][0], xf[sb][1]), mf[sb][0], acc_y); acc_y = SSD_MFMA(SSD_PK(xf[sb][2], xf[sb][3]), mf[sb][1], acc_y); }
}
#undef SSD_XF

__device__ __forceinline__ void ssd_unit(LAS char* L, int unit, const bf16* xbc, const float* dtb, const float* a_log, const float* dskip, bf16* yout, int tid_in) {
    const int dir = unit & 1, head = (unit >> 1) & 127, b = unit >> 8, grp = head >> 4;
    asm volatile("" : "+s"(xbc), "+s"(dtb), "+s"(yout));
    int tid_l = tid_in; asm volatile("" : "+v"(tid_l));
    const int tid = tid_l, lane = tid & 63, w = __builtin_amdgcn_readfirstlane(tid >> 6), h = lane >> 5, l31 = lane & 31;
    const int pb = (w < 4) ? 0 : 1, lb = (w < 4) ? w : 7 - w, nb = w & 3, pb2 = w >> 2;
    constexpr int SCANW = 7;
    const float A = -__expf(a_log[dir * SSM_H + head]); const float dsk_eff = (dir == 0) ? dskip[head] : 0.f;
    const int rr0 = 256 * l31 + 16 * (h ^ (((l31 & 3) << 2) | ((l31 >> 2) & 3)));
    const int tq = (lane & 15) >> 2, tp = lane & 3, tblk = (lane >> 4) & 1;
    const int Lb = (int)(uintptr_t)L;
    const int xtr0 = Lb + XX_OFF + 256 * (4 * h + tq) + 16 * ((4 * pb + 2 * tblk + (tp >> 1)) ^ ((tq << 2) | ((0 + h) & 3))) + 8 * (tp & 1);
    const int xtr1 = Lb + XX_OFF + 256 * (4 * h + tq) + 16 * ((4 * pb + 2 * tblk + (tp >> 1)) ^ ((tq << 2) | ((2 + h) & 3))) + 8 * (tp & 1);
    const int btr0 = Lb + B_OFF + 256 * (8 * h + tq) + 16 * ((4 * nb + 2 * tblk + (tp >> 1)) ^ ((tq << 2) | (2 * h + 0))) + 8 * (tp & 1);
    const int btr1 = Lb + B_OFF + 256 * (8 * h + tq) + 16 * ((4 * nb + 2 * tblk + (tp >> 1)) ^ ((tq << 2) | (2 * h + 1))) + 8 * (tp & 1);
    const int wtr0 = Lb + XX_OFF + 256 * (8 * h + tq) + 16 * ((4 * (2 + pb2) + 2 * tblk + (tp >> 1)) ^ ((tq << 2) | (2 * h + 0))) + 8 * (tp & 1);
    const int wtr1 = Lb + XX_OFF + 256 * (8 * h + tq) + 16 * ((4 * (2 + pb2) + 2 * tblk + (tp >> 1)) ^ ((tq << 2) | (2 * h + 1))) + 8 * (tp & 1);

    { unsigned z0; asm volatile("v_mov_b32 %0, 0" : "=v"(z0)); const v4u zz = (v4u){z0, z0, z0, z0};
      for (int i = tid; i < 16384 / 16; i += 512) *(LAS v4u*)(L + H_OFF + i * 16) = zz; }
    f32x16 acc_h = {};
    v4u xr[2], br[4], cr[4]; float dtr0 = 0.f, dtr1 = 0.f, dtn0 = 0.f, dtn1 = 0.f;
    const size_t brow = (size_t)b * SEQ; const int sgn = dir ? -1 : 1;
#define SSD_TOK(ci, tau) (dir ? ((SEQ / 128 - 1 - (ci)) * 128 + 127 - (tau)) : ((ci) * 128 + (tau)))
#define SSD_TB(ci) ((int)brow + (dir ? ((SEQ / 128 - 1 - (ci)) * 128 + 127) : ((ci) * 128)))
#define SSD_PREFETCH(ci) do { const int tb_ = SSD_TB(ci); \
        { const unsigned ox = (unsigned)((tb_ + sgn * (tidl >> 3)) * (SSM_CONVD * 2) + (head * 64 + (tidl & 7) * 8) * 2); const unsigned sx = (unsigned)(sgn * 64 * SSM_CONVD * 2); \
          _Pragma("unroll") for (int i = 0; i < 2; ++i) xr[i] = *(const GAS v4u*)((const char*)xbc + (ox + (unsigned)i * sx)); } \
        { const unsigned ob = (unsigned)((tb_ + sgn * (tidl >> 4)) * (SSM_CONVD * 2) + (SSM_DI + grp * 128 + (tidl & 15) * 8) * 2); const unsigned sb = (unsigned)(sgn * 32 * SSM_CONVD * 2); \
          _Pragma("unroll") for (int i = 0; i < 4; ++i) { const char* rp = (const char*)xbc + (ob + (unsigned)i * sb); br[i] = *(const GAS v4u*)rp; cr[i] = *(const GAS v4u*)(rp + 2048); } } } while (0)
#define SSD_DTLOAD(ci, d0, d1) do { if (w == SCANW) { const unsigned od = (unsigned)((SSD_TB(ci) + sgn * 2 * lane) * 256 + dir * SSM_H + head) * 4u; \
        d0 = *(const GAS float*)((const char*)dtb + od); d1 = *(const GAS float*)((const char*)dtb + (od + (unsigned)(sgn * 1024))); } } while (0)
#define SSD_SCAN(TB) do { if (w == SCANW) { LAS char* tb_ = L + TBL_OFF + (TB) * TBL_BYTES; \
        const float a0 = dtr0 * A, a1 = dtr1 * A; float inc = a0 + a1; \
        _Pragma("unroll") for (int o = 1; o < 64; o <<= 1) { const float v = __shfl_up(inc, o); if (lane >= o) inc += v; } \
        const float c1 = inc, c0 = inc - a1; const float total = __shfl(inc, 63); \
        *(LAS f2*)(tb_ + T_CUM + 8 * lane) = (f2){c0, c1}; *(LAS f2*)(tb_ + T_DT + 8 * lane) = (f2){(c0 - __logf(dtr0)) * 1.4426950408889634f, (c1 - __logf(dtr1)) * 1.4426950408889634f}; \
        *(LAS f2*)(tb_ + T_WT + 8 * lane) = (f2){__expf(total - c0) * dtr0, __expf(total - c1) * dtr1}; if (lane == 0) *(LAS float*)(tb_ + T_ETOT) = __expf(total); } } while (0)
#define SSD_STAGE(TB) do { const LAS char* tb_ = L + TBL_OFF + (TB) * TBL_BYTES; \
        { const int obc = off_b(tidl >> 4, tidl & 15);                    \
          _Pragma("unroll") for (int i = 0; i < 4; ++i) { *(LAS v4u*)(L + B_OFF + obc + 8192 * i) = br[i]; *(LAS v4u*)(L + C_OFF + obc + 8192 * i) = cr[i]; } } \
        { const int oxx = off_b(tidl >> 3, tidl & 7);                     \
          _Pragma("unroll") for (int i = 0; i < 2; ++i) { const float wt = *(const LAS float*)(tb_ + T_WT + 4 * (tidl >> 3) + 256 * i); \
            *(LAS v4u*)(L + XX_OFF + oxx + 16384 * i) = xr[i]; \
            v4u o; o.x = pkbf(bflo(xr[i].x) * wt, bfhi(xr[i].x) * wt); o.y = pkbf(bflo(xr[i].y) * wt, bfhi(xr[i].y) * wt); o.z = pkbf(bflo(xr[i].z) * wt, bfhi(xr[i].z) * wt); o.w = pkbf(bflo(xr[i].w) * wt, bfhi(xr[i].w) * wt); \
            *(LAS v4u*)(L + XX_OFF + (oxx ^ 128) + 16384 * i) = o; } } } while (0)

    int tidl = tid; asm volatile("" : "+v"(tidl));
    SSD_DTLOAD(0, dtr0, dtr1);
    SSD_PREFETCH(0);
    SSD_SCAN(0);
    SSD_DTLOAD(1, dtr0, dtr1);
    __syncthreads();
    SSD_STAGE(0);
    SSD_PREFETCH(1);
    __syncthreads();
    for (int ci = 0; ci < SEQ / 128; ++ci) {
        const bool more = (ci + 1 < SEQ / 128);
        tidl = tid; asm volatile("" : "+v"(tidl));
        LAS const char* tbl = L + TBL_OFF + (ci & 1) * TBL_BYTES;
        if (ci + 2 < SEQ / 128) SSD_DTLOAD(ci + 2, dtn0, dtn1);
        if (more) SSD_SCAN((ci + 1) & 1);
        const float e_tot = *(const LAS float*)(tbl + T_ETOT);
        f32x16 acc_y;
        if (pb == 0) { if (lb == 0) chunk_y1<0, 0>(acc_y, L, tbl, rr0, pb, lane, l31, h); else if (lb == 1) chunk_y1<1, 0>(acc_y, L, tbl, rr0, pb, lane, l31, h);
                       else if (lb == 2) chunk_y1<2, 0>(acc_y, L, tbl, rr0, pb, lane, l31, h); else chunk_y1<3, 0>(acc_y, L, tbl, rr0, pb, lane, l31, h); }
        else         { if (lb == 0) chunk_y1<0, 1>(acc_y, L, tbl, rr0, pb, lane, l31, h); else if (lb == 1) chunk_y1<1, 1>(acc_y, L, tbl, rr0, pb, lane, l31, h);
                       else if (lb == 2) chunk_y1<2, 1>(acc_y, L, tbl, rr0, pb, lane, l31, h); else chunk_y1<3, 1>(acc_y, L, tbl, rr0, pb, lane, l31, h); }
        __syncthreads();
        if (lb == 0) chunk_y2<0>(acc_y, L, xtr0, xtr1, lane); else if (lb == 1) chunk_y2<1>(acc_y, L, xtr0, xtr1, lane);
        else if (lb == 2) chunk_y2<2>(acc_y, L, xtr0, xtr1, lane); else chunk_y2<3>(acc_y, L, xtr0, xtr1, lane);
        s16x4 sa[8][2], sb_[8][2];
#define SSD_ST_RD(KS) do { sa[KS][0] = tr_read<256 * (16 * (KS) + 0)>(btr0); sa[KS][1] = tr_read<256 * (16 * (KS) + 4)>(btr1); \
                           sb_[KS][0] = tr_read<256 * (16 * (KS) + 0)>(wtr0); sb_[KS][1] = tr_read<256 * (16 * (KS) + 4)>(wtr1); } while (0)
        SSD_ST_RD(0); SSD_ST_RD(1); SSD_ST_RD(2); SSD_ST_RD(3); SSD_ST_RD(4); SSD_ST_RD(5); SSD_ST_RD(6); SSD_ST_RD(7);
#undef SSD_ST_RD
        { char* yp = (char*)yout + (unsigned)((SSD_TB(ci) + sgn * (32 * lb + l31)) * SSM_DI + head * 64 + 32 * pb + 4 * h) * 2u;
          if (dir == 0) { const int x0 = off_b(32 * lb + l31, 4 * pb) + 8 * h;
#pragma unroll
            for (int q = 0; q < 4; ++q) { const v2u xq = *(const LAS v2u*)(L + XX_OFF + (x0 ^ (16 * q)));
              v2u o; o.x = pkbf(acc_y[4 * q] + dsk_eff * bflo(xq.x), acc_y[4 * q + 1] + dsk_eff * bfhi(xq.x)); o.y = pkbf(acc_y[4 * q + 2] + dsk_eff * bflo(xq.y), acc_y[4 * q + 3] + dsk_eff * bfhi(xq.y));
              *(GAS v2u*)(yp + 16 * q) = o; }
          } else {
#pragma unroll
            for (int q = 0; q < 4; ++q) { v2u o; o.x = pkbf(acc_y[4 * q], acc_y[4 * q + 1]); o.y = pkbf(acc_y[4 * q + 2], acc_y[4 * q + 3]); *(GAS v2u*)(yp + 16 * q) = o; } } }
        dtr0 = dtn0; dtr1 = dtn1;
        SSD_LGKM0();
        __syncthreads();
        { f32x16 ha = {}, hb = {};
          __builtin_amdgcn_s_setprio(1);
          ha = SSD_MFMA(SSD_PK(sa[0][0], sa[0][1]), SSD_PK(sb_[0][0], sb_[0][1]), ha); hb = SSD_MFMA(SSD_PK(sa[1][0], sa[1][1]), SSD_PK(sb_[1][0], sb_[1][1]), hb);
          ha = SSD_MFMA(SSD_PK(sa[2][0], sa[2][1]), SSD_PK(sb_[2][0], sb_[2][1]), ha); hb = SSD_MFMA(SSD_PK(sa[3][0], sa[3][1]), SSD_PK(sb_[3][0], sb_[3][1]), hb);
          ha = SSD_MFMA(SSD_PK(sa[4][0], sa[4][1]), SSD_PK(sb_[4][0], sb_[4][1]), ha); hb = SSD_MFMA(SSD_PK(sa[5][0], sa[5][1]), SSD_PK(sb_[5][0], sb_[5][1]), hb);
          ha = SSD_MFMA(SSD_PK(sa[6][0], sa[6][1]), SSD_PK(sb_[6][0], sb_[6][1]), ha); hb = SSD_MFMA(SSD_PK(sa[7][0], sa[7][1]), SSD_PK(sb_[7][0], sb_[7][1]), hb);
          __builtin_amdgcn_s_setprio(0);
#pragma unroll
          for (int r = 0; r < 16; ++r) acc_h[r] = acc_h[r] * e_tot + (ha[r] + hb[r]); }
        tidl = tid; asm volatile("" : "+v"(tidl));
        if (more) {
            const int a0 = off_b(32 * pb2 + l31, 4 * nb) + 8 * h;
#pragma unroll
            for (int q = 0; q < 4; ++q) { v2u o; o.x = pkbf(acc_h[4 * q], acc_h[4 * q + 1]); o.y = pkbf(acc_h[4 * q + 2], acc_h[4 * q + 3]);
                *(LAS v2u*)(L + H_OFF + (a0 ^ (16 * q))) = o; }
            SSD_STAGE((ci + 1) & 1);
            if (ci + 2 < SEQ / 128) SSD_PREFETCH(ci + 2);
        }
        __syncthreads();
    }
#undef SSD_TOK
#undef SSD_PREFETCH
#undef SSD_DTLOAD
#undef SSD_SCAN
#undef SSD_STAGE
}
#undef SSD_PK
#undef SSD_LGKM0
#undef SSD_MFMA
#undef SSD_BROW
#undef SSD_RRO
#undef SSD_MXA
}
#define XB_TMO      128
#define XB_XCNT(j)  (256  + 64 * (j))
#define XB_XSUB(j)  (1280 + 64 * (j))
#define XB_XGEN(j)  (2304 + 64 * (j))
#define XB_TOP      3328
#define XB_TOPGEN   3392
#define XCD_BAR_WORDS 3456
#define XB_SPIN_CAP (1u << 18)

__device__ __forceinline__ unsigned xb_ld(unsigned* p)              { return __hip_atomic_load(p, __ATOMIC_RELAXED, __HIP_MEMORY_SCOPE_AGENT); }
__device__ __forceinline__ unsigned xb_add(unsigned* p, unsigned v) { return __hip_atomic_fetch_add(p, v, __ATOMIC_RELAXED, __HIP_MEMORY_SCOPE_AGENT); }
__device__ __forceinline__ unsigned xb_xcc_id() { return (unsigned)__builtin_amdgcn_s_getreg((3 << 11) | 20) & 0xFu; }
#define XB_SPIN(cond, bar) do { unsigned _sp = 0; while (cond) { __builtin_amdgcn_s_sleep(1); \
    if ((++_sp & 255u) == 0u) { if (xb_ld(&(bar)[XB_TMO])) break; if (_sp > XB_SPIN_CAP) { atomicAdd(&(bar)[XB_TMO], 1u); break; } } } } while (0)

struct XcdBarrier {
    unsigned* bar; unsigned x;
    volatile LAS unsigned* st;
};

__device__ __forceinline__ XcdBarrier xcd_barrier_post(unsigned* bar, volatile LAS unsigned* st, int tid) {
    XcdBarrier b; b.bar = bar; b.x = xb_xcc_id(); b.st = st;
    if (tid == 0) (void)xb_add(&bar[XB_XCNT(b.x)], 1u);
    return b;
}
__device__ __forceinline__ void xcd_barrier_complete(unsigned* bar, unsigned x, unsigned& nloc, unsigned& nx) {
    const unsigned G = gridDim.x * gridDim.y * gridDim.z;
    unsigned sum, cnt, mine, sp = 0u;
    for (;;) {
        sum = 0u; cnt = 0u; mine = 0u;
#pragma unroll
        for (unsigned j = 0; j < 16; ++j) { const unsigned c = xb_ld(&bar[XB_XCNT(j)]); sum += c; cnt += (c > 0u) ? 1u : 0u; mine = (j == x) ? c : mine; }
        if (sum == G) break;
        __builtin_amdgcn_s_sleep(1);
        if ((++sp & 255u) == 0u) { if (xb_ld(&bar[XB_TMO])) break; if (sp > XB_SPIN_CAP) { atomicAdd(&bar[XB_TMO], 1u); break; } }
    }
    nloc = mine > 0u ? mine : 1u; nx = cnt > 0u ? cnt : 1u;
}

__device__ __forceinline__ void xcd_barrier(const XcdBarrier& b, int tid) {
    asm volatile("s_waitcnt vmcnt(0)" ::: "memory");
    __syncthreads();
    if (tid == 0) {
        unsigned* bar = b.bar;
        __builtin_amdgcn_s_waitcnt(0);
        unsigned nloc = b.st[0], nx = b.st[1];
        if (nloc == 0u) { xcd_barrier_complete(bar, b.x, nloc, nx); b.st[0] = nloc; b.st[1] = nx; }
        const unsigned old = xb_add(&bar[XB_XSUB(b.x)], 1u);
        const unsigned gen = old / nloc;
        if (old + 1u == (gen + 1u) * nloc) {
            __builtin_amdgcn_fence(__ATOMIC_RELEASE, "agent");
            asm volatile("s_waitcnt vmcnt(0)" ::: "memory");
            const unsigned og = xb_add(&bar[XB_TOP], 1u);
            const unsigned tg = og / nx;
            if (og + 1u == (tg + 1u) * nx) xb_add(&bar[XB_TOPGEN], 1u);
            else XB_SPIN(xb_ld(&bar[XB_TOPGEN]) == tg, bar);
            __builtin_amdgcn_fence(__ATOMIC_ACQUIRE, "agent");
            xb_add(&bar[XB_XGEN(b.x)], 1u);
            asm volatile("s_waitcnt vmcnt(0)" ::: "memory");
        } else {
            XB_SPIN(xb_ld(&bar[XB_XGEN(b.x)]) == gen, bar);
            __builtin_amdgcn_fence(__ATOMIC_ACQUIRE, "agent");
            asm volatile("s_waitcnt vmcnt(0)" ::: "memory");
        }
    }
    __syncthreads();
}
struct Ctx { LAS unsigned char* lds; int tid, lane, wave, gw, NGW, G; };
constexpr int NWAVES_C = 8;

__device__ __forceinline__ void transpose_item(const float* W, int K, int N, bf16* WT, int row_off, LAS float* scr, int item, int lane) {
    const int nblk = N / 32, kb = item / nblk, nb = item % nblk, k0 = 64 * kb, n0 = 32 * nb;
#pragma unroll 8
    for (int i = 0; i < 32; ++i) { const int kk = 2 * i + (lane >> 5); scr[kk * 33 + (lane & 31)] = W[(size_t)(k0 + kk) * N + n0 + (lane & 31)]; }
    LDS_WAIT(); asm volatile("" ::: "memory");
    const int c = lane & 7;
#pragma unroll
    for (int j = 0; j < 4; ++j) { const int n = (lane >> 3) + 8 * j; const LAS float* s = scr + (8 * c) * 33 + n;
        v4u o; o.x = pkbf(s[0 * 33], s[1 * 33]); o.y = pkbf(s[2 * 33], s[3 * 33]); o.z = pkbf(s[4 * 33], s[5 * 33]); o.w = pkbf(s[6 * 33], s[7 * 33]);
        *(GAS v4u*)(WT + (size_t)(row_off + n0 + n) * K + k0 + 8 * c) = o; }
    LDS_WAIT(); asm volatile("" ::: "memory");
}

struct P0Args { const float *c, *w_ada, *b_ada; float* mod; float* ropetab; const float *w_in, *w_gate, *w_ssm, *w_att, *w_out, *w_up, *w_dn; bf16 *Wcat, *Wssm, *Watt, *Wout, *Wup, *Wdn; };
__device__ __forceinline__ void phase_prologue(const Ctx& X, const P0Args& A) {
    for (int it = X.gw; it < 96 * 64; it += X.NGW) {
        const int nb = it % 96, kc = it / 96, n0 = nb * 256 + X.lane * 4, k0 = kc * 64;
        float sc[4];
#pragma unroll
        for (int b = 0; b < 4; ++b) sc[b] = siluf_(A.c[b * D_MODEL + k0 + X.lane]);
        v4f acc[4];
#pragma unroll
        for (int b = 0; b < 4; ++b) acc[b] = (v4f){0.f, 0.f, 0.f, 0.f};
        const float* wp = A.w_ada + (size_t)k0 * MOD_LD + n0;
#pragma unroll 1
        for (int kq = 0; kq < 4; ++kq) {
            v4f w[16];
#pragma unroll
            for (int kk = 0; kk < 16; ++kk) w[kk] = *(const GAS v4f*)(wp + (size_t)(kq * 16 + kk) * MOD_LD);
#pragma unroll
            for (int kk = 0; kk < 16; ++kk)
#pragma unroll
                for (int b = 0; b < 4; ++b) { const float s = __uint_as_float(__builtin_amdgcn_readlane(__float_as_uint(sc[b]), kq * 16 + kk)); acc[b] += w[kk] * s; }
        }
        if (kc == 0) { const v4f bb = *(const GAS v4f*)(A.b_ada + n0);
#pragma unroll
            for (int b = 0; b < 4; ++b) acc[b] += bb; }
#pragma unroll
        for (int b = 0; b < 4; ++b) { float* mp = A.mod + (size_t)b * MOD_LD + n0;
            unsafeAtomicAdd(mp, acc[b].x); unsafeAtomicAdd(mp + 1, acc[b].y); unsafeAtomicAdd(mp + 2, acc[b].z); unsafeAtomicAdd(mp + 3, acc[b].w); }
    }
    { const int gt = X.gw * 64 + X.lane;
      if (gt < 64 * 32) { const int pos = gt >> 5, i = gt & 31; const float ang = (float)pos * exp2f(-(float)i * (13.287712379549449f / 32.0f)); float sn, cs; sincosf(ang, &sn, &cs);
          A.ropetab[2 * gt] = cs; A.ropetab[2 * gt + 1] = sn; } }
    LAS float* scr = (LAS float*)(X.lds + X.wave * 16384);
    constexpr int I_IN = (D_MODEL / 64) * (IN_COLS / 32), I_GATE = (D_MODEL / 64) * (2 * D_MODEL / 32);
    constexpr int NITEMS = I_IN + I_GATE;
    for (int it = X.gw; it < NITEMS; it += X.NGW) {
        int r = it;
        if (r < I_IN) { transpose_item(A.w_in, D_MODEL, IN_COLS, A.Wcat, 0, scr, r, X.lane); continue; } r -= I_IN;
        transpose_item(A.w_gate, D_MODEL, 2 * D_MODEL, A.Wcat, IN_COLS, scr, r, X.lane);
    }
}
__device__ __forceinline__ void transposes_up_share(const Ctx& X, const float* w_up, bf16* Wup) {
    LAS float* scr = (LAS float*)(X.lds + X.wave * 16384);
    constexpr int I_UP = (D_MODEL / 64) * (FFN2 / 32), nblk = FFN2 / 32;
    const int lr = X.lane >> 3, lc = 4 * (X.lane & 7);
    for (int it0 = X.gw; it0 < I_UP; it0 += 2 * X.NGW) {
        const int it1 = it0 + X.NGW; const bool two = it1 < I_UP;
        v4f v[2][8];
#pragma unroll
        for (int s = 0; s < 2; ++s) { const int it = (s && two) ? it1 : it0; const int kb = it / nblk, nb = it % nblk;
            const GAS float* src = (const GAS float*)w_up + (size_t)(64 * kb + lr) * FFN2 + 32 * nb + lc;
#pragma unroll
            for (int i = 0; i < 8; ++i) v[s][i] = *(const GAS v4f*)(src + (size_t)(8 * i) * FFN2); }
#pragma unroll
        for (int s = 0; s < 2; ++s) {
            if (s && !two) break;
            const int it = s ? it1 : it0; const int kb = it / nblk, nb = it % nblk, k0 = 64 * kb, n0 = 32 * nb;
            const int f = (n0 < FFN) ? (256 * (n0 >> 7) + (n0 & 127)) : (256 * ((n0 - FFN) >> 7) + 128 + ((n0 - FFN) & 127));
#pragma unroll
            for (int i = 0; i < 8; ++i) { LAS float* d = scr + (lr + 8 * i) * 33 + lc; d[0] = v[s][i].x; d[1] = v[s][i].y; d[2] = v[s][i].z; d[3] = v[s][i].w; }
            LDS_WAIT(); asm volatile("" ::: "memory");
            const int c = X.lane & 7;
#pragma unroll
            for (int j = 0; j < 4; ++j) { const int n = (X.lane >> 3) + 8 * j; const LAS float* sp = scr + (8 * c) * 33 + n;
                v4u o; o.x = pkbf(sp[0 * 33], sp[1 * 33]); o.y = pkbf(sp[2 * 33], sp[3 * 33]); o.z = pkbf(sp[4 * 33], sp[5 * 33]); o.w = pkbf(sp[6 * 33], sp[7 * 33]);
                *(GAS v4u*)(Wup + (size_t)(f + n) * D_MODEL + k0 + 8 * c) = o; }
            LDS_WAIT(); asm volatile("" ::: "memory");
        }
    }
}
__device__ __forceinline__ void tail_transposes_mix(const Ctx& X, int first, const float* w_ssm, const float* w_att, const float* w_out, bf16* Wssm, bf16* Watt, bf16* Wout) {
    if ((int)blockIdx.x < first) return;
    LAS float* scr = (LAS float*)(X.lds + X.wave * 16384);
    constexpr int I_SSM = (SSM_DI / 64) * (D_MODEL / 32), I_ATT = (D_MODEL / 64) * (D_MODEL / 32), NIT = I_SSM + 2 * I_ATT;
    const int gwv = ((int)blockIdx.x - first) * NWAVES_C + X.wave, ngw = (X.G - first) * NWAVES_C;
    for (int it = gwv; it < NIT; it += ngw) {
        int r = it;
        if (r < I_SSM) { transpose_item(w_ssm, SSM_DI, D_MODEL, Wssm, 0, scr, r, X.lane); continue; } r -= I_SSM;
        if (r < I_ATT) { transpose_item(w_att, D_MODEL, D_MODEL, Watt, 0, scr, r, X.lane); continue; } r -= I_ATT;
        transpose_item(w_out, D_MODEL, D_MODEL, Wout, 0, scr, r, X.lane);
    }
}
__device__ __forceinline__ void tail_transposes_down(const Ctx& X, int first, const float* w_dn, bf16* Wdn) {
    if ((int)blockIdx.x < first) return;
    LAS float* scr = (LAS float*)(X.lds + X.wave * 16384);
    constexpr int NIT = (FFN / 64) * (D_MODEL / 32);
    const int gwv = ((int)blockIdx.x - first) * NWAVES_C + X.wave, ngw = (X.G - first) * NWAVES_C;
    for (int it = gwv; it < NIT; it += ngw) transpose_item(w_dn, FFN, D_MODEL, Wdn, 0, scr, it, X.lane);
}
__device__ __forceinline__ void phase_mod_reduce(const Ctx& X, const float* part, const float* b_ada, float* mod) {
    const int gt = X.gw * 64 + X.lane;
    for (int i = gt; i < 4 * MOD_LD / 4; i += X.NGW * 64) {
        const int b = i / (MOD_LD / 4), n = (i % (MOD_LD / 4)) * 4;
        v4f s = *(const GAS v4f*)(b_ada + n);
#pragma unroll 8
        for (int kc = 0; kc < 64; ++kc) s += *(const GAS v4f*)(part + ((size_t)(kc * 4 + b)) * MOD_LD + n);
        *(GAS v4f*)(mod + (size_t)b * MOD_LD + n) = s;
    }
}
__device__ __forceinline__ void ln_stats(const v4f (&v)[16], float& mean, float& rstd) {
    float s = 0.f;
#pragma unroll
    for (int j = 0; j < 16; ++j) s += (v[j].x + v[j].y) + (v[j].z + v[j].w);
    mean = wave_sum(s) * (1.f / D_MODEL); float s2 = 0.f;
#pragma unroll
    for (int j = 0; j < 16; ++j) { const v4f d = v[j] - mean; s2 += (d.x * d.x + d.y * d.y) + (d.z * d.z + d.w * d.w); }
    rstd = 1.0f / sqrtf(wave_sum(s2) * (1.f / D_MODEL) + LN_EPS);
}
__device__ __forceinline__ void phase_h(const Ctx& X, const float* x, const float* mod, bf16* h) {
    for (int m = X.gw; m < MTOK; m += X.NGW) {
        const GAS v4f* xr = (const GAS v4f*)(x + (size_t)m * D_MODEL) + X.lane;
        v4f v[16];
#pragma unroll
        for (int j = 0; j < 16; ++j) v[j] = xr[64 * j];
        float mean, rstd; ln_stats(v, mean, rstd);
        const float* mrow = mod + (size_t)(m / SEQ) * MOD_LD;
        const GAS v4f* sh = (const GAS v4f*)(mrow) + X.lane; const GAS v4f* sc = (const GAS v4f*)(mrow + D_MODEL) + X.lane;
        GAS v2u* o = (GAS v2u*)(h + (size_t)m * D_MODEL) + X.lane;
#pragma unroll
        for (int j = 0; j < 16; ++j) { const v4f y = (v[j] - mean) * rstd * (sc[64 * j] + 1.0f) + sh[64 * j]; v2u w; w.x = pkbf(y.x, y.y); w.y = pkbf(y.z, y.w); o[64 * j] = w; }
    }
}
__device__ __forceinline__ void unpack8(const v4u w, float (&f)[8]) { f[0] = bflo(w.x); f[1] = bfhi(w.x); f[2] = bflo(w.y); f[3] = bfhi(w.y); f[4] = bflo(w.z); f[5] = bfhi(w.z); f[6] = bflo(w.w); f[7] = bfhi(w.w); }
__device__ __forceinline__ void phase_xbc_fixup(const Ctx& X, const float* edge, const float* cw, const float* cb, bf16* out) {
    constexpr int NCG = SSM_CONVD / 8, NSEG = MTOK / 128;
    const int gt = X.gw * 64 + X.lane, NT = X.NGW * 64;
    for (int it = gt; it < (NSEG - 1) * NCG; it += NT) {
        const int bd = 1 + it / NCG, c = 8 * (it % NCG);
        if ((bd & 31) == 0) continue;
        const float* e_lm1 = edge + ((size_t)(bd - 1) * 4 + 2) * SSM_CONVD + c; const float* e_l = e_lm1 + SSM_CONVD;
        const float* e_f = edge + ((size_t)bd * 4 + 0) * SSM_CONVD + c; const float* e_f1 = e_f + SSM_CONVD;
        float oa[8], ob[8];
#pragma unroll
        for (int j = 0; j < 8; ++j) { const float w0 = cw[c + j], w1 = cw[SSM_CONVD + c + j], w2 = cw[2 * SSM_CONVD + c + j], bb = cb[c + j];
            oa[j] = siluf_(e_lm1[j] * w0 + e_l[j] * w1 + e_f[j] * w2 + bb);
            ob[j] = siluf_(e_l[j] * w0 + e_f[j] * w1 + e_f1[j] * w2 + bb); }
        v4u w0_, w1_; w0_.x = pkbf(oa[0], oa[1]); w0_.y = pkbf(oa[2], oa[3]); w0_.z = pkbf(oa[4], oa[5]); w0_.w = pkbf(oa[6], oa[7]);
        w1_.x = pkbf(ob[0], ob[1]); w1_.y = pkbf(ob[2], ob[3]); w1_.z = pkbf(ob[4], ob[5]); w1_.w = pkbf(ob[6], ob[7]);
        *(GAS v4u*)(out + (size_t)(128 * bd - 1) * SSM_CONVD + c) = w0_; *(GAS v4u*)(out + (size_t)(128 * bd) * SSM_CONVD + c) = w1_;
    }
}
__device__ __forceinline__ void qk_norm_rope_rows(const Ctx& X, bf16* buf, int nheads, const float* nw, const float* tab) {
    const int total = MTOK * nheads / 4;
    const int sub = X.lane >> 4, j16 = X.lane & 15;
    float wv[8];
#pragma unroll
    for (int e = 0; e < 8; ++e) wv[e] = nw[j16 * 8 + e];
    const int half = j16 >> 3, jj = j16 & 7;
    const bool is_x2 = (jj >= 4);
    const int i0 = (jj & 3) * 8;
    for (int it = X.gw; it < total; it += X.NGW) {
        const int pair = it * 4 + sub, tok = pair / nheads, hd = pair % nheads;
        GAS v4u* p = (GAS v4u*)(buf + ((size_t)tok * nheads + hd) * 128 + j16 * 8);
        float f[8]; unpack8(*p, f);
        float ss = 0.f;
#pragma unroll
        for (int e = 0; e < 8; ++e) ss += f[e] * f[e];
        ss += __shfl_xor(ss, 1); ss += __shfl_xor(ss, 2); ss += __shfl_xor(ss, 4); ss += __shfl_xor(ss, 8);
        const float r = 1.0f / sqrtf(ss * (1.f / 128.f) + RMS_EPS);
#pragma unroll
        for (int e = 0; e < 8; ++e) f[e] = f[e] * r * wv[e];
        const int t = tok % SEQ; const int pos = half ? (t % GRID_W) : (t / GRID_W);
        const GAS v4f* tp = (const GAS v4f*)(tab + (size_t)(pos * 32 + i0) * 2);
        float csn[16];
#pragma unroll
        for (int q4 = 0; q4 < 4; ++q4) { const v4f tv = tp[q4]; csn[q4 * 4 + 0] = tv.x; csn[q4 * 4 + 1] = tv.y; csn[q4 * 4 + 2] = tv.z; csn[q4 * 4 + 3] = tv.w; }
        float o[8];
#pragma unroll
        for (int e = 0; e < 8; ++e) { const float other = __shfl_xor(f[e], 4); const float cs = csn[2 * e], sn = csn[2 * e + 1];
            o[e] = is_x2 ? (f[e] * cs + other * sn) : (f[e] * cs - other * sn); }
        v4u w; w.x = pkbf(o[0], o[1]); w.y = pkbf(o[2], o[3]); w.z = pkbf(o[4], o[5]); w.w = pkbf(o[6], o[7]);
        *p = w;
    }
}
__device__ __forceinline__ void ssd_naive_unit(const Ctx& X, int unit, const bf16* xbc, const float* dtb, const float* a_log, bf16* yout) {
    const int dir = unit & 1, head = (unit >> 1) & 127, b = unit >> 8, grp = head >> 4;
    const int tid = X.tid, p = tid >> 3, ng = tid & 7;
    LAS float* xs = (LAS float*)X.lds;
    LAS float* Bs = xs + 64 * 64;
    LAS float* Cs = Bs + 64 * 128;
    LAS float* dts = Cs + 64 * 128;
    LAS float* as_ = dts + 64;
    LAS float* ys = as_ + 64;
    const float A = -__expf(a_log[dir * SSM_H + head]);
    float h[16];
#pragma unroll
    for (int i = 0; i < 16; ++i) h[i] = 0.f;
    for (int ci = 0; ci < SEQ / 64; ++ci) {
        const int c = dir ? (SEQ / 64 - 1 - ci) : ci; const size_t row0 = (size_t)b * SEQ + (size_t)c * 64;
        { const int tok = tid >> 3, s8 = (tid & 7);
          const bf16* rp = xbc + (row0 + tok) * SSM_CONVD;
          float f[8]; unpack8(*(const GAS v4u*)(rp + head * 64 + s8 * 8), f);
#pragma unroll
          for (int j = 0; j < 8; ++j) xs[tok * 64 + s8 * 8 + j] = f[j];
          unpack8(*(const GAS v4u*)(rp + SSM_DI + grp * 128 + s8 * 16), f);
#pragma unroll
          for (int j = 0; j < 8; ++j) Bs[tok * 128 + s8 * 16 + j] = f[j];
          unpack8(*(const GAS v4u*)(rp + SSM_DI + grp * 128 + s8 * 16 + 8), f);
#pragma unroll
          for (int j = 0; j < 8; ++j) Bs[tok * 128 + s8 * 16 + 8 + j] = f[j];
          unpack8(*(const GAS v4u*)(rp + SSM_DI + 1024 + grp * 128 + s8 * 16), f);
#pragma unroll
          for (int j = 0; j < 8; ++j) Cs[tok * 128 + s8 * 16 + j] = f[j];
          unpack8(*(const GAS v4u*)(rp + SSM_DI + 1024 + grp * 128 + s8 * 16 + 8), f);
#pragma unroll
          for (int j = 0; j < 8; ++j) Cs[tok * 128 + s8 * 16 + 8 + j] = f[j];
          if (tid < 64) { const float dv = dtb[(row0 + tid) * 256 + dir * SSM_H + head]; dts[tid] = dv; as_[tid] = __expf(dv * A); } }
        __syncthreads();
#pragma unroll 2
        for (int ti = 0; ti < 64; ++ti) {
            const int t = dir ? 63 - ti : ti;
            const float av = as_[t], xv = xs[t * 64 + p] * dts[t];
            float part = 0.f;
#pragma unroll
            for (int i4 = 0; i4 < 4; ++i4) { const v4f bv = *(const LAS v4f*)(Bs + t * 128 + ng * 16 + i4 * 4), cv = *(const LAS v4f*)(Cs + t * 128 + ng * 16 + i4 * 4);
#pragma unroll
                for (int j = 0; j < 4; ++j) { h[i4 * 4 + j] = av * h[i4 * 4 + j] + xv * bv[j]; part += cv[j] * h[i4 * 4 + j]; } }
            part += __shfl_xor(part, 1); part += __shfl_xor(part, 2); part += __shfl_xor(part, 4);
            if (ng == 0) ys[t * 64 + p] = part;
        }
        __syncthreads();
        { const int tok = tid >> 3, s8 = tid & 7; const LAS float* yp = ys + tok * 64 + s8 * 8;
          v4u o; o.x = pkbf(yp[0], yp[1]); o.y = pkbf(yp[2], yp[3]); o.z = pkbf(yp[4], yp[5]); o.w = pkbf(yp[6], yp[7]);
          *(GAS v4u*)(yout + (row0 + tok) * SSM_DI + head * 64 + s8 * 8) = o; }
    }
    __syncthreads();
}
__device__ __forceinline__ void phase_ssm_combine(const Ctx& X, const bf16* yf, const bf16* yb, bf16* z, const float* normw) {
    for (int it = X.gw; it < MTOK * SSM_G; it += X.NGW) {
        const int tok = it >> 3, g = it & 7, e0 = g * 1024 + X.lane * 16;
        float y[16];
#pragma unroll
        for (int hh = 0; hh < 2; ++hh) { float a[8], bq[8], zz[8];
            unpack8(*(const GAS v4u*)(yf + (size_t)tok * SSM_DI + e0 + hh * 8), a); unpack8(*(const GAS v4u*)(yb + (size_t)tok * SSM_DI + e0 + hh * 8), bq);
            unpack8(*(const GAS v4u*)(z + (size_t)tok * SSM_DI + e0 + hh * 8), zz);
#pragma unroll
            for (int j = 0; j < 8; ++j) y[hh * 8 + j] = (a[j] + bq[j]) * siluf_(zz[j]); }
        float ss = 0.f;
#pragma unroll
        for (int j = 0; j < 16; ++j) ss += y[j] * y[j];
        const float r = 1.0f / sqrtf(wave_sum(ss) * (1.f / 1024.f) + RMS_EPS);
#pragma unroll
        for (int hh = 0; hh < 2; ++hh) { float o[8];
#pragma unroll
            for (int j = 0; j < 8; ++j) o[j] = y[hh * 8 + j] * r * normw[e0 + hh * 8 + j];
            v4u w; w.x = pkbf(o[0], o[1]); w.y = pkbf(o[2], o[3]); w.z = pkbf(o[4], o[5]); w.w = pkbf(o[6], o[7]);
            *(GAS v4u*)(z + (size_t)tok * SSM_DI + e0 + hh * 8) = w; }
    }
}
__device__ __forceinline__ void phase_ln1(const Ctx& X, const float* r1, const float* g, const float* bt, const float* mod, float* stats, bf16* h2) {
    for (int m = X.gw; m < MTOK; m += X.NGW) {
        const GAS v4f* rr = (const GAS v4f*)(r1 + (size_t)m * D_MODEL) + X.lane;
        v4f v[16];
#pragma unroll
        for (int j = 0; j < 16; ++j) v[j] = rr[64 * j];
        float mean, rstd; ln_stats(v, mean, rstd);
        const float* gl = g; const float* bl = bt; asm volatile("" : "+s"(gl), "+s"(bl));
        const GAS v4f* gp = (const GAS v4f*)gl + X.lane; const GAS v4f* bp = (const GAS v4f*)bl + X.lane;
        if (X.lane == 0) { typedef float f2_ __attribute__((ext_vector_type(2))); *(GAS f2_*)(stats + 2 * (size_t)m) = (f2_){mean, rstd}; }
#pragma unroll
        for (int j = 0; j < 16; ++j) { v[j] = (v[j] - mean) * rstd * gp[64 * j] + bp[64 * j]; if ((j & 3) == 3) asm volatile("" ::: "memory"); }
        ln_stats(v, mean, rstd);
        const float* mrow = mod + (size_t)(m / SEQ) * MOD_LD;
        const GAS v4f* sh = (const GAS v4f*)(mrow + 3 * D_MODEL) + X.lane; const GAS v4f* sc = (const GAS v4f*)(mrow + 4 * D_MODEL) + X.lane;
        GAS v2u* o = (GAS v2u*)(h2 + (size_t)m * D_MODEL) + X.lane;
#pragma unroll
        for (int j = 0; j < 16; ++j) { const v4f y = (v[j] - mean) * rstd * (sc[64 * j] + 1.0f) + sh[64 * j]; v2u w; w.x = pkbf(y.x, y.y); w.y = pkbf(y.z, y.w); o[64 * j] = w; }
    }
}
__device__ __forceinline__ void phase_conv_fixup(const Ctx& X, const float* edge, const float* cw, const float* cb, bf16* act) {
    constexpr int NCG = FFN / 8, NSEG = MTOK / 128;
    const int gt = X.gw * 64 + X.lane, NT = X.NGW * 64;
    for (int it = gt; it < (NSEG - 1) * NCG; it += NT) {
        const int bd = 1 + it / NCG, cg = it % NCG;
        if ((bd & 31) == 0) continue;
        const int c = 8 * cg, tca = 256 * (c >> 7) + (c & 127);
        const float* e_lm1 = edge + ((size_t)(bd - 1) * 4 + 2) * 22016 + tca;
        const float* e_l = e_lm1 + 22016;
        const float* e_f = edge + ((size_t)bd * 4 + 0) * 22016 + tca;
        const float* e_f1 = e_f + 22016;
        float oa[8], ob[8];
#pragma unroll
        for (int j = 0; j < 8; ++j) {
            const float wa0 = cw[c + j], wa1 = cw[FFN2 + c + j], wa2 = cw[2 * FFN2 + c + j], ba = cb[c + j];
            const float wb0 = cw[FFN + c + j], wb1 = cw[FFN2 + FFN + c + j], wb2 = cw[2 * FFN2 + FFN + c + j], bb = cb[FFN + c + j];
            const float a_lm1 = e_lm1[j], a_l = e_l[j], a_f = e_f[j], a_f1 = e_f1[j], b_lm1 = e_lm1[128 + j], b_l = e_l[128 + j], b_f = e_f[128 + j], b_f1 = e_f1[128 + j];
            const float ca0 = a_lm1 * wa0 + a_l * wa1 + a_f * wa2 + ba, cb0 = b_lm1 * wb0 + b_l * wb1 + b_f * wb2 + bb;
            const float ca1 = a_l * wa0 + a_f * wa1 + a_f1 * wa2 + ba, cb1 = b_l * wb0 + b_f * wb1 + b_f1 * wb2 + bb;
            oa[j] = siluf_(ca0) * cb0; ob[j] = siluf_(ca1) * cb1; }
        v4u w0, w1; w0.x = pkbf(oa[0], oa[1]); w0.y = pkbf(oa[2], oa[3]); w0.z = pkbf(oa[4], oa[5]); w0.w = pkbf(oa[6], oa[7]);
        w1.x = pkbf(ob[0], ob[1]); w1.y = pkbf(ob[2], ob[3]); w1.z = pkbf(ob[4], ob[5]); w1.w = pkbf(ob[6], ob[7]);
        *(GAS v4u*)(act + (size_t)(128 * bd - 1) * FFN + c) = w0; *(GAS v4u*)(act + (size_t)(128 * bd) * FFN + c) = w1;
    }
}
__device__ __forceinline__ void phase_ln_final(const Ctx& X, float* io, const float* g, const float* bt) {
    for (int m = X.gw; m < MTOK; m += X.NGW) {
        GAS v4f* rr = (GAS v4f*)(io + (size_t)m * D_MODEL) + X.lane;
        v4f v[16];
#pragma unroll
        for (int j = 0; j < 16; ++j) v[j] = rr[64 * j];
        float mean, rstd; ln_stats(v, mean, rstd);
        const GAS v4f* gp = (const GAS v4f*)g + X.lane; const GAS v4f* bp = (const GAS v4f*)bt + X.lane;
#pragma unroll
        for (int j = 0; j < 16; ++j) rr[64 * j] = (v[j] - mean) * rstd * gp[64 * j] + bp[64 * j];
    }
}
constexpr int N_PHASES = 15;
struct Args { const float* in[26]; float* out; unsigned char* ws; int ph_lo, ph_hi; };
__global__ void __launch_bounds__(NWAVES * 64, 2) mk_fwd(Args args) {
    extern __shared__ __attribute__((aligned(16))) unsigned char lds[];
    volatile LAS unsigned* MISC = (volatile LAS unsigned*)((LAS unsigned char*)lds + MISC_OFF);
    unsigned char* const ws = args.ws;
    for (int u = threadIdx.x; u < (LDS_BYTES - LDS_ZERO_OFF) / 4; u += NWAVES * 64) ((LAS unsigned*)((LAS unsigned char*)lds + LDS_ZERO_OFF))[u] = 0u;
    __syncthreads();
    const int s_wave = __builtin_amdgcn_readfirstlane((int)threadIdx.x >> 6);
#define TIDX() ((s_wave << 6) | lane_id_now())
    XcdBarrier bar = xcd_barrier_post((unsigned*)(ws + WS_CTL), MISC + 8, TIDX());
    const int lo = args.ph_lo, hi = args.ph_hi;
#define IN(k) (lo <= (k) && (k) < hi)
#define SEAM(k) do { if (IN(k) && IN((k) + 1)) xcd_barrier(bar, TIDX()); } while (0)
#define MKCTX() Ctx X; { int t_ = TIDX(); asm volatile("" : "+v"(t_)); X.lds = (LAS unsigned char*)lds; X.tid = t_; X.lane = t_ & 63; X.wave = __builtin_amdgcn_readfirstlane(t_ >> 6); \
        X.G = gridDim.x; X.gw = blockIdx.x * NWAVES + X.wave; X.NGW = X.G * NWAVES; }
#define x_in args.in[0]
#define mod ((float*)(ws + WS_MOD))
#define ropetab ((float*)(ws + WS_MOD + 393216))
#define Wcat ((bf16*)(ws + WS_WCAT))
#define Wssm ((bf16*)(ws + WS_WSSM))
#define Watt ((bf16*)(ws + WS_WATT))
#define Wout ((bf16*)(ws + WS_WOUT))
#define Wup ((bf16*)(ws + WS_WUP))
#define Wdn ((bf16*)(ws + WS_WDN))
#define hbuf ((bf16*)(ws + WS_H))
#define zbuf ((bf16*)(ws + WS_Z))
#define edge1 ((float*)(ws + WS_EDGE1))
#define dtb ((float*)(ws + WS_DT))
#define qb ((bf16*)(ws + WS_Q))
#define kb ((bf16*)(ws + WS_K))
#define vb ((bf16*)(ws + WS_V))
#define gates ((bf16*)(ws + WS_GATES))
#define xbcc ((bf16*)(ws + WS_XBCC))
#define yfb ((bf16*)args.out)
#define ybb ((bf16*)(ws + WS_YB))
#define pm ((bf16*)(ws + WS_PM))
#define r1 ((float*)(ws + WS_R1))
#define st1 ((float*)(ws + WS_ST1))
#define h2 ((bf16*)(ws + WS_H2))
#define edgeb ((float*)(ws + WS_EDGE))
#define act ((bf16*)(ws + WS_ACT))

    if (IN(0)) { MKCTX();
        P0Args A{args.in[1], args.in[2], args.in[3], mod, ropetab, args.in[4], args.in[15], args.in[13], args.in[14], args.in[17], args.in[20], args.in[23], Wcat, Wssm, Watt, Wout, Wup, Wdn};
        phase_prologue(X, A);
    }
    SEAM(0);
    if (IN(2)) { MKCTX(); phase_h(X, x_in, mod, hbuf); }
    SEAM(2);
    if (IN(3)) { MKCTX();
        pg8::Gemm g{hbuf, Wcat, MTOK, CAT_COLS, D_MODEL}; pg8::StaticOrder S; S.init(MTOK, CAT_COLS, X.G, (int)blockIdx.x);
        pg8::EpiIn E{zbuf, xbcc, qb, kb, vb, gates, dtb, args.in[8], args.in[16], args.in[5], args.in[6], edge1};
        pg8::gemm_phase<pg8::EpiIn, pg8::StaticOrder, true, true>(X.lds, g, S, E, X.tid);
    }
    if (IN(3)) { MKCTX();
        { const int nwg = (MTOK / 256) * (CAT_COLS / 256), first = nwg % X.G; if (first) tail_transposes_mix(X, first, args.in[13], args.in[14], args.in[17], Wssm, Watt, Wout); else tail_transposes_mix(X, 0, args.in[13], args.in[14], args.in[17], Wssm, Watt, Wout); }
    }
    SEAM(3);
    if (IN(4)) { MKCTX();
        phase_xbc_fixup(X, edge1, args.in[5], args.in[6], xbcc);
        qk_norm_rope_rows(X, kb, AT_HKV, args.in[12], ropetab);
    }
    SEAM(4);
    if (IN(5)) { MKCTX();
        const bool xcd_map = (X.G == 256);
        const int up_pos = ((int)blockIdx.x & 7) % 5; int slot = 0;
        for (int u = blockIdx.x; u < BATCH * SSM_H * 2; u += X.G, ++slot) {
            if (slot == up_pos) { __syncthreads(); transposes_up_share(X, args.in[20], Wup); __syncthreads(); }
            int unit = u;
            if (xcd_map) { const int c = blockIdx.x, r = u >> 8, grp = c & 7, j = c >> 3; unit = ((r * SSM_H + grp * 16 + (j & 15)) << 1) | (j >> 4); }
            ssd::ssd_unit((LAS char*)X.lds, unit, xbcc, dtb, args.in[7], args.in[9], (unit & 1) ? ybb : yfb, X.tid);
        }
        if (slot <= up_pos) { __syncthreads(); transposes_up_share(X, args.in[20], Wup); __syncthreads(); }
        {
            auto unit_ptrs = [&](int u, size_t& qoff, size_t& koff, int& qblk) {
                qblk = u % (SEQ / 256); int hh = (u / (SEQ / 256)) % AT_HQ, b = u / ((SEQ / 256) * AT_HQ);
                if (xcd_map) { const int c = blockIdx.x, r = u >> 8, kvh_ = c & 7, j = (c >> 3) + 32 * (r & 1); b = r >> 1; hh = kvh_ * (AT_HQ / AT_HKV) + (j >> 4); qblk = j & 15; }
                const int kvh = hh / (AT_HQ / AT_HKV);
                qoff = ((size_t)b * SEQ + (size_t)qblk * 256) * (AT_HQ * AT_D) + (size_t)hh * AT_D; koff = (size_t)b * SEQ * (AT_HKV * AT_D) + (size_t)kvh * AT_D; };
            const int NU = BATCH * AT_HQ * (SEQ / 256);
            attn::AttnPre P; size_t qoff, koff; int qblk;
            if ((int)blockIdx.x < NU) { unit_ptrs(blockIdx.x, qoff, koff, qblk); attn::attn_prime(P, qb + qoff, kb + koff, vb + koff, X.tid); }
            for (int u = blockIdx.x; u < NU; u += X.G) {
                const bool has_next = u + X.G < NU; size_t qn = qoff, kn = koff; int qbn = qblk;
                if (has_next) unit_ptrs(u + X.G, qn, kn, qbn);
                attn::attn_dense_body(P, kb + koff, vb + koff, qb + qoff, SEQ, (char*)lds, args.in[11], ropetab, qblk * 256, X.tid, qb + qn, kb + kn, vb + kn, has_next);
                qoff = qn; koff = kn; qblk = qbn;
            }
        }
        __syncthreads();
    }
    SEAM(5);
    if (IN(6)) { MKCTX(); phase_ssm_combine(X, yfb, ybb, zbuf, args.in[10]); }
    SEAM(6);
    if (IN(7)) { MKCTX();
        pg8::Gemm g{zbuf, Wssm, MTOK, D_MODEL, SSM_DI}; pg8::StaticOrder S; S.init(MTOK, D_MODEL, X.G, (int)blockIdx.x);
        pg8::EpiMix E{gates, pm, 0};
        pg8::gemm_phase<pg8::EpiMix, pg8::StaticOrder, true, true>(X.lds, g, S, E, X.tid);
    }
    if (IN(8)) { MKCTX();
        pg8::Gemm g{qb, Watt, MTOK, D_MODEL, D_MODEL}; pg8::StaticOrder S; S.init(MTOK, D_MODEL, X.G, (int)blockIdx.x);
        pg8::EpiMix E{gates, pm, 1};
        pg8::gemm_phase<pg8::EpiMix, pg8::StaticOrder, true, true>(X.lds, g, S, E, X.tid);
    }
    SEAM(8);
    if (IN(9)) { MKCTX();
        pg8::Gemm g{pm, Wout, MTOK, D_MODEL, D_MODEL}; pg8::StaticOrder S; S.init(MTOK, D_MODEL, X.G, (int)blockIdx.x);
        pg8::EpiRes E{x_in, r1, mod + 2 * D_MODEL, DN_ALPHA};
        pg8::gemm_phase<pg8::EpiRes, pg8::StaticOrder, true, true>(X.lds, g, S, E, X.tid);
    }
    SEAM(9);
    if (IN(10)) { MKCTX(); phase_ln1(X, r1, args.in[18], args.in[19], mod, st1, h2); }
    SEAM(10);
    if (IN(11)) { MKCTX();
        pg8::Gemm g{h2, Wup, MTOK, FFN2, D_MODEL}; pg8::StaticOrder S; S.init(MTOK, FFN2, X.G, (int)blockIdx.x);
        pg8::EpiConvGate E{act, edgeb, args.in[21], args.in[22]};
        pg8::gemm_phase<pg8::EpiConvGate, pg8::StaticOrder, true, true>(X.lds, g, S, E, X.tid);
    }
    if (IN(11)) { MKCTX();
        { const int nwg = (MTOK / 256) * (FFN2 / 256), first = nwg % X.G; tail_transposes_down(X, first, args.in[23], Wdn); }
    }
    SEAM(11);
    if (IN(12)) { MKCTX(); phase_conv_fixup(X, edgeb, args.in[21], args.in[22], act); }
    SEAM(12);
    if (IN(13)) { MKCTX();
        pg8::Gemm g{act, Wdn, MTOK, D_MODEL, FFN}; pg8::StaticOrder S; S.init(MTOK, D_MODEL, X.G, (int)blockIdx.x);
        pg8::EpiResLn E{r1, st1, args.in[18], args.in[19], args.out, mod + 5 * D_MODEL, DN_ALPHA};
        pg8::gemm_phase<pg8::EpiResLn, pg8::StaticOrder, true, true>(X.lds, g, S, E, X.tid);
    }
    SEAM(13);
    if (IN(14)) { MKCTX(); phase_ln_final(X, args.out, args.in[24], args.in[25]); }
#undef IN
#undef SEAM
#undef MKCTX
#undef TIDX
#undef x_in
#undef mod
#undef ropetab
#undef Wcat
#undef Wssm
#undef Watt
#undef Wout
#undef Wup
#undef Wdn
#undef hbuf
#undef zbuf
#undef edge1
#undef dtb
#undef qb
#undef kb
#undef vb
#undef gates
#undef xbcc
#undef yfb
#undef ybb
#undef pm
#undef r1
#undef st1
#undef h2
#undef edgeb
#undef act
}

extern "C" void kernel_launch(void* const* d_in, const int* in_sizes, int n_in, void* d_out, int out_size, void* d_ws, size_t ws_size, hipStream_t stream) {
    static int grid = 0;
    if (grid == 0) {
        if (n_in != 26 || in_sizes[0] != MTOK * D_MODEL || out_size != MTOK * D_MODEL || ws_size < WS_END) {
            fprintf(stderr, "kernel_launch: shape mismatch (n_in %d in0 %d out %d ws %zu need %zu); nothing launched\n", n_in, n_in > 0 ? in_sizes[0] : -1, out_size, ws_size, (size_t)WS_END); grid = -1; return; }
        int dev = 0, cus = 0, per_cu = 0;
        if (hipGetDevice(&dev) != hipSuccess || hipDeviceGetAttribute(&cus, hipDeviceAttributeMultiprocessorCount, dev) != hipSuccess) { grid = -1; return; }
        if (hipFuncSetAttribute((const void*)mk_fwd, hipFuncAttributeMaxDynamicSharedMemorySize, LDS_BYTES) != hipSuccess) { fprintf(stderr, "kernel_launch: hipFuncSetAttribute failed\n"); grid = -1; return; }
        if (hipOccupancyMaxActiveBlocksPerMultiprocessor(&per_cu, (const void*)mk_fwd, NWAVES * 64, LDS_BYTES) != hipSuccess || per_cu < 1) { fprintf(stderr, "kernel_launch: occupancy query says %d blocks per CU\n", per_cu); }
        (void)hipGetLastError();
        grid = cus;
    }
    if (grid < 0) return;
    if (hipMemsetAsync((char*)d_ws + WS_CTL, 0, CTL_ZERO_BYTES, stream) != hipSuccess) return;
    Args a{};
    for (int i = 0; i < 26; ++i) a.in[i] = (const float*)d_in[i];
    a.out = (float*)d_out; a.ws = (unsigned char*)d_ws; a.ph_lo = 0; a.ph_hi = N_PHASES;
    hipLaunchKernelGGL(mk_fwd, dim3(grid), dim3(NWAVES * 64), LDS_BYTES, stream, a);
    const hipError_t le = hipPeekAtLastError();
    if (le != hipSuccess) fprintf(stderr, "kernel_launch: launch failed: %s\n", hipGetErrorName(le));
}
```
